# Optimizing an MI355X kernel written in HIP

```python
import math
import jax, jax.numpy as jnp
from jax import lax
import numpy as np

D_MODEL = 2048
BATCH = 8
SEQ = 2048
DEPTH = 4

S5_WIDTH = D_MODEL
S5_GROUP = 16
S5_GROUPS = S5_WIDTH // S5_GROUP
S5_STATE = 64
S5_DT_MIN = 1e-3
S5_DT_MAX = 1e-1
ATT_HEADS = 16
ATT_HEAD_DIM = D_MODEL // ATT_HEADS
Q_LORA = 512
KV_LORA = 512
IDX_HEADS = 16
IDX_DIM = 128
IDX_TOPK = 256
Q_BLOCK = 128
DSA_IN_WIDTH = Q_LORA + KV_LORA + IDX_DIM + IDX_HEADS
REL_BUCKETS = 32
REL_MAX_DIST = 128
MOE_GROUPS = 4
MOE_PER_GROUP = 8
MOE_EXPERTS = MOE_GROUPS * MOE_PER_GROUP
MOE_TOPK = 2
MOE_FF = 256
DN_ALPHA = (2 * DEPTH) ** 0.25
DN_BETA = (8 * DEPTH) ** -0.25
N_S5_LAYERS = (DEPTH + 1) // 2
N_DSA_LAYERS = DEPTH // 2
LN_EPS = 1e-5
RMS_EPS = 1e-6

kernel_name = "hybrid_s5_dsa_hmoe_deepnorm"


def _layer_norm(x, g, b):
    xf = x.astype(jnp.float32)
    xc = xf - jnp.mean(xf, -1, keepdims=True)
    var = jnp.mean(xc * xc, -1, keepdims=True)
    return (xc * lax.rsqrt(var + LN_EPS) * g.astype(jnp.float32) + b.astype(jnp.float32)).astype(x.dtype)


def _rms_norm(x, g):
    xf = x.astype(jnp.float32)
    return (xf * lax.rsqrt(jnp.mean(xf * xf, -1, keepdims=True) + RMS_EPS) * g.astype(jnp.float32)).astype(x.dtype)


def _rel_bucket(rel):
    n = jnp.maximum(rel, 0)
    max_exact = REL_BUCKETS // 2
    nf = jnp.maximum(n, 1).astype(jnp.float32)
    large = max_exact + (jnp.log(nf / max_exact) / math.log(REL_MAX_DIST / max_exact)
                         * (REL_BUCKETS - max_exact)).astype(jnp.int32)
    large = jnp.minimum(large, REL_BUCKETS - 1)
    return jnp.where(n < max_exact, n, large)


def _s5_mixer(x, w_in, a_re, a_im, log_dt, b_re, b_im, c_re, c_im, d, w_glu, w_out):
    bsz, L, _ = x.shape
    f32 = jnp.float32
    u = (x @ w_in).astype(f32).reshape(bsz, L, S5_GROUPS, S5_GROUP)
    lam = lax.complex(jnp.minimum(a_re.astype(f32), -1e-4), a_im.astype(f32))
    dt = jnp.exp(log_dt.astype(f32))[:, None]
    a_bar = jnp.exp(lam * dt)
    b_bar = ((a_bar - 1.0) / lam)[..., None] * lax.complex(b_re.astype(f32), b_im.astype(f32))
    bu = jnp.einsum('blgp,gnp->blgn', u.astype(jnp.complex64), b_bar)
    a_seq = jnp.broadcast_to(a_bar, (1, L) + a_bar.shape)

    def combine(e1, e2):
        a1, b1 = e1
        a2, b2 = e2
        return a2 * a1, a2 * b1 + b2

    _, h = lax.associative_scan(combine, (a_seq, bu), axis=1)
    c = lax.complex(c_re.astype(f32), c_im.astype(f32))
    y = jnp.einsum('blgn,gpn->blgp', h, c).real + d.astype(f32) * u
    z = jax.nn.gelu(y.reshape(bsz, L, S5_WIDTH)).astype(x.dtype)
    return (z * jax.nn.sigmoid(z @ w_glu)) @ w_out


def _dsa_mixer(x, rel_bias, w_in, q_norm, kv_norm, w_uq, w_qidx, w_uk, w_uv, w_out):
    bsz, L, _ = x.shape
    proj = x @ w_in
    c_q, c_kv, k_idx, w_idx = jnp.split(proj, [Q_LORA, Q_LORA + KV_LORA, Q_LORA + KV_LORA + IDX_DIM], axis=-1)
    c_q = _rms_norm(c_q, q_norm)
    c_kv = _rms_norm(c_kv, kv_norm)
    q = (c_q @ w_uq).reshape(bsz, L, ATT_HEADS, ATT_HEAD_DIM)
    q_idx = (c_q @ w_qidx).reshape(bsz, L, IDX_HEADS, IDX_DIM)
    w_idx = w_idx * (IDX_HEADS ** -0.5)
    n_sel = min(IDX_TOPK, L // 4)
    n_blk = L // Q_BLOCK
    att_scale = ATT_HEAD_DIM ** -0.5
    idx_scale = IDX_DIM ** -0.5
    key_pos = jnp.arange(L, dtype=jnp.int32)
    gather_rows = jax.vmap(lambda rows, ids: rows[ids])

    def block(jb):
        t0 = jb * Q_BLOCK
        q_pos = t0 + jnp.arange(Q_BLOCK, dtype=jnp.int32)
        qb = lax.dynamic_slice_in_dim(q, t0, Q_BLOCK, axis=1)
        qib = lax.dynamic_slice_in_dim(q_idx, t0, Q_BLOCK, axis=1)
        wib = lax.dynamic_slice_in_dim(w_idx, t0, Q_BLOCK, axis=1)
        rel_scores = jax.nn.relu(jnp.einsum('bqhd,bsd->bqhs', qib, k_idx) * idx_scale)
        index = jnp.einsum('bqhs,bqh->bqs', rel_scores, wib).astype(jnp.float32)
        causal = key_pos[None, :] <= q_pos[:, None]
        index = jnp.where(causal[None], index, -jnp.inf)
        _, sel = lax.top_k(index, n_sel)
        valid = sel <= q_pos[None, :, None]
        kv_sel = gather_rows(c_kv, sel)
        q_lat = jnp.einsum('bqhd,hdc->bqhc', qb, w_uk)
        logits = jnp.einsum('bqhc,bqkc->bhqk', q_lat, kv_sel).astype(jnp.float32) * att_scale
        bias = rel_bias[_rel_bucket(q_pos[None, :, None] - sel)]
        logits = logits + jnp.moveaxis(bias, -1, 1).astype(jnp.float32)
        logits = jnp.where(valid[:, None], logits, -jnp.inf)
        p = jax.nn.softmax(logits, axis=-1).astype(x.dtype)
        o_lat = jnp.einsum('bhqk,bqkc->bqhc', p, kv_sel)
        o = jnp.einsum('bqhc,hcd->bqhd', o_lat, w_uv)
        return o.reshape(bsz, Q_BLOCK, ATT_HEADS * ATT_HEAD_DIM)

    out = lax.map(block, jnp.arange(n_blk, dtype=jnp.int32))
    out = jnp.moveaxis(out, 0, 1).reshape(bsz, L, ATT_HEADS * ATT_HEAD_DIM)
    return out @ w_out


def _hier_moe(x, w_group, b_group, w_expert, b_expert, w_gate, w_up, w_down):
    bsz, L, dm = x.shape
    t = x.reshape(bsz * L, dm)
    g_prob = jax.nn.softmax((t @ w_group).astype(jnp.float32) + b_group.astype(jnp.float32), axis=-1)
    g_p, g_idx = lax.top_k(g_prob, 1)
    g_onehot = jax.nn.one_hot(g_idx[:, 0], MOE_GROUPS, dtype=jnp.float32)
    e_logits = ((t @ w_expert).astype(jnp.float32) + b_expert.astype(jnp.float32)).reshape(-1, MOE_GROUPS, MOE_PER_GROUP)
    e_logits = jnp.einsum('tge,tg->te', e_logits, g_onehot)
    e_p, e_idx = lax.top_k(jax.nn.softmax(e_logits, axis=-1), MOE_TOPK)
    e_p = e_p / jnp.sum(e_p, -1, keepdims=True)
    within = jnp.einsum('tk,tke->te', e_p, jax.nn.one_hot(e_idx, MOE_PER_GROUP, dtype=jnp.float32))
    gate = ((g_onehot * g_p)[:, :, None] * within[:, None, :]).reshape(-1, MOE_EXPERTS).astype(x.dtype)
    h = jax.nn.silu(jnp.einsum('td,edf->tef', t, w_gate)) * jnp.einsum('td,edf->tef', t, w_up)
    y = jnp.einsum('tef,efd->td', h * gate[:, :, None], w_down)
    return y.reshape(bsz, L, dm)


def setup_inputs(seed: int = 0) -> dict:
    key = jax.random.key(seed)
    ks = iter(jax.random.split(key, 40))
    f32 = jnp.float32

    def nrm(shape, scale):
        return jax.random.normal(next(ks), shape, f32) * scale

    NS, ND = N_S5_LAYERS, N_DSA_LAYERS
    HD = ATT_HEADS * ATT_HEAD_DIM
    n_idx = jnp.arange(S5_STATE, dtype=f32)
    x = nrm((BATCH, SEQ, D_MODEL), 1.0)
    rel_bias = nrm((REL_BUCKETS, ATT_HEADS), 0.5)
    s5_w_in = nrm((NS, D_MODEL, S5_WIDTH), D_MODEL ** -0.5)
    s5_a_re = -0.5 + nrm((NS, S5_GROUPS, S5_STATE), 0.01)
    s5_a_im = math.pi * n_idx + nrm((NS, S5_GROUPS, S5_STATE), 0.01)
    s5_log_dt = jax.random.uniform(next(ks), (NS, S5_GROUPS), f32, math.log(S5_DT_MIN), math.log(S5_DT_MAX))
    s5_b_re = nrm((NS, S5_GROUPS, S5_STATE, S5_GROUP), (2 * S5_GROUP) ** -0.5)
    s5_b_im = nrm((NS, S5_GROUPS, S5_STATE, S5_GROUP), (2 * S5_GROUP) ** -0.5)
    s5_c_re = nrm((NS, S5_GROUPS, S5_GROUP, S5_STATE), S5_STATE ** -0.5)
    s5_c_im = nrm((NS, S5_GROUPS, S5_GROUP, S5_STATE), S5_STATE ** -0.5)
    s5_d = nrm((NS, S5_GROUPS, S5_GROUP), 1.0)
    s5_w_glu = nrm((NS, S5_WIDTH, S5_WIDTH), S5_WIDTH ** -0.5)
    s5_w_out = nrm((NS, S5_WIDTH, D_MODEL), S5_WIDTH ** -0.5 * DN_BETA)
    dsa_w_in = nrm((ND, D_MODEL, DSA_IN_WIDTH), D_MODEL ** -0.5)
    dsa_q_norm = 1.0 + nrm((ND, Q_LORA), 0.02)
    dsa_kv_norm = 1.0 + nrm((ND, KV_LORA), 0.02)
    dsa_w_uq = nrm((ND, Q_LORA, HD), Q_LORA ** -0.5)
    dsa_w_qidx = nrm((ND, Q_LORA, IDX_HEADS * IDX_DIM), Q_LORA ** -0.5)
    dsa_w_uk = nrm((ND, ATT_HEADS, ATT_HEAD_DIM, KV_LORA), KV_LORA ** -0.5)
    dsa_w_uv = nrm((ND, ATT_HEADS, KV_LORA, ATT_HEAD_DIM), KV_LORA ** -0.5)
    dsa_w_out = nrm((ND, HD, D_MODEL), HD ** -0.5 * DN_BETA)
    moe_w_group = nrm((DEPTH, D_MODEL, MOE_GROUPS), D_MODEL ** -0.5)
    moe_b_group = nrm((DEPTH, MOE_GROUPS), 0.01)
    moe_w_expert = nrm((DEPTH, D_MODEL, MOE_EXPERTS), D_MODEL ** -0.5)
    moe_b_expert = nrm((DEPTH, MOE_EXPERTS), 0.01)
    moe_w_gate = nrm((DEPTH, MOE_EXPERTS, D_MODEL, MOE_FF), D_MODEL ** -0.5)
    moe_w_up = nrm((DEPTH, MOE_EXPERTS, D_MODEL, MOE_FF), D_MODEL ** -0.5)
    moe_w_down = nrm((DEPTH, MOE_EXPERTS, MOE_FF, D_MODEL), MOE_FF ** -0.5 * DN_BETA)
    ln_mix_g = 1.0 + nrm((DEPTH, D_MODEL), 0.02)
    ln_mix_b = nrm((DEPTH, D_MODEL), 0.02)
    ln_ffn_g = 1.0 + nrm((DEPTH, D_MODEL), 0.02)
    ln_ffn_b = nrm((DEPTH, D_MODEL), 0.02)
    return {
        "x": x, "rel_bias": rel_bias,
        "s5_w_in": s5_w_in, "s5_a_re": s5_a_re, "s5_a_im": s5_a_im, "s5_log_dt": s5_log_dt,
        "s5_b_re": s5_b_re, "s5_b_im": s5_b_im, "s5_c_re": s5_c_re, "s5_c_im": s5_c_im,
        "s5_d": s5_d, "s5_w_glu": s5_w_glu, "s5_w_out": s5_w_out,
        "dsa_w_in": dsa_w_in, "dsa_q_norm": dsa_q_norm, "dsa_kv_norm": dsa_kv_norm,
        "dsa_w_uq": dsa_w_uq, "dsa_w_qidx": dsa_w_qidx, "dsa_w_uk": dsa_w_uk,
        "dsa_w_uv": dsa_w_uv, "dsa_w_out": dsa_w_out,
        "moe_w_group": moe_w_group, "moe_b_group": moe_b_group,
        "moe_w_expert": moe_w_expert, "moe_b_expert": moe_b_expert,
        "moe_w_gate": moe_w_gate, "moe_w_up": moe_w_up, "moe_w_down": moe_w_down,
        "ln_mix_g": ln_mix_g, "ln_mix_b": ln_mix_b, "ln_ffn_g": ln_ffn_g, "ln_ffn_b": ln_ffn_b,
    }


def reference(x, rel_bias, s5_w_in, s5_a_re, s5_a_im, s5_log_dt, s5_b_re, s5_b_im, s5_c_re, s5_c_im,
              s5_d, s5_w_glu, s5_w_out, dsa_w_in, dsa_q_norm, dsa_kv_norm, dsa_w_uq, dsa_w_qidx,
              dsa_w_uk, dsa_w_uv, dsa_w_out, moe_w_group, moe_b_group, moe_w_expert, moe_b_expert,
              moe_w_gate, moe_w_up, moe_w_down, ln_mix_g, ln_mix_b, ln_ffn_g, ln_ffn_b):
    h = x
    for i in range(DEPTH):
        j = i // 2
        if i % 2 == 0:
            mix = _s5_mixer(h, s5_w_in[j], s5_a_re[j], s5_a_im[j], s5_log_dt[j], s5_b_re[j], s5_b_im[j],
                            s5_c_re[j], s5_c_im[j], s5_d[j], s5_w_glu[j], s5_w_out[j])
        else:
            mix = _dsa_mixer(h, rel_bias, dsa_w_in[j], dsa_q_norm[j], dsa_kv_norm[j], dsa_w_uq[j],
                             dsa_w_qidx[j], dsa_w_uk[j], dsa_w_uv[j], dsa_w_out[j])
        h = _layer_norm(DN_ALPHA * h + mix, ln_mix_g[i], ln_mix_b[i])
        ffn = _hier_moe(h, moe_w_group[i], moe_b_group[i], moe_w_expert[i], moe_b_expert[i],
                        moe_w_gate[i], moe_w_up[i], moe_w_down[i])
        h = _layer_norm(DN_ALPHA * h + ffn, ln_ffn_g[i], ln_ffn_b[i])
    return h
```

```cpp
#include <hip/hip_runtime.h>
#include <cstdio>
#include <cstdint>
#include <cstddef>


#ifndef MK_PHMASK
#define MK_PHMASK 0xffffffffu
#endif
#define PON(k) (((MK_PHMASK) >> (k)) & 1u)
#ifndef MK_REPEAT
#define MK_REPEAT 0u
#endif
#define PREP(k) (((MK_REPEAT) >> (k)) & 1u)
#define LAS __attribute__((address_space(3)))
#define GAS __attribute__((address_space(1)))
typedef unsigned short bf16_t;
typedef short bf16x8 __attribute__((ext_vector_type(8)));
typedef float f32x4 __attribute__((ext_vector_type(4)));
typedef float f32x2 __attribute__((ext_vector_type(2)));
typedef unsigned u32x4 __attribute__((ext_vector_type(4)));
typedef unsigned u32x2 __attribute__((ext_vector_type(2)));
typedef GAS unsigned gu32;

constexpr int NB = 8, SEQ = 2048, T = NB * SEQ, D = 2048, DEPTH = 4;
constexpr int S5G = 128, S5P = 16, S5N = 64;
constexpr int NH = 16, HD = 128, QL = 512, KVL = 512, IDXD = 128, TOPK = 256;
constexpr int DSA_IN = QL + KVL + IDXD + NH;
constexpr int DSA_IN_PAD = 1280;
constexpr int NE = 32, EPG = 8, NG = 4, FF = 256;
constexpr float LN_EPS = 1e-5f, RMS_EPS = 1e-6f;
constexpr float DN_ALPHA = 1.6817928305074290f;
constexpr int MAXPOS = 40960;

constexpr size_t MiB = 1u << 20;
constexpr size_t WS_CTL = 0, CTL_ZERO_BYTES = 1 * MiB;
constexpr size_t WS_RT = 1 * MiB;
constexpr size_t WS_S5C = 2 * MiB;
constexpr size_t WS_LIST = 4 * MiB;
constexpr size_t WS_GWL = 6 * MiB;
constexpr size_t WS_TPOS = 8 * MiB;
constexpr size_t WS_GPOS = 9 * MiB;
constexpr size_t WS_WIDX = 10 * MiB;
constexpr size_t WS_KIDX = 12 * MiB;
constexpr size_t WS_SEL = 16 * MiB;
constexpr size_t WS_CQ = 24 * MiB;
constexpr size_t WS_CKV = 40 * MiB;
constexpr size_t WS_WMIX = 56 * MiB;
constexpr size_t WS_WMOE = 88 * MiB;
constexpr size_t WS_H32 = 184 * MiB;
constexpr size_t WS_H16 = 312 * MiB;
constexpr size_t WS_S = 376 * MiB;
constexpr size_t WS_S5T = 888 * MiB;
constexpr size_t S5T_FD = 0, S5T_WS = 2 * MiB, S5T_WY = 10 * MiB, S5T_A16 = 18 * MiB;
constexpr size_t WS_END = 908 * MiB;
constexpr size_t WM_S5_IN = 0, WM_S5_GLU = 8 * MiB, WM_S5_OUT = 16 * MiB;
constexpr size_t WM_D_IN = 0  , WM_D_Q = 6 * MiB  , WM_D_UK = 10 * MiB  , WM_D_UV = 14 * MiB  , WM_D_OUT = 18 * MiB  ;
constexpr size_t WE_GU = 0, WE_DN = 64 * MiB;
constexpr size_t S_U16 = 0, S_Z16 = 64 * MiB, S_ZZ16 = 128 * MiB;
constexpr size_t S_QLAT = 0, S_O16 = 0, S_Q16 = 256 * MiB, S_QIDX = 320 * MiB, S_INDEX = 384 * MiB, S_OLAT = 256 * MiB;
constexpr size_t S_XS = 0, S_HMID = 160 * MiB, S_Y0 = 192 * MiB, S_Y1 = 256 * MiB, S_H16LO = 320 * MiB;
constexpr int CW_TMO = 0, CW_CODE = 1, CW_BAR = 4096, CW_CNT = 16384, CW_DEP = 65536;

constexpr int RING_BYTES = 131072;
constexpr int LDSCTL_OFF = 159744, MISC_OFF = LDSCTL_OFF + 320;
constexpr int MOETAB_OFF = LDSCTL_OFF + 1024;
constexpr int LDS_BYTES = 163840;

#define RLX_AGENT __ATOMIC_RELAXED, __HIP_MEMORY_SCOPE_AGENT
#define LDS_WAIT() asm volatile("s_waitcnt lgkmcnt(0)" ::: "memory")
#define VM_WAIT() asm volatile("s_waitcnt vmcnt(0)" ::: "memory")

__device__ __forceinline__ unsigned f2bf(float f) { unsigned u = __builtin_bit_cast(unsigned, f); return (u + 0x7fffu + ((u >> 16) & 1u)) >> 16; }
__device__ __forceinline__ unsigned pk2(float lo, float hi) { return f2bf(lo) | (f2bf(hi) << 16); }
__device__ __forceinline__ float bf2f(unsigned b) { return __builtin_bit_cast(float, b << 16); }
__device__ __forceinline__ float bflo(unsigned w) { return __builtin_bit_cast(float, w << 16); }
__device__ __forceinline__ float bfhi(unsigned w) { return __builtin_bit_cast(float, w & 0xffff0000u); }
__device__ __forceinline__ int shx_i(int v, int o, int lane) { return __builtin_amdgcn_ds_bpermute((lane ^ o) << 2, v); }
__device__ __forceinline__ float shx(float v, int o, int lane) { return __builtin_bit_cast(float, __builtin_amdgcn_ds_bpermute((lane ^ o) << 2, __builtin_bit_cast(int, v))); }
#define DPP_F(x, ctrl) __builtin_bit_cast(float, __builtin_amdgcn_update_dpp(0, __builtin_bit_cast(int, (x)), (ctrl), 0xf, 0xf, false))
__device__ __forceinline__ float wave_sum(float v, int lane) {
    (void)lane;
    float t = v;
    t += DPP_F(t, 0xB1);
    t += DPP_F(t, 0x4E);
    t += DPP_F(t, 0x141);
    t += DPP_F(t, 0x140);
    const float s0 = __builtin_bit_cast(float, __builtin_amdgcn_readlane(__builtin_bit_cast(int, t), 0)), s1 = __builtin_bit_cast(float, __builtin_amdgcn_readlane(__builtin_bit_cast(int, t), 16));
    const float s2 = __builtin_bit_cast(float, __builtin_amdgcn_readlane(__builtin_bit_cast(int, t), 32)), s3 = __builtin_bit_cast(float, __builtin_amdgcn_readlane(__builtin_bit_cast(int, t), 48));
    return (s0 + s1) + (s2 + s3);
}
__device__ __forceinline__ float wave_max(float v, int lane) {
#pragma unroll
    for (int o = 1; o < 64; o <<= 1) v = fmaxf(v, shx(v, o, lane));
    return v;
}

namespace pg8 {
constexpr int BM = 256, BK = 64, HALF = 128, HTB = HALF * BK * 2, STAGE_BYTES = 8 * HTB, NXCD = 8, WGM = 8;
__host__ __device__ __forceinline__ int lds_byte(int r, int c) { const int st = (r >> 4) * 2 + (c >> 5), rr = r & 15, cc = c & 31, ob = rr * 64 + cc * 2; return st * 1024 + (ob ^ (((ob >> 9) & 1) << 5)); }
__host__ __device__ __forceinline__ void stage_rc(int b, int& R, int& C) { const int st = b / 1024, sb = b % 1024, swz = sb ^ (((sb >> 9) & 1) << 5); R = (st >> 1) * 16 + swz / 64; C = (st & 1) * 32 + (swz % 64) / 2; }
__host__ __device__ __forceinline__ int perm32(int rho) { const int n = rho >> 4, i = rho & 15; return 8 * (i >> 2) + 4 * n + (i & 3); }

struct Unit { int pm, pn, pb; };
struct Gemm { const bf16_t* A; const bf16_t* Bt; int lda, ldb, K; long long sA, sB; };

struct SchedGrid {
    int nM, nN, nB, G, c;
    __device__ __forceinline__ bool next(int i, Unit& u) const { return unit((long)i * G + c, u); }
    __device__ __forceinline__ bool unit(long L, Unit& u) const {
        const int per = nM * nN, nwg = per * nB; if (L >= nwg) return false;
        int wgid = (int)L; { const int q = nwg / NXCD, r = nwg % NXCD, xcd = wgid % NXCD, off = wgid / NXCD; wgid = (xcd < r ? xcd * (q + 1) : r * (q + 1) + (xcd - r) * q) + off; }
        u.pb = wgid / per; const int w = wgid % per;
        const int nig = WGM * nN, gid = w / nig, fm = gid * WGM, gsz = (nM - fm) < WGM ? (nM - fm) : WGM;
        u.pm = fm + ((w % nig) % gsz); u.pn = (w % nig) / gsz; return true;
    }
};
struct SchedGridSplit {
    SchedGrid base; int thr, KA;
    __device__ __forceinline__ bool next(int i, Unit& u) const {
        const int G = base.G, c = base.c, U2 = base.nM * base.nN * base.nB, nl = G - thr;
        const int NA = (KA * nl < U2) ? KA * nl : U2;
        long L;
        if (c >= thr) { const int q = c - thr; const int ra = q < NA ? (NA - q + nl - 1) / nl : 0;
            L = i < ra ? (long)q + (long)i * nl : (long)NA + c + (long)(i - ra) * G; }
        else L = (long)NA + c + (long)i * G;
        return base.unit(L, u);
    }
};
struct SchedMoe {
    const LAS int* tab; int sh  , G, c;
    __device__ __forceinline__ bool next(int i, Unit& u) const {
        const int nmt = __builtin_amdgcn_readfirstlane(tab[0]); const long L = (long)i * G + c; if (L >= ((long)nmt << sh)) return false;
        const int mt = (int)(L >> sh); u.pm = mt; u.pn = (int)(L & ((1 << sh) - 1)); u.pb = __builtin_amdgcn_readfirstlane((int)((const LAS unsigned char*)(tab + 66))[mt]); return true;
    }
};

struct SchedMoe2 {
    const LAS int* tab; unsigned* dep; int G, c;
    static constexpr int KA = 4;
    __device__ __forceinline__ bool next(int i, Unit& u) const {
        const int nmt = __builtin_amdgcn_readfirstlane(tab[0]); const int U1 = nmt << 1, U2 = nmt << 3;
        const int maxu = (U1 + G - 1) / G, thr = U1 - G * (maxu - 1), nl = G - thr;
        const int NA = (KA * nl < U2) ? KA * nl : U2;
        long L;
        if (c >= thr) { const int q = c - thr; const int ra = q < NA ? (NA - q + nl - 1) / nl : 0;
            L = i < ra ? (long)q + (long)i * nl : (long)NA + c + (long)(i - ra) * G; }
        else L = (long)NA + c + (long)i * G;
        if (L >= U2) return false;
        const int mt = (int)(L >> 3); u.pm = mt; u.pn = (int)(L & 7); u.pb = __builtin_amdgcn_readfirstlane((int)((const LAS unsigned char*)(tab + 66))[mt]);
        unsigned sp = 0u;
        while (__hip_atomic_load(dep + 16 * mt, __ATOMIC_RELAXED, __HIP_MEMORY_SCOPE_AGENT) < 2u) { __builtin_amdgcn_s_sleep(2); if (++sp > (1u << 20)) break; }
        asm volatile("" ::: "memory");
        return true;
    }
};

__device__ __forceinline__ unsigned cvt_pk_bf16(float lo, float hi) { unsigned r; asm volatile("v_cvt_pk_bf16_f32 %0, %1, %2" : "=v"(r) : "v"(lo), "v"(hi)); return r; }

struct EpiStoreBf16 {
    static constexpr bool PERM = true; static constexpr bool SIGNAL = false;
    bf16_t* O; int ldc; int bcol; int split_cols; size_t split_stride;
    __device__ __forceinline__ void operator()(const f32x4 (&acc)[2][2][4][2], const Unit& u, int wr, int wc, int fr, int fq) const {
        const int row0 = u.pm * BM + wr * 64 + fr; int colt = u.pn * BM; bf16_t* base = O + (size_t)u.pb * bcol;
        if (split_cols) { const int t = colt / split_cols; base += (size_t)t * split_stride; colt -= t * split_cols; }
        const int col0 = colt + wc * 32 + 8 * fq;
#pragma unroll
        for (int ai = 0; ai < 2; ++ai)
#pragma unroll
            for (int m = 0; m < 4; ++m) { bf16_t* rowp = base + (size_t)(row0 + ai * HALF + m * 16) * ldc + col0;
#pragma unroll
                for (int bj = 0; bj < 2; ++bj) { const f32x4 v0 = acc[ai][bj][m][0], v1 = acc[ai][bj][m][1];
                    u32x4 w; w.x = cvt_pk_bf16(v0[0], v0[1]); w.y = cvt_pk_bf16(v0[2], v0[3]); w.z = cvt_pk_bf16(v1[0], v1[1]); w.w = cvt_pk_bf16(v1[2], v1[3]);
                    *(u32x4*)(rowp + bj * HALF) = w; } }
    }
};
struct EpiStoreFp8 {
    static constexpr bool PERM = true; static constexpr bool SIGNAL = false;
    unsigned char* O; int ldc; int bcol;
    __device__ __forceinline__ void operator()(const f32x4 (&acc)[2][2][4][2], const Unit& u, int wr, int wc, int fr, int fq) const {
        const int row0 = u.pm * BM + wr * 64 + fr; unsigned char* base = O + (size_t)u.pb * bcol;
        const int col0 = u.pn * BM + wc * 32 + 8 * fq;
#pragma unroll
        for (int ai = 0; ai < 2; ++ai)
#pragma unroll
            for (int m = 0; m < 4; ++m) { unsigned char* rowp = base + (size_t)(row0 + ai * HALF + m * 16) * ldc + col0;
#pragma unroll
                for (int bj = 0; bj < 2; ++bj) { const f32x4 v0 = acc[ai][bj][m][0] * 16.0f, v1 = acc[ai][bj][m][1] * 16.0f;
                    int p0 = __builtin_amdgcn_cvt_pk_fp8_f32(v0[0], v0[1], 0, false); p0 = __builtin_amdgcn_cvt_pk_fp8_f32(v0[2], v0[3], p0, true);
                    int p1 = __builtin_amdgcn_cvt_pk_fp8_f32(v1[0], v1[1], 0, false); p1 = __builtin_amdgcn_cvt_pk_fp8_f32(v1[2], v1[3], p1, true);
                    u32x2 w; w.x = (unsigned)p0; w.y = (unsigned)p1; *(u32x2*)(rowp + bj * HALF) = w; } }
    }
};
struct EpiGlu {
    static constexpr bool PERM = true; static constexpr bool SIGNAL = false;
    const bf16_t* Z; bf16_t* O; int ldc;
    __device__ __forceinline__ void operator()(const f32x4 (&acc)[2][2][4][2], const Unit& u, int wr, int wc, int fr, int fq) const {
        const int row0 = u.pm * BM + wr * 64 + fr, col0 = u.pn * BM + wc * 32 + 8 * fq;
        u32x4 zv[2][4][2];
#pragma unroll
        for (int ai = 0; ai < 2; ++ai)
#pragma unroll
            for (int m = 0; m < 4; ++m)
#pragma unroll
                for (int bj = 0; bj < 2; ++bj) zv[ai][m][bj] = *(const u32x4*)(Z + (size_t)(row0 + ai * HALF + m * 16) * ldc + col0 + bj * HALF);
        __builtin_amdgcn_sched_barrier(0);
#pragma unroll
        for (int ai = 0; ai < 2; ++ai) {
#pragma unroll
            for (int m = 0; m < 4; ++m) { const size_t ro = (size_t)(row0 + ai * HALF + m * 16) * ldc + col0;
#pragma unroll
                for (int bj = 0; bj < 2; ++bj) { const f32x4 v0 = acc[ai][bj][m][0], v1 = acc[ai][bj][m][1];
                    const u32x4 z = zv[ai][m][bj];
                    float r[8]; const float a[8] = {v0[0], v0[1], v0[2], v0[3], v1[0], v1[1], v1[2], v1[3]};
                    const float zz[8] = {bflo(z.x), bfhi(z.x), bflo(z.y), bfhi(z.y), bflo(z.z), bfhi(z.z), bflo(z.w), bfhi(z.w)};
#pragma unroll
                    for (int j = 0; j < 8; ++j) r[j] = zz[j] / (1.0f + __expf(-a[j]));
                    u32x4 w; w.x = cvt_pk_bf16(r[0], r[1]); w.y = cvt_pk_bf16(r[2], r[3]); w.z = cvt_pk_bf16(r[4], r[5]); w.w = cvt_pk_bf16(r[6], r[7]);
                    *(u32x4*)(O + ro + bj * HALF) = w; } }
            __builtin_amdgcn_sched_barrier(0);
        }
    }
};
struct EpiResid {
    static constexpr bool PERM = true; static constexpr bool SIGNAL = false;
    bf16_t* H; int ldc; float alpha;
    __device__ __forceinline__ void operator()(const f32x4 (&acc)[2][2][4][2], const Unit& u, int wr, int wc, int fr, int fq) const {
        const int row0 = u.pm * BM + wr * 64 + fr, col0 = u.pn * BM + wc * 32 + 8 * fq;
        u32x4 hv[2][4][2];
#pragma unroll
        for (int ai = 0; ai < 2; ++ai)
#pragma unroll
            for (int m = 0; m < 4; ++m)
#pragma unroll
                for (int bj = 0; bj < 2; ++bj) hv[ai][m][bj] = *(const u32x4*)(H + (size_t)(row0 + ai * HALF + m * 16) * ldc + col0 + bj * HALF);
        __builtin_amdgcn_sched_barrier(0);
#pragma unroll
        for (int ai = 0; ai < 2; ++ai) {
#pragma unroll
            for (int m = 0; m < 4; ++m) { bf16_t* rowp = H + (size_t)(row0 + ai * HALF + m * 16) * ldc + col0;
#pragma unroll
                for (int bj = 0; bj < 2; ++bj) { const f32x4 v0 = acc[ai][bj][m][0], v1 = acc[ai][bj][m][1]; const u32x4 h = hv[ai][m][bj];
                    u32x4 w; w.x = cvt_pk_bf16(bflo(h.x) * alpha + v0[0], bfhi(h.x) * alpha + v0[1]); w.y = cvt_pk_bf16(bflo(h.y) * alpha + v0[2], bfhi(h.y) * alpha + v0[3]);
                    w.z = cvt_pk_bf16(bflo(h.z) * alpha + v1[0], bfhi(h.z) * alpha + v1[1]); w.w = cvt_pk_bf16(bflo(h.w) * alpha + v1[2], bfhi(h.w) * alpha + v1[3]);
                    *(u32x4*)(rowp + bj * HALF) = w; } }
            __builtin_amdgcn_sched_barrier(0);
        }
    }
};
struct EpiDsaIn {
    static constexpr bool PERM = true; static constexpr bool SIGNAL = false;
    bf16_t* CQ; bf16_t* CKV; bf16_t* KIDX; float* WIDX; int pn0;
    __device__ __forceinline__ void operator()(const f32x4 (&acc)[2][2][4][2], const Unit& u0, int wr, int wc, int fr, int fq) const {
        Unit u = u0; u.pn += pn0;
        const int row0 = u.pm * BM + wr * 64 + fr, cb = wc * 32 + 8 * fq;
#pragma unroll
        for (int ai = 0; ai < 2; ++ai)
#pragma unroll
            for (int m = 0; m < 4; ++m) { const size_t row = (size_t)(row0 + ai * HALF + m * 16);
#pragma unroll
                for (int bj = 0; bj < 2; ++bj) { const f32x4 v0 = acc[ai][bj][m][0], v1 = acc[ai][bj][m][1];
                    u32x4 w; w.x = cvt_pk_bf16(v0[0], v0[1]); w.y = cvt_pk_bf16(v0[2], v0[3]); w.z = cvt_pk_bf16(v1[0], v1[1]); w.w = cvt_pk_bf16(v1[2], v1[3]);
                    if (u.pn < 2) *(u32x4*)(CQ + row * 512 + u.pn * 256 + bj * HALF + cb) = w;
                    else if (u.pn < 4) *(u32x4*)(CKV + row * 512 + (u.pn - 2) * 256 + bj * HALF + cb) = w;
                    else if (bj == 0) *(u32x4*)(KIDX + row * 128 + cb) = w;
                    else if (cb < 16) { *(f32x4*)(WIDX + row * 16 + cb) = v0 * 0.25f; *(f32x4*)(WIDX + row * 16 + cb + 4) = v1 * 0.25f; } } }
    }
};
struct EpiMoe1 {
    static constexpr bool PERM = true; static constexpr bool SIGNAL = true;
    bf16_t* HM; const float* GWL; const LAS int* tab; unsigned* dep;
    __device__ __forceinline__ void operator()(const f32x4 (&acc)[2][2][4][2], const Unit& u, int wr, int wc, int fr, int fq) const {
        const int row0 = u.pm * BM + wr * 64 + fr, cb = u.pn * 128 + wc * 32 + 8 * fq;
        const int poff = tab[1 + u.pb], cnt = tab[34 + u.pb];
        float gwv[2][4];
#pragma unroll
        for (int ai = 0; ai < 2; ++ai)
#pragma unroll
            for (int m = 0; m < 4; ++m) { const int slot = row0 + ai * HALF + m * 16 - poff; gwv[ai][m] = slot < cnt ? GWL[(size_t)u.pb * T + slot] : 0.f; }
        __builtin_amdgcn_sched_barrier(0);
#pragma unroll
        for (int ai = 0; ai < 2; ++ai)
#pragma unroll
            for (int m = 0; m < 4; ++m) { const int pos = row0 + ai * HALF + m * 16; const float gw = gwv[ai][m];
                const f32x4 g0 = acc[ai][0][m][0], g1 = acc[ai][0][m][1], u0 = acc[ai][1][m][0], u1 = acc[ai][1][m][1];
                const float g[8] = {g0[0], g0[1], g0[2], g0[3], g1[0], g1[1], g1[2], g1[3]}, uu[8] = {u0[0], u0[1], u0[2], u0[3], u1[0], u1[1], u1[2], u1[3]}; float r[8];
#pragma unroll
                for (int j = 0; j < 8; ++j) r[j] = g[j] / (1.0f + __expf(-g[j])) * uu[j] * gw;
                u32x4 w; w.x = cvt_pk_bf16(r[0], r[1]); w.y = cvt_pk_bf16(r[2], r[3]); w.z = cvt_pk_bf16(r[4], r[5]); w.w = cvt_pk_bf16(r[6], r[7]);
                *(u32x4*)(HM + (size_t)pos * 256 + cb) = w; }
    }
};
struct EpiMoe2 {
    static constexpr bool PERM = true; static constexpr bool SIGNAL = false;
    unsigned char* Y0; unsigned char* Y1; const unsigned* LIST; const LAS int* tab;
    __device__ __forceinline__ void operator()(const f32x4 (&acc)[2][2][4][2], const Unit& u, int wr, int wc, int fr, int fq) const {
        const int row0 = u.pm * BM + wr * 64 + fr, col0 = u.pn * BM + wc * 32 + 8 * fq;
        const int poff = tab[1 + u.pb], cnt = tab[34 + u.pb];
        unsigned tkv2[2][4];
#pragma unroll
        for (int ai = 0; ai < 2; ++ai)
#pragma unroll
          for (int m = 0; m < 4; ++m) { const int slot = row0 + ai * HALF + m * 16 - poff; tkv2[ai][m] = slot < cnt ? LIST[(size_t)u.pb * T + slot] : 0xffffffffu; }
        __builtin_amdgcn_sched_barrier(0);
#pragma unroll
        for (int ai = 0; ai < 2; ++ai) {
#pragma unroll
            for (int m = 0; m < 4; ++m) { const unsigned tk = tkv2[ai][m];
                if (tk != 0xffffffffu) { unsigned char* rowp = ((tk >> 31) ? Y1 : Y0) + (size_t)(tk & 0x7fffffffu) * D + col0;
#pragma unroll
                    for (int bj = 0; bj < 2; ++bj) { const f32x4 v0 = acc[ai][bj][m][0] * 16.0f, v1 = acc[ai][bj][m][1] * 16.0f;
                        int p0 = __builtin_amdgcn_cvt_pk_fp8_f32(v0[0], v0[1], 0, false); p0 = __builtin_amdgcn_cvt_pk_fp8_f32(v0[2], v0[3], p0, true);
                        int p1 = __builtin_amdgcn_cvt_pk_fp8_f32(v1[0], v1[1], 0, false); p1 = __builtin_amdgcn_cvt_pk_fp8_f32(v1[2], v1[3], p1, true);
                        u32x2 w; w.x = (unsigned)p0; w.y = (unsigned)p1; *(u32x2*)(rowp + bj * HALF) = w; } } }
        }
    }
};

template <class Epi, class Sched, bool GATHER = false>
__device__ __forceinline__ void gemm_phase(LAS unsigned char* lds, const Gemm g, const Sched& S, const Epi& E, int wid, int lane, const LAS int* gtok = nullptr) {
    const int tid = wid * 64 + lane, wr = wid >> 2, wc = wid & 3, fr = lane & 15, fq = lane >> 4;
    const int K = g.K, nt = K / BK;
    unsigned voffA[2], voffB[2];
#pragma unroll
    for (int i = 0; i < 2; ++i) { int R, C; stage_rc(tid * 16 + i * 8192, R, C); const int Rb = Epi::PERM ? ((R & ~31) + perm32(R & 31)) : R;
        voffA[i] = GATHER ? (unsigned)(R * 65536 + C * 2) : (unsigned)(R * g.lda + C) * 2u; voffB[i] = (unsigned)(Rb * g.ldb + C) * 2u; }
    const size_t kstep = (size_t)(BK * 2);
    const size_t hstepA = GATHER ? 0 : (size_t)HALF * g.lda * 2, hstepB = (size_t)HALF * g.ldb * 2;
    unsigned vc[2][2], vn[2][2];
#define PG8_GTOK(dst, ui_) do { _Pragma("unroll") for (int h_ = 0; h_ < 2; ++h_) _Pragma("unroll") for (int i_ = 0; i_ < 2; ++i_) \
        dst[h_][i_] = (unsigned)gtok[(ui_) * 256 + h_ * HALF + (int)(voffA[i_] >> 16)] * (unsigned)(g.lda * 2) + (voffA[i_] & 0xffffu); } while (0)
    const unsigned ldsw = (unsigned)wid * 1024u;
    const int aoff = lds_byte(wr * 64 + fr, fq * 8), boff = lds_byte(wc * 32 + fr, fq * 8);
#define PG8_SA(b, h) (((b) * 2 + (h)) * HTB)
#define PG8_SB(b, h) ((4 + (b) * 2 + (h)) * HTB)
#define PG8_STAGE(bufoff, gbase, voff) do { _Pragma("unroll") for (int _i = 0; _i < 2; ++_i) \
        __builtin_amdgcn_global_load_lds((const unsigned*)((const char*)(gbase) + (voff)[_i]), (LAS unsigned*)(lds + (bufoff) + ldsw + _i * 8192), 16, 0, 0); } while (0)
#define PG8_LDA(dst, b, h) do { _Pragma("unroll") for (int m = 0; m < 4; ++m) _Pragma("unroll") for (int k = 0; k < 2; ++k) dst[m][k] = *(const LAS bf16x8*)(lds + PG8_SA(b, h) + aoff + m * 2048 + k * 1024); } while (0)
#define PG8_LDB(dst, b, h) do { _Pragma("unroll") for (int n = 0; n < 2; ++n) _Pragma("unroll") for (int k = 0; k < 2; ++k) dst[n][k] = *(const LAS bf16x8*)(lds + PG8_SB(b, h) + boff + n * 2048 + k * 1024); } while (0)
#define PG8_MMA(ai, bj, At, Bt) do { __builtin_amdgcn_s_setprio(1); _Pragma("unroll") for (int m = 0; m < 4; ++m) _Pragma("unroll") for (int n = 0; n < 2; ++n) _Pragma("unroll") for (int k = 0; k < 2; ++k) \
        acc[ai][bj][m][n] = __builtin_amdgcn_mfma_f32_16x16x32_bf16(Bt[n][k], At[m][k], acc[ai][bj][m][n], 0, 0, 0); __builtin_amdgcn_s_setprio(0); } while (0)
#define PG8_WAIT_V(n) asm volatile("s_waitcnt vmcnt(" #n ")" ::: "memory")
#define PG8_WAIT_L(n) asm volatile("s_waitcnt lgkmcnt(" #n ")" ::: "memory")
#define PG8_BAR __builtin_amdgcn_s_barrier()
#define PG8_SCHED __builtin_amdgcn_sched_barrier(0)
#define PG8_TA(u) (GATHER ? (const char*)g.A : (const char*)g.A + ((size_t)(u).pb * (size_t)g.sA + (size_t)(u).pm * BM * (size_t)g.lda) * 2)
#define PG8_STAGE_A(bufoff, gbase, h, nx) do { if constexpr (GATHER) { unsigned vo_[2] = {(nx) ? vn[h][0] : vc[h][0], (nx) ? vn[h][1] : vc[h][1]}; PG8_STAGE(bufoff, gbase, vo_); } else { PG8_STAGE(bufoff, (gbase) + (h) * hstepA, voffA); } } while (0)
#define PG8_TB(u) ((const char*)g.Bt + ((size_t)(u).pb * (size_t)g.sB + (size_t)(u).pn * BM * (size_t)g.ldb) * 2)
    Unit cur, nxt; int ui = 0;
    if (!S.next(0, cur)) return;
    f32x4 acc[2][2][4][2];
#pragma unroll
    for (int a = 0; a < 2; ++a)
#pragma unroll
        for (int b = 0; b < 2; ++b)
#pragma unroll
            for (int m = 0; m < 4; ++m)
#pragma unroll
                for (int n = 0; n < 2; ++n) acc[a][b][m][n] = (f32x4){0.f, 0.f, 0.f, 0.f};
    bf16x8 At[4][2], B0[2][2], B1[2][2];
    const char* cA = PG8_TA(cur); const char* cB = PG8_TB(cur);
    if constexpr (GATHER) { PG8_GTOK(vc, 0); PG8_GTOK(vn, 0); }
    PG8_STAGE(PG8_SB(0, 0), cB, voffB); PG8_STAGE(PG8_SB(0, 1), cB + hstepB, voffB); PG8_STAGE_A(PG8_SA(0, 0), cA, 0, false); PG8_STAGE_A(PG8_SA(0, 1), cA, 1, false);
    if (wr == 1) PG8_BAR;
    PG8_WAIT_V(2); PG8_BAR;
    PG8_STAGE(PG8_SB(1, 0), cB + kstep, voffB); PG8_STAGE_A(PG8_SA(1, 0), cA + kstep, 0, false); PG8_STAGE(PG8_SB(1, 1), cB + hstepB + kstep, voffB);
    PG8_WAIT_V(6); PG8_BAR;
    for (;;) {
        const bool has_next = S.next(ui + 1, nxt);
        const char* nA = has_next ? PG8_TA(nxt) : cA; const char* nB = has_next ? PG8_TB(nxt) : cB;
        for (int t = 0; t < nt; t += 2) {
            const bool last = (t == nt - 2);
            const char* a1 = cA + (size_t)(t + 1) * kstep;
            const char* a2 = last ? nA : cA + (size_t)(t + 2) * kstep; const char* b2 = last ? nB : cB + (size_t)(t + 2) * kstep;
            const char* a3 = a2 + kstep; const char* b3 = b2 + kstep;
            if constexpr (GATHER) { if (last && has_next) PG8_GTOK(vn, ui + 1); }
            PG8_LDB(B0, 0, 0); PG8_LDB(B1, 0, 1); PG8_SCHED; PG8_LDA(At, 0, 0); PG8_STAGE_A(PG8_SA(1, 1), a1, 1, false);
            PG8_WAIT_V(8); PG8_WAIT_L(0); PG8_BAR; PG8_MMA(0, 0, At, B0); PG8_MMA(0, 1, At, B1); PG8_BAR; PG8_SCHED;
            PG8_LDA(At, 0, 1); PG8_STAGE(PG8_SB(0, 0), b2, voffB); PG8_STAGE(PG8_SB(0, 1), b2 + hstepB, voffB); PG8_STAGE_A(PG8_SA(0, 0), a2, 0, last);
            PG8_WAIT_V(8); PG8_WAIT_L(0); PG8_BAR; PG8_MMA(1, 0, At, B0); PG8_MMA(1, 1, At, B1); PG8_BAR; PG8_SCHED;
            PG8_LDB(B0, 1, 0); PG8_LDB(B1, 1, 1); PG8_SCHED; PG8_LDA(At, 1, 0); PG8_STAGE_A(PG8_SA(0, 1), a2, 1, last);
            PG8_WAIT_V(8); PG8_WAIT_L(0); PG8_BAR; PG8_MMA(0, 0, At, B0); PG8_MMA(0, 1, At, B1); PG8_BAR; PG8_SCHED;
            PG8_LDA(At, 1, 1); PG8_STAGE(PG8_SB(1, 0), b3, voffB); PG8_STAGE(PG8_SB(1, 1), b3 + hstepB, voffB); PG8_STAGE_A(PG8_SA(1, 0), a3, 0, last);
            PG8_WAIT_V(8); PG8_WAIT_L(0); PG8_BAR; PG8_MMA(1, 0, At, B0); PG8_MMA(1, 1, At, B1); PG8_BAR; PG8_SCHED;
        }
        if (wr == 0) PG8_BAR;
        { int l2_; asm volatile("v_mbcnt_lo_u32_b32 %0, -1, 0\n\tv_mbcnt_hi_u32_b32 %0, -1, %0" : "=v"(l2_)); E(acc, cur, wr, wc, l2_ & 15, l2_ >> 4);
          if constexpr (Epi::SIGNAL) { PG8_WAIT_V(0); PG8_BAR;
              if (wid == 0 && l2_ == 0) { __builtin_amdgcn_fence(__ATOMIC_RELEASE, "agent"); (void)__hip_atomic_fetch_add(E.dep + 16 * cur.pm, 1u, __ATOMIC_RELAXED, __HIP_MEMORY_SCOPE_AGENT); } } }
        if (!has_next) break;
#pragma unroll
        for (int a = 0; a < 2; ++a)
#pragma unroll
            for (int b = 0; b < 2; ++b)
#pragma unroll
                for (int m = 0; m < 4; ++m)
#pragma unroll
                    for (int n = 0; n < 2; ++n) acc[a][b][m][n] = (f32x4){0.f, 0.f, 0.f, 0.f};
        cur = nxt; cA = nA; cB = nB; ++ui;
        if constexpr (GATHER) { _Pragma("unroll") for (int h_ = 0; h_ < 2; ++h_) _Pragma("unroll") for (int i_ = 0; i_ < 2; ++i_) vc[h_][i_] = vn[h_][i_]; }
        if (wr == 1) PG8_BAR;
    }
    PG8_WAIT_V(0);
    PG8_BAR;
#undef PG8_SA
#undef PG8_SB
#undef PG8_STAGE
#undef PG8_LDA
#undef PG8_LDB
#undef PG8_MMA
#undef PG8_WAIT_V
#undef PG8_WAIT_L
#undef PG8_BAR
#undef PG8_SCHED
#undef PG8_TA
#undef PG8_STAGE_A
#undef PG8_GTOK
#undef PG8_TB
}
}

#define XB_TMO      128
#define XB_XCNT(j)  (256  + 64 * (j))
#define XB_XSUB(j)  (1280 + 64 * (j))
#define XB_XGEN(j)  (2304 + 64 * (j))
#define XB_TOP      3328
#define XB_TOPGEN   3392
#define XCD_BAR_WORDS 3456
#define XB_SPIN_CAP (1u << 18)
__device__ __forceinline__ unsigned xb_ld(unsigned* p)              { return __hip_atomic_load(p, __ATOMIC_RELAXED, __HIP_MEMORY_SCOPE_AGENT); }
__device__ __forceinline__ unsigned xb_add(unsigned* p, unsigned v) { return __hip_atomic_fetch_add(p, v, __ATOMIC_RELAXED, __HIP_MEMORY_SCOPE_AGENT); }
__device__ __forceinline__ unsigned xb_xcc_id() { return (unsigned)__builtin_amdgcn_s_getreg((3 << 11) | 20) & 0xFu; }
#define XB_SPIN(cond, bar) do { unsigned _sp = 0; while (cond) { __builtin_amdgcn_s_sleep(1); \
    if ((++_sp & 255u) == 0u) { if (xb_ld(&(bar)[XB_TMO])) break; if (_sp > XB_SPIN_CAP) { atomicAdd(&(bar)[XB_TMO], 1u); break; } } } } while (0)
struct XcdBarrier { unsigned* bar; unsigned x; volatile LAS unsigned* st; };
__device__ __forceinline__ XcdBarrier xcd_barrier_post(unsigned* bar, volatile LAS unsigned* st, int tid) {
    XcdBarrier b; b.bar = bar; b.x = xb_xcc_id(); b.st = st;
    if (tid == 0) (void)xb_add(&bar[XB_XCNT(b.x)], 1u);
    return b;
}
__device__ __forceinline__ void xcd_barrier_complete(unsigned* bar, unsigned x, unsigned& nloc, unsigned& nx) {
    const unsigned G = gridDim.x * gridDim.y * gridDim.z;
    unsigned sum, cnt, mine, sp = 0u;
    for (;;) {
        sum = 0u; cnt = 0u; mine = 0u;
#pragma unroll
        for (unsigned j = 0; j < 16; ++j) { const unsigned c = xb_ld(&bar[XB_XCNT(j)]); sum += c; cnt += (c > 0u) ? 1u : 0u; mine = (j == x) ? c : mine; }
        if (sum == G) break;
        __builtin_amdgcn_s_sleep(1);
        if ((++sp & 255u) == 0u) { if (xb_ld(&bar[XB_TMO])) break; if (sp > XB_SPIN_CAP) { atomicAdd(&bar[XB_TMO], 1u); break; } }
    }
    nloc = mine > 0u ? mine : 1u; nx = cnt > 0u ? cnt : 1u;
}
__device__ __forceinline__ void xcd_barrier(const XcdBarrier& b, int tid) {
    asm volatile("s_waitcnt vmcnt(0)" ::: "memory");
    __syncthreads();
    if (tid == 0) {
        unsigned* bar; { unsigned long long bb_ = (unsigned long long)b.bar; asm volatile("" : "+s"(bb_)); bar = (unsigned*)(GAS unsigned*)bb_; }
        __builtin_amdgcn_s_waitcnt(0);
        unsigned nloc = b.st[0], nx = b.st[1];
        if (nloc == 0u) { xcd_barrier_complete(bar, b.x, nloc, nx); b.st[0] = nloc; b.st[1] = nx; }
        const unsigned old = xb_add(&bar[XB_XSUB(b.x)], 1u);
        const unsigned gen = old / nloc;
        if (old + 1u == (gen + 1u) * nloc) {
            __builtin_amdgcn_fence(__ATOMIC_RELEASE, "agent");
            asm volatile("s_waitcnt vmcnt(0)" ::: "memory");
            const unsigned og = xb_add(&bar[XB_TOP], 1u);
            const unsigned tg = og / nx;
            if (og + 1u == (tg + 1u) * nx) xb_add(&bar[XB_TOPGEN], 1u);
            else XB_SPIN(xb_ld(&bar[XB_TOPGEN]) == tg, bar);
            __builtin_amdgcn_fence(__ATOMIC_ACQUIRE, "agent");
            asm volatile("s_waitcnt vmcnt(0)" ::: "memory");
        } else {
            XB_SPIN(xb_ld(&bar[XB_TOPGEN]) == gen, bar);
            __builtin_amdgcn_fence(__ATOMIC_ACQUIRE, "agent");
            asm volatile("s_waitcnt vmcnt(0)" ::: "memory");
        }
    }
    __syncthreads();
}

struct Args { const float* in[32]; float* out; unsigned char* ws; int ph_lo, ph_hi; };
struct Frame {
    LAS unsigned char* lds;
    volatile LAS unsigned* MISC;
    gu32* ctl;
    int tid, lane, wave, G, vcu, gw, NGW;
    unsigned char* ws;
};
enum { I_X = 0, I_RELB, I_S5_WIN, I_S5_ARE, I_S5_AIM, I_S5_LOGDT, I_S5_BRE, I_S5_BIM, I_S5_CRE, I_S5_CIM, I_S5_D, I_S5_WGLU, I_S5_WOUT,
       I_D_WIN, I_D_QN, I_D_KVN, I_D_WUQ, I_D_WQIDX, I_D_WUK, I_D_WUV, I_D_WOUT,
       I_M_WG, I_M_BG, I_M_WE, I_M_BE, I_M_WGATE, I_M_WUP, I_M_WDOWN, I_LNM_G, I_LNM_B, I_LNF_G, I_LNF_B };

__device__ __forceinline__ void tr_item(const float* src, int ldS, int nvalid, bf16_t* dst, int ldD, long zoff, bool zfill, LAS float* scr, int lane) {
    const int nn = lane & 31; const bool ok = nn < nvalid;
    const float* sp = src + (size_t)(lane >> 5) * ldS + nn; const size_t st2 = (size_t)2 * ldS;
#pragma unroll
    for (int hb = 0; hb < 2; ++hb) {
        float tv[16];
#pragma unroll
        for (int i = 0; i < 16; ++i) { tv[i] = ok ? *sp : 0.f; sp += st2; }
        __builtin_amdgcn_sched_barrier(0);
#pragma unroll
        for (int i = 0; i < 16; ++i) scr[(2 * (hb * 16 + i) + (lane >> 5)) * 33 + nn] = tv[i];
        __builtin_amdgcn_sched_barrier(0);
    }
    LDS_WAIT(); asm volatile("" ::: "memory");
    const int c = lane & 7;
#pragma unroll
    for (int j = 0; j < 4; ++j) { const int n = (lane >> 3) + 8 * j; const LAS float* s = scr + (8 * c) * 33 + n;
        u32x4 o; o.x = pk2(s[0 * 33], s[1 * 33]); o.y = pk2(s[2 * 33], s[3 * 33]); o.z = pk2(s[4 * 33], s[5 * 33]); o.w = pk2(s[6 * 33], s[7 * 33]);
        *(GAS u32x4*)(dst + (size_t)n * ldD + 8 * c) = o;
        if (zfill) *(GAS u32x4*)(dst + zoff + (size_t)n * ldD + 8 * c) = (u32x4){0u, 0u, 0u, 0u}; }
    LDS_WAIT(); asm volatile("" ::: "memory");
}

__device__ __forceinline__ void s5_tables(const Frame& F, const Args& a, int j) {
    unsigned char* ws = F.ws;
    LAS f32x2* PW = (LAS f32x2*)F.lds;
    LAS f32x2* BBs = PW + 17 * 64;
    LAS f32x2* Cs = BBs + 1024;
    LAS float* Ks = (LAS float*)(Cs + 1024);
    for (int item = F.vcu; item < 2 * S5G; item += F.G) {
        const int g = item >> 1, half = item & 1;
        __syncthreads();
        const float dt = expf(a.in[I_S5_LOGDT][j * S5G + g]);
        for (int idx = F.tid; idx < 17 * 64; idx += 512) { const int k = idx >> 6, n = idx & 63;
            const float are = fminf(a.in[I_S5_ARE][((size_t)j * S5G + g) * S5N + n], -1e-4f), aim = a.in[I_S5_AIM][((size_t)j * S5G + g) * S5N + n];
            const float x = are * dt * (float)k, y = aim * dt * (float)k; float sy, cy; sincosf(y, &sy, &cy); const float ex = expf(x);
            PW[idx] = (f32x2){ex * cy, ex * sy}; }
        for (int idx = F.tid; idx < 1024; idx += 512) { const int n = idx >> 4;
            const float are = fminf(a.in[I_S5_ARE][((size_t)j * S5G + g) * S5N + n], -1e-4f), aim = a.in[I_S5_AIM][((size_t)j * S5G + g) * S5N + n];
            const float x = are * dt, y = aim * dt; float sy, cy; sincosf(y, &sy, &cy); const float ex = expf(x), sh = sinf(0.5f * y);
            const float nr = expm1f(x) * cy - 2.0f * sh * sh, ni = ex * sy, den = are * are + aim * aim;
            const float cr = (nr * are + ni * aim) / den, ci = (ni * are - nr * aim) / den;
            const float br = a.in[I_S5_BRE][(((size_t)j * S5G + g) * S5N) * S5P + idx], bi = a.in[I_S5_BIM][(((size_t)j * S5G + g) * S5N) * S5P + idx];
            BBs[idx] = (f32x2){cr * br - ci * bi, cr * bi + ci * br}; }
        for (int idx = F.tid; idx < 1024; idx += 512) Cs[idx] = (f32x2){a.in[I_S5_CRE][((size_t)j * S5G + g) * S5P * S5N + idx], a.in[I_S5_CIM][((size_t)j * S5G + g) * S5P * S5N + idx]};
        __syncthreads();
        { const int lag = F.tid >> 5, p = (F.tid >> 1) & 15, qh = F.tid & 1; float kacc[8];
#pragma unroll
          for (int q = 0; q < 8; ++q) kacc[q] = 0.f;
#pragma unroll 4
          for (int n = 0; n < S5N; ++n) { const f32x2 c = Cs[p * 64 + n], w = PW[lag * 64 + n];
              const float tr = c.x * w.x - c.y * w.y, ti = c.x * w.y + c.y * w.x;
              const LAS f32x4* bq = (const LAS f32x4*)(BBs + n * 16 + qh * 8);
#pragma unroll
              for (int q2 = 0; q2 < 4; ++q2) { const f32x4 b2 = bq[q2]; kacc[2 * q2] += tr * b2[0] - ti * b2[1]; kacc[2 * q2 + 1] += tr * b2[2] - ti * b2[3]; } }
#pragma unroll
          for (int q = 0; q < 8; ++q) { float v = kacc[q]; if (lag == 0 && p == qh * 8 + q) v += a.in[I_S5_D][((size_t)j * S5G + g) * S5P + p]; Ks[(lag * 16 + p) * 16 + qh * 8 + q] = v; } }
        __syncthreads();
        bf16_t* FD = (bf16_t*)(ws + WS_S5T + S5T_FD) + (size_t)g * 16 * 512; bf16_t* WS_ = (bf16_t*)(ws + WS_S5T + S5T_WS) + (size_t)g * 128 * 256; bf16_t* WY = (bf16_t*)(ws + WS_S5T + S5T_WY) + (size_t)g * 256 * 128;
        for (int idx = F.tid; idx < 8 * 512; idx += 512) { const int d = 8 * half + (idx >> 9), l = (idx >> 3) & 63, jj = idx & 7, p = l & 15, gq = l >> 4;
            float v = 0.f; if (gq < 2) v = Ks[(d * 16 + p) * 16 + 8 * gq + jj]; else if (d >= 1) v = Ks[((d - 1) * 16 + p) * 16 + 8 * (gq - 2) + jj];
            FD[(size_t)d * 512 + (idx & 511)] = (bf16_t)f2bf(v); }
        for (int idx = F.tid; idx < 64 * 256; idx += 512) { const int R = 64 * half + (idx >> 8), k = idx & 255, n = R >> 1, c = R & 1, s_ = k >> 4, q = k & 15;
            const f32x2 w = PW[(15 - s_) * 64 + n], bq = BBs[n * 16 + q];
            const float v = c ? (w.x * bq.y + w.y * bq.x) : (w.x * bq.x - w.y * bq.y);
            WS_[(size_t)R * 256 + k] = (bf16_t)f2bf(v); }
        for (int idx = F.tid; idx < 128 * 128; idx += 512) { const int R = 128 * half + (idx >> 7), k = idx & 127, t = R >> 4, p = R & 15, n = k >> 1, c = k & 1;
            const f32x2 cc = Cs[p * 64 + n], w = PW[(t + 1) * 64 + n];
            const float v = c ? -(cc.x * w.y + cc.y * w.x) : (cc.x * w.x - cc.y * w.y);
            WY[(size_t)R * 128 + k] = (bf16_t)f2bf(v); }
        if (half == 0 && F.tid < 64) ((f32x2*)(ws + WS_S5T + S5T_A16))[g * 64 + F.tid] = PW[16 * 64 + F.tid];
    }
    __syncthreads();
}

struct CvItem { const float* src; bf16_t* dst; int ldS, ldD, nvalid, zoff; };
__device__ __forceinline__ int conv_nmix(int li) { return (li & 1) == 0 ? 3 * 2048 : (1280 + 1024 + 512 + 512 + 2048); }
__device__ __forceinline__ CvItem conv_item(const Args& a, unsigned char* ws, int li, int r) {
    const int j = li >> 1; const bool s5 = (li & 1) == 0; const int nmix = conv_nmix(li);
    CvItem I; I.nvalid = 32; I.zoff = 0;
    if (r < nmix) {
        if (s5) { const int mat = r / 2048, item = r % 2048, kb = item / 64, nb = item % 64;
            const float* W = a.in[mat == 0 ? I_S5_WIN : (mat == 1 ? I_S5_WGLU : I_S5_WOUT)] + (size_t)j * D * D;
            I.src = W + (size_t)(kb * 64) * D + nb * 32; I.ldS = D; I.dst = (bf16_t*)(ws + WS_WMIX + (size_t)mat * 8 * MiB) + (size_t)(nb * 32) * D + kb * 64; I.ldD = D; return I; }
        if (r < 1280) { const int kb = r / 40, nb = r % 40; const float* W = a.in[I_D_WIN] + (size_t)j * D * DSA_IN;
            int nv = DSA_IN - nb * 32; nv = nv < 0 ? 0 : (nv > 32 ? 32 : nv);
            I.src = W + (size_t)(kb * 64) * DSA_IN + (nv ? nb * 32 : 0); I.ldS = DSA_IN; I.nvalid = nv;        I.dst = (bf16_t*)(ws + WS_WMIX + WM_D_IN) + (size_t)(nb * 32) * D + kb * 64; I.ldD = D; return I; }
        r -= 1280;
        if (r < 1024) { const int mat = r / 512, item = r % 512, kb = item / 64, nb = item % 64;
            const float* W = a.in[mat == 0 ? I_D_WUQ : I_D_WQIDX] + (size_t)j * QL * 2048;
            I.src = W + (size_t)(kb * 64) * 2048 + nb * 32; I.ldS = 2048; I.dst = (bf16_t*)(ws + WS_WMIX + WM_D_Q) + (size_t)(mat * 2048 + nb * 32) * QL + kb * 64; I.ldD = QL; return I; }
        r -= 1024;
        if (r < 512) { const int h = r / 32, item = r % 32, kb = item / 16, nb = item % 16;
            const float* W = a.in[I_D_WUK] + ((size_t)j * NH + h) * HD * KVL;
            I.src = W + (size_t)(kb * 64) * KVL + nb * 32; I.ldS = KVL; I.dst = (bf16_t*)(ws + WS_WMIX + WM_D_UK) + (size_t)h * 512 * 128 + (size_t)(nb * 32) * 128 + kb * 64; I.ldD = 128; return I; }
        r -= 512;
        if (r < 512) { const int h = r / 32, item = r % 32, kb = item / 4, nb = item % 4, p = h >> 1, hh = h & 1;
            const float* W = a.in[I_D_WUV] + ((size_t)j * NH + h) * KVL * HD;
            I.src = W + (size_t)(kb * 64) * HD + nb * 32; I.ldS = HD; I.dst = (bf16_t*)(ws + WS_WMIX + WM_D_UV) + (size_t)p * 256 * 1024 + (size_t)(hh * 128 + nb * 32) * 1024 + hh * 512 + kb * 64; I.ldD = 1024;
            I.zoff = hh ? -512 : 512; return I; }
        r -= 512;
        { const int kb = r / 64, nb = r % 64; const float* W = a.in[I_D_WOUT] + (size_t)j * D * D;
          I.src = W + (size_t)(kb * 64) * D + nb * 32; I.ldS = D; I.dst = (bf16_t*)(ws + WS_WMIX + WM_D_OUT) + (size_t)(nb * 32) * D + kb * 64; I.ldD = D; return I; }
    }
    r -= nmix;
    if (r < 16384) { const int job = r / 128, item = r % 128, e = job >> 2, which = (job >> 1) & 1, fg = job & 1, kb = item / 4, nb = item % 4;
        const float* W = a.in[which ? I_M_WUP : I_M_WGATE] + ((size_t)li * NE + e) * D * FF;
        I.src = W + (size_t)(kb * 64) * FF + fg * 128 + nb * 32; I.ldS = FF; I.dst = (bf16_t*)(ws + WS_WMOE + WE_GU) + (size_t)e * 512 * D + (size_t)(fg * 256 + which * 128 + nb * 32) * D + kb * 64; I.ldD = D; return I; }
    r -= 16384;
    { const int e = r / 256, item = r % 256, kb = item / 64, nb = item % 64;
      const float* W = a.in[I_M_WDOWN] + ((size_t)li * NE + e) * FF * D;
      I.src = W + (size_t)(kb * 64) * D + nb * 32; I.ldS = D; I.dst = (bf16_t*)(ws + WS_WMOE + WE_DN) + (size_t)e * D * FF + (size_t)(nb * 32) * FF + kb * 64; I.ldD = FF; return I; }
}
__device__ __forceinline__ void conv_run(const Frame& F, const Args& a, int li, int r0, int r1, int first, int stride) {
    unsigned char* ws = F.ws;
    LAS float* scr = (LAS float*)(F.lds + F.wave * 16384);
    int r = r0 + first; if (r >= r1) return;
    const int lane = F.lane, nn = lane & 31, hi = lane >> 5, c = lane & 7;
    CvItem cur = conv_item(a, ws, li, r);
    float tv[32];
#define CV_LOAD(I_) do { const unsigned vo_ = ((unsigned)hi * (unsigned)(I_).ldS + (unsigned)(nn < (I_).nvalid ? nn : 0)) * 4u; const char* sb_ = (const char*)(I_).src; const size_t st2_ = (size_t)8 * (I_).ldS; \
        _Pragma("unroll") for (int i_ = 0; i_ < 32; ++i_) { tv[i_] = *(const float*)(sb_ + vo_); sb_ += st2_; } } while (0)
    CV_LOAD(cur);
    for (;;) {
        __builtin_amdgcn_sched_barrier(0);
        const bool okc = nn < cur.nvalid;
#pragma unroll
        for (int i = 0; i < 32; ++i) scr[(2 * i + hi) * 33 + nn] = okc ? tv[i] : 0.f;
        __builtin_amdgcn_sched_barrier(0);
        r += stride; const bool more = r < r1;
        CvItem nxt = cur;
        if (more) { nxt = conv_item(a, ws, li, r); CV_LOAD(nxt); }
        __builtin_amdgcn_sched_barrier(0);
        LDS_WAIT(); asm volatile("" ::: "memory");
#pragma unroll
        for (int q = 0; q < 4; ++q) { const int n = (lane >> 3) + 8 * q; const LAS float* sl = scr + (8 * c) * 33 + n;
            u32x4 o; o.x = pk2(sl[0 * 33], sl[1 * 33]); o.y = pk2(sl[2 * 33], sl[3 * 33]); o.z = pk2(sl[4 * 33], sl[5 * 33]); o.w = pk2(sl[6 * 33], sl[7 * 33]);
            *(GAS u32x4*)(cur.dst + (size_t)n * cur.ldD + 8 * c) = o;
            if (cur.zoff) { unsigned z0 = 0u; asm volatile("" : "+v"(z0)); *(GAS u32x4*)(cur.dst + cur.zoff + (size_t)n * cur.ldD + 8 * c) = (u32x4){z0, z0, z0, z0}; } }
        LDS_WAIT(); asm volatile("" ::: "memory");
        if (!more) break;
        cur = nxt;
    }
#undef CV_LOAD
}
__device__ __forceinline__ void phase_conv(const Frame& F, const Args& a, int li) {
    unsigned char* ws = F.ws;
    const int j = li >> 1; const bool s5 = (li & 1) == 0;
    if (s5) s5_tables(F, a, j);
    conv_run(F, a, li, 0, conv_nmix(li) + 24576, F.gw, F.NGW);
    if (li == 0) {
        const float* x = a.in[I_X]; bf16_t* h16 = (bf16_t*)(ws + WS_H16);
        for (int m = F.gw; m < T; m += F.NGW) {
            const f32x4* xr = (const f32x4*)(x + (size_t)m * D) + F.lane; u32x2* br = (u32x2*)(h16 + (size_t)m * D) + F.lane;
            f32x4 xv[8];
#pragma unroll
            for (int q = 0; q < 8; ++q) xv[q] = xr[64 * q];
            __builtin_amdgcn_sched_barrier(0);
#pragma unroll
            for (int q = 0; q < 8; ++q) { const f32x4 v = xv[q]; u32x2 w; w.x = pk2(v[0], v[1]); w.y = pk2(v[2], v[3]); br[64 * q] = w; }
        }
    }
    {
        const int gt = F.vcu * 512 + F.tid;
        if (gt < 48 * D) { const int n = gt / D, k = gt % D;
            const float v = n < NG ? a.in[I_M_WG][((size_t)li * D + k) * NG + n] : (n < NG + NE ? a.in[I_M_WE][((size_t)li * D + k) * NE + (n - NG)] : 0.f);
            const unsigned hi = f2bf(v); const unsigned lo = f2bf(v - bf2f(hi));
            bf16_t* RT = (bf16_t*)(ws + WS_RT); RT[gt] = (bf16_t)hi; RT[48 * D + gt] = (bf16_t)lo; }
    }
}

__device__ __forceinline__ void phase_ssm2(const Frame& F, const Args& a) {
    unsigned char* ws = F.ws;
    const bf16_t* U = (const bf16_t*)(ws + WS_S + S_U16); bf16_t* Z = (bf16_t*)(ws + WS_S + S_Z16);
    const int lane = F.lane, w = F.wave, r16 = lane & 15, gq = lane >> 4;
    constexpr int UP = 528, HP = 272;
    LAS unsigned char* Us = F.lds;
    LAS unsigned char* Hs = F.lds + 128 * UP;
    LAS unsigned char* Fs = Hs + 128 * HP;
    u32x4 uv[8], fv[2];
#define SSM_FETCH(un_) do { const int b_ = (un_) / S5G, g_ = (un_) % S5G; \
        _Pragma("unroll") for (int it = 0; it < 8; ++it) { const int idx = it * 512 + F.tid, t = idx >> 1, hf = idx & 1; uv[it] = *(const u32x4*)(U + (size_t)(b_ * SEQ + t) * D + g_ * S5P + hf * 8); } \
        _Pragma("unroll") for (int it = 0; it < 2; ++it) { const int idx = it * 512 + F.tid; fv[it] = *((const u32x4*)(ws + WS_S5T + S5T_FD + (size_t)g_ * 16384) + idx); } } while (0)
    if (F.vcu < NB * S5G) SSM_FETCH(F.vcu);
    for (int unit = F.vcu; unit < NB * S5G; unit += F.G) {
        const int b = unit / S5G, g = unit % S5G;
        __syncthreads();
        { __builtin_amdgcn_sched_barrier(0);
#pragma unroll
          for (int it = 0; it < 8; ++it) { const int idx = it * 512 + F.tid, t = idx >> 1, hf = idx & 1; *(LAS u32x4*)(Us + (t >> 4) * UP + (t & 15) * 32 + hf * 16) = uv[it]; }
#pragma unroll
          for (int it = 0; it < 2; ++it) { const int idx = it * 512 + F.tid; *(LAS u32x4*)(Fs + idx * 16) = fv[it]; } }
        const bf16_t* WSg = (const bf16_t*)(ws + WS_S5T + S5T_WS) + (size_t)g * 128 * 256; const bf16_t* WYg = (const bf16_t*)(ws + WS_S5T + S5T_WY) + (size_t)g * 256 * 128;
        bf16x8 wa[8];
#pragma unroll
        for (int ks = 0; ks < 8; ++ks) wa[ks] = *(const bf16x8*)(WSg + (size_t)(16 * w + r16) * 256 + 32 * ks + 8 * gq);
        __syncthreads();
#pragma unroll 2
        for (int nt = 0; nt < 8; ++nt) {
            f32x4 acc = {0.f, 0.f, 0.f, 0.f}; bf16x8 ub8[8];
#pragma unroll
            for (int ks = 0; ks < 8; ++ks) ub8[ks] = *(const LAS bf16x8*)(Us + (nt * 16 + r16) * UP + (2 * ks + (gq >> 1)) * 32 + (gq & 1) * 16);
            __builtin_amdgcn_sched_barrier(0);
#pragma unroll
            for (int ks = 0; ks < 8; ++ks) acc = __builtin_amdgcn_mfma_f32_16x16x32_bf16(wa[ks], ub8[ks], acc, 0, 0, 0);
            __builtin_amdgcn_sched_barrier(0);
            u32x2 o; o.x = pk2(acc[0], acc[1]); o.y = pk2(acc[2], acc[3]);
            *(LAS u32x2*)(Hs + (nt * 16 + r16) * HP + (16 * w + 4 * gq) * 2) = o;
        }
        __syncthreads();
        const int t0 = w, t1 = 15 - w;
        bf16x8 wy0[4], wy1[4];
#pragma unroll
        for (int ks = 0; ks < 4; ++ks) { wy0[ks] = *(const bf16x8*)(WYg + (size_t)(t0 * 16 + r16) * 128 + 32 * ks + 8 * gq); wy1[ks] = *(const bf16x8*)(WYg + (size_t)(t1 * 16 + r16) * 128 + 32 * ks + 8 * gq); }
        __builtin_amdgcn_sched_barrier(0);
        if (w == 0) {
            const f32x2 a16 = ((const f32x2*)(ws + WS_S5T + S5T_A16))[g * 64 + lane];
            float hr = 0.f, hi = 0.f;
#pragma unroll 1
            for (int c0 = 0; c0 < 128; c0 += 32) {
                unsigned sv[32];
#pragma unroll
                for (int c = 0; c < 32; ++c) sv[c] = *(const LAS unsigned*)(Hs + (c0 + c) * HP + lane * 4);
#pragma unroll
                for (int c = 0; c < 32; ++c) { const unsigned hp = pk2(hr, hi); const float sr = bflo(sv[c]), si = bfhi(sv[c]);
                    const float nr = a16.x * hr - a16.y * hi + sr, ni = a16.x * hi + a16.y * hr + si; hr = nr; hi = ni; sv[c] = hp; }
#pragma unroll
                for (int c = 0; c < 32; ++c) *(LAS unsigned*)(Hs + (c0 + c) * HP + lane * 4) = sv[c];
            }
        }
        __builtin_amdgcn_s_waitcnt(0x0F70);
        __builtin_amdgcn_sched_barrier(0);
        { const int un = unit + F.G < NB * S5G ? unit + F.G : unit; SSM_FETCH(un); }
        __builtin_amdgcn_sched_barrier(0);
        asm volatile("s_waitcnt lgkmcnt(0)" ::: "memory"); __builtin_amdgcn_s_barrier(); asm volatile("" ::: "memory");
        bf16x8 fa[4], fb[8];
#pragma unroll
        for (int sp = 0; sp < 4; ++sp) { const int da = t0 - 2 * sp; fa[sp] = *(const LAS bf16x8*)(Fs + (da > 0 ? da : 0) * 1024 + lane * 16); }
#pragma unroll
        for (int sp = 0; sp < 8; ++sp) { const int db = t1 - 2 * sp; fb[sp] = *(const LAS bf16x8*)(Fs + (db > 0 ? db : 0) * 1024 + lane * 16); }
#pragma unroll 1
        for (int nt = 0; nt < 8; ++nt) {
            f32x4 acc0 = {0.f, 0.f, 0.f, 0.f}, acc1 = {0.f, 0.f, 0.f, 0.f};
            bf16x8 ub8[8], hb4[4];
#pragma unroll
            for (int sp = 0; sp < 8; ++sp) ub8[sp] = *(const LAS bf16x8*)(Us + (nt * 16 + r16) * UP + (2 * sp + (gq >> 1)) * 32 + (gq & 1) * 16);
#pragma unroll
            for (int ks = 0; ks < 4; ++ks) hb4[ks] = *(const LAS bf16x8*)(Hs + (nt * 16 + r16) * HP + (32 * ks + 8 * gq) * 2);
            __builtin_amdgcn_sched_barrier(0);
#pragma unroll
            for (int ks = 0; ks < 4; ++ks) { acc0 = __builtin_amdgcn_mfma_f32_16x16x32_bf16(wy0[ks], hb4[ks], acc0, 0, 0, 0); acc1 = __builtin_amdgcn_mfma_f32_16x16x32_bf16(wy1[ks], hb4[ks], acc1, 0, 0, 0); }
#pragma unroll
            for (int sp = 0; sp < 4; ++sp) { if (2 * sp <= t0) acc0 = __builtin_amdgcn_mfma_f32_16x16x32_bf16(fa[sp], ub8[sp], acc0, 0, 0, 0); }
#pragma unroll
            for (int sp = 0; sp < 8; ++sp) { if (2 * sp <= t1) acc1 = __builtin_amdgcn_mfma_f32_16x16x32_bf16(fb[sp], ub8[sp], acc1, 0, 0, 0); }
            __builtin_amdgcn_sched_barrier(0);
            float z0[4], z1[4];
#pragma unroll
            for (int jj = 0; jj < 4; ++jj) { const float y0 = acc0[jj], y1 = acc1[jj];
                z0[jj] = y0 / (1.0f + __expf(-1.5957691216057308f * (y0 + 0.044715f * y0 * y0 * y0)));
                z1[jj] = y1 / (1.0f + __expf(-1.5957691216057308f * (y1 + 0.044715f * y1 * y1 * y1))); }
            const size_t rowb = (size_t)b * SEQ + 16 * (nt * 16 + r16);
            u32x2 o0, o1; o0.x = pk2(z0[0], z0[1]); o0.y = pk2(z0[2], z0[3]); o1.x = pk2(z1[0], z1[1]); o1.y = pk2(z1[2], z1[3]);
            *(u32x2*)(Z + (rowb + t0) * D + g * S5P + 4 * gq) = o0; *(u32x2*)(Z + (rowb + t1) * D + g * S5P + 4 * gq) = o1;
        }
    }
}

#undef SSM_FETCH
template <int MODE>
__device__ __forceinline__ void phase_ln(const Frame& F, const Args& a, int li, int m0, int mstep, int mend) {
    unsigned char* ws = F.ws;
    bf16_t* H16 = (bf16_t*)(ws + WS_H16);
    const float* gam = a.in[MODE == 0 ? I_LNM_G : I_LNF_G] + (size_t)li * D; const float* bet = a.in[MODE == 0 ? I_LNM_B : I_LNF_B] + (size_t)li * D;
    const bf16_t* Y0 = (const bf16_t*)(ws + WS_S + S_Y0); const bf16_t* Y1 = (const bf16_t*)(ws + WS_S + S_Y1);
    const int lane = F.lane;
    const bool last = (MODE == 1) && (li == DEPTH - 1);
    for (int m = m0; m < mend; m += mstep) {
        float v[4][8];
        const u32x4* xr = (const u32x4*)(H16 + (size_t)m * D) + lane;
#pragma unroll
        for (int q = 0; q < 4; ++q) { const u32x4 p = xr[64 * q]; v[q][0] = bflo(p.x); v[q][1] = bfhi(p.x); v[q][2] = bflo(p.y); v[q][3] = bfhi(p.y); v[q][4] = bflo(p.z); v[q][5] = bfhi(p.z); v[q][6] = bflo(p.w); v[q][7] = bfhi(p.w); }
        if (MODE == 1) {
            const u32x2* y0 = (const u32x2*)((const unsigned char*)Y0 + (size_t)m * D) + lane; const u32x2* y1 = (const u32x2*)((const unsigned char*)Y1 + (size_t)m * D) + lane;
            u32x2 pa[4], pb[4];
#pragma unroll
            for (int q = 0; q < 4; ++q) { pa[q] = y0[64 * q]; pb[q] = y1[64 * q]; }
            __builtin_amdgcn_sched_barrier(0);
#pragma unroll
            for (int q = 0; q < 4; ++q) {
                const f32x2 a0 = __builtin_amdgcn_cvt_pk_f32_fp8((int)pa[q].x, false), a1 = __builtin_amdgcn_cvt_pk_f32_fp8((int)pa[q].x, true), a2 = __builtin_amdgcn_cvt_pk_f32_fp8((int)pa[q].y, false), a3 = __builtin_amdgcn_cvt_pk_f32_fp8((int)pa[q].y, true);
                const f32x2 b0 = __builtin_amdgcn_cvt_pk_f32_fp8((int)pb[q].x, false), b1 = __builtin_amdgcn_cvt_pk_f32_fp8((int)pb[q].x, true), b2 = __builtin_amdgcn_cvt_pk_f32_fp8((int)pb[q].y, false), b3 = __builtin_amdgcn_cvt_pk_f32_fp8((int)pb[q].y, true);
                v[q][0] = v[q][0] * DN_ALPHA + (a0[0] + b0[0]) * 0.0625f; v[q][1] = v[q][1] * DN_ALPHA + (a0[1] + b0[1]) * 0.0625f;
                v[q][2] = v[q][2] * DN_ALPHA + (a1[0] + b1[0]) * 0.0625f; v[q][3] = v[q][3] * DN_ALPHA + (a1[1] + b1[1]) * 0.0625f;
                v[q][4] = v[q][4] * DN_ALPHA + (a2[0] + b2[0]) * 0.0625f; v[q][5] = v[q][5] * DN_ALPHA + (a2[1] + b2[1]) * 0.0625f;
                v[q][6] = v[q][6] * DN_ALPHA + (a3[0] + b3[0]) * 0.0625f; v[q][7] = v[q][7] * DN_ALPHA + (a3[1] + b3[1]) * 0.0625f; }
        }
        float s = 0.f;
#pragma unroll
        for (int q = 0; q < 4; ++q)
#pragma unroll
            for (int e = 0; e < 8; ++e) s += v[q][e];
        const float mean = wave_sum(s, lane) * (1.0f / D); float s2 = 0.f;
#pragma unroll
        for (int q = 0; q < 4; ++q)
#pragma unroll
            for (int e = 0; e < 8; ++e) { v[q][e] -= mean; s2 += v[q][e] * v[q][e]; }
        const float rstd = 1.0f / sqrtf(wave_sum(s2, lane) * (1.0f / D) + LN_EPS);
#pragma unroll
        for (int q = 0; q < 4; ++q) { const f32x4 g0 = *((const f32x4*)gam + 2 * (lane + 64 * q)), g1 = *((const f32x4*)gam + 2 * (lane + 64 * q) + 1), b0 = *((const f32x4*)bet + 2 * (lane + 64 * q)), b1 = *((const f32x4*)bet + 2 * (lane + 64 * q) + 1);
#pragma unroll
            for (int e = 0; e < 4; ++e) { v[q][e] = v[q][e] * rstd * g0[e] + b0[e]; v[q][4 + e] = v[q][4 + e] * rstd * g1[e] + b1[e]; } }
        if (last) {
            f32x4* o = (f32x4*)(a.out + (size_t)m * D) + 2 * lane;
#pragma unroll
            for (int q = 0; q < 4; ++q) { o[128 * q] = (f32x4){v[q][0], v[q][1], v[q][2], v[q][3]}; o[128 * q + 1] = (f32x4){v[q][4], v[q][5], v[q][6], v[q][7]}; }
        } else {
            u32x4* ob = (u32x4*)(H16 + (size_t)m * D) + lane;
#pragma unroll
            for (int q = 0; q < 4; ++q) { u32x4 w; w.x = pk2(v[q][0], v[q][1]); w.y = pk2(v[q][2], v[q][3]); w.z = pk2(v[q][4], v[q][5]); w.w = pk2(v[q][6], v[q][7]); ob[64 * q] = w;
 }
        }
    }
}

__device__ __forceinline__ void phase_router(const Frame& F, const Args& a, int li) {
    unsigned char* ws = F.ws;
    const bf16_t* XH = (const bf16_t*)(ws + WS_H16);
    const bf16_t* WH = (const bf16_t*)(ws + WS_RT);
    const int lane = F.lane, r16 = lane & 15, g = lane >> 4, wq = F.wave & 3, kh = F.wave >> 2;
    LAS float* lb = (LAS float*)(F.lds + F.wave * 4096);
    const LAS float* lbp = (const LAS float*)(F.lds + (F.wave ^ 4) * 4096);
    for (int t0 = 0; t0 < T / 16; t0 += F.G * 4) {
        { const int rb = (t0 + F.vcu * 4) * 16 + F.wave * 8; const int re = rb + 8 < T ? rb + 8 : T; phase_ln<0>(F, a, li, rb, 1, re); }
        asm volatile("s_waitcnt vmcnt(0)" ::: "memory"); __syncthreads();
        const int tile = t0 + F.vcu * 4 + wq; const bool act = tile < T / 16;
        f32x4 acc[3];
#pragma unroll
        for (int n = 0; n < 3; ++n) acc[n] = (f32x4){0.f, 0.f, 0.f, 0.f};
        if (act) {
            const bf16_t* xh = XH + ((size_t)tile * 16 + r16) * D + 8 * g + kh * (D / 2);
            const bf16_t* wh = WH + (size_t)r16 * D + 8 * g + kh * (D / 2);
            bf16x8 ah[2][4], bh[2][4][3];
#define RT_LOAD(buf, s0) do { _Pragma("unroll") for (int u_ = 0; u_ < 4; ++u_) { ah[buf][u_] = *(const bf16x8*)(xh + 32 * ((s0) + u_)); \
                _Pragma("unroll") for (int n_ = 0; n_ < 3; ++n_) bh[buf][u_][n_] = *(const bf16x8*)(wh + (size_t)(n_ * 16) * D + 32 * ((s0) + u_)); } } while (0)
#define RT_MMA(buf) do { _Pragma("unroll") for (int u_ = 0; u_ < 4; ++u_) _Pragma("unroll") for (int n_ = 0; n_ < 3; ++n_) acc[n_] = __builtin_amdgcn_mfma_f32_16x16x32_bf16(ah[buf][u_], bh[buf][u_][n_], acc[n_], 0, 0, 0); } while (0)
            RT_LOAD(0, 0);
#pragma unroll 1
            for (int s0 = 0; s0 < D / 64; s0 += 8) {
                __builtin_amdgcn_sched_barrier(0);
                RT_LOAD(1, s0 + 4);
                __builtin_amdgcn_sched_barrier(0);
                RT_MMA(0);
                __builtin_amdgcn_sched_barrier(0);
                if (s0 + 8 < D / 64) RT_LOAD(0, s0 + 8);
                __builtin_amdgcn_sched_barrier(0);
                RT_MMA(1);
            }
#undef RT_LOAD
#undef RT_MMA
        }
#pragma unroll
        for (int n = 0; n < 3; ++n)
#pragma unroll
            for (int j = 0; j < 4; ++j) lb[(4 * g + j) * 52 + n * 16 + r16] = acc[n][j];
        __syncthreads();
        LAS unsigned* bc = (LAS unsigned*)(F.lds + 8 * 4096);
        if (F.tid < 64) bc[F.tid] = 0u;
        __syncthreads();
        int e1 = 0, e2 = 0; float w1 = 0.f, w2 = 0.f; unsigned l1 = 0u, l2 = 0u; const bool dec = act && kh == 0 && lane < 16;
        if (dec) {
            const LAS float* L = lb + lane * 52; const LAS float* L2 = lbp + lane * 52;
            float lg[NG];
#pragma unroll
            for (int q = 0; q < NG; ++q) lg[q] = L[q] + L2[q] + a.in[I_M_BG][li * NG + q];
            int gi = 0; float gm = lg[0];
#pragma unroll
            for (int q = 1; q < NG; ++q) if (lg[q] > gm) { gm = lg[q]; gi = q; }
            float gs = 0.f;
#pragma unroll
            for (int q = 0; q < NG; ++q) gs += __expf(lg[q] - gm);
            const float gp = 1.0f / gs;
            float el[EPG];
#pragma unroll
            for (int i = 0; i < EPG; ++i) el[i] = L[NG + gi * EPG + i] + L2[NG + gi * EPG + i] + a.in[I_M_BE][li * NE + gi * EPG + i];
            int i1 = 0; float m1 = el[0];
#pragma unroll
            for (int i = 1; i < EPG; ++i) if (el[i] > m1) { m1 = el[i]; i1 = i; }
            int i2 = -1; float m2 = -3.0e38f; asm volatile("" : "+v"(m2));
#pragma unroll
            for (int i = 0; i < EPG; ++i) if (i != i1 && el[i] > m2) { m2 = el[i]; i2 = i; }
            w1 = gp / (1.0f + __expf(m2 - m1)); w2 = gp / (1.0f + __expf(m1 - m2));
            e1 = gi * EPG + i1; e2 = gi * EPG + i2;
            l1 = __hip_atomic_fetch_add(bc + e1, 1u, __ATOMIC_RELAXED, __HIP_MEMORY_SCOPE_WORKGROUP);
            l2 = __hip_atomic_fetch_add(bc + e2, 1u, __ATOMIC_RELAXED, __HIP_MEMORY_SCOPE_WORKGROUP);
        }
        __syncthreads();
        if (F.tid < NE) { const unsigned n = bc[F.tid]; bc[32 + F.tid] = n ? __hip_atomic_fetch_add(F.ctl + CW_CNT + (li * NE + F.tid) * 64, n, RLX_AGENT) : 0u; }
        __syncthreads();
        if (dec) {
            const int m = tile * 16 + lane;
            unsigned* LIST = (unsigned*)(ws + WS_LIST); float* GWL = (float*)(ws + WS_GWL);
            const unsigned s1 = bc[32 + e1] + l1, s2_ = bc[32 + e2] + l2;
            LIST[(size_t)e1 * T + s1] = (unsigned)m; GWL[(size_t)e1 * T + s1] = w1;
            LIST[(size_t)e2 * T + s2_] = (unsigned)m | 0x80000000u; GWL[(size_t)e2 * T + s2_] = w2;
        }
        __syncthreads();
    }
}

__device__ __forceinline__ void moe_table(const Frame& F, int li) {
    LAS int* tab = (LAS int*)(F.lds + MOETAB_OFF);
    __syncthreads();
    if (F.tid < 64) {
        const int e = F.lane; const int c = (e < NE) ? (int)__hip_atomic_load(F.ctl + CW_CNT + (li * NE + e) * 64, RLX_AGENT) : 0; const int nt = (c + 255) >> 8;
        int incl = nt;
#pragma unroll
        for (int o = 1; o < 32; o <<= 1) { const int v = __builtin_amdgcn_ds_bpermute(((e - o) & 63) << 2, incl); if (e >= o) incl += v; }
        const int excl = incl - nt;
        if (e < NE) { tab[1 + e] = excl * 256; tab[34 + e] = c;
#pragma nounroll
            for (int k = 0; k < nt; ++k) ((LAS unsigned char*)(tab + 66))[excl + k] = (unsigned char)e; }
        if (e == NE - 1) { tab[33] = incl * 256; tab[0] = incl; }
    }
    __syncthreads();
}
__device__ __forceinline__ void phase_rms(const Frame& F, const Args& a, int j) {
    unsigned char* ws = F.ws;
    const int lane = F.lane;
    for (int it0 = F.gw * 4; it0 < 2 * T; it0 += F.NGW * 4) {
        u32x4 w[4]; bf16_t* X[4]; const float* gn[4];
#pragma unroll
        for (int r = 0; r < 4; ++r) { const int it = it0 + r; const int which = it >= T, m = it - which * T;
            X[r] = (bf16_t*)(ws + (which ? WS_CKV : WS_CQ)) + (size_t)m * 512; gn[r] = a.in[which ? I_D_KVN : I_D_QN] + (size_t)j * 512;
            w[r] = *((const u32x4*)X[r] + lane); }
#pragma unroll
        for (int r = 0; r < 4; ++r) {
            float x[8] = {bflo(w[r].x), bfhi(w[r].x), bflo(w[r].y), bfhi(w[r].y), bflo(w[r].z), bfhi(w[r].z), bflo(w[r].w), bfhi(w[r].w)};
            float s = 0.f;
#pragma unroll
            for (int q = 0; q < 8; ++q) s += x[q] * x[q];
            const float rs = 1.0f / sqrtf(wave_sum(s, lane) * (1.0f / 512.0f) + RMS_EPS);
            const f32x4 g0 = *((const f32x4*)gn[r] + 2 * lane), g1 = *((const f32x4*)gn[r] + 2 * lane + 1);
            u32x4 o; o.x = pk2(x[0] * rs * g0[0], x[1] * rs * g0[1]); o.y = pk2(x[2] * rs * g0[2], x[3] * rs * g0[3]);
            o.z = pk2(x[4] * rs * g1[0], x[5] * rs * g1[1]); o.w = pk2(x[6] * rs * g1[2], x[7] * rs * g1[3]);
            *((u32x4*)X[r] + lane) = o;
        }
    }
}

__device__ __forceinline__ void phase_topk(const Frame& F, const Args& a) {
    unsigned char* ws = F.ws;
    const float* IDX = (const float*)(ws + WS_S + S_INDEX); unsigned short* SEL = (unsigned short*)(ws + WS_SEL);
    const int lane = F.lane;
    LAS unsigned* hist = (LAS unsigned*)(F.lds + F.wave * 2048);
    LAS unsigned short* sl = (LAS unsigned short*)(F.lds + F.wave * 2048 + 1024);
    for (int i0 = 0; i0 * F.NGW < T; ++i0) {
        int rot = F.gw + i0 * 257; while (rot >= F.NGW) rot -= F.NGW;
        const int m = i0 * F.NGW + rot; if (m >= T) continue;
        const int t = m % SEQ; unsigned short* sel = SEL + (size_t)m * TOPK;
        if (t < TOPK) { for (int k = lane; k <= t; k += 64) sel[k] = (unsigned short)k; continue; }
        unsigned key[32];
        const float* row = IDX + (size_t)m * SEQ;
        const int nreg = t >> 6;
#pragma unroll
        for (int i = 0; i < 32; ++i) { const int s = i * 64 + lane; key[i] = (s <= t) ? __builtin_bit_cast(unsigned, row[s]) : 0x7fffffffu; }
        __builtin_amdgcn_sched_barrier(0);
#pragma unroll
        for (int i = 0; i < 32; ++i) { const unsigned u = key[i]; key[i] = (u == 0x7fffffffu) ? 0u : ((u & 0x80000000u) ? ~u : (u | 0x80000000u)); }
        unsigned prefix = 0u; int need = TOPK;
#pragma unroll 1
        for (int shift = 24; shift >= 0; shift -= 8) {
            { unsigned z_ = 0u; asm volatile("" : "+v"(z_)); *(LAS u32x4*)(hist + 4 * lane) = (u32x4){z_, z_, z_, z_}; }
            const unsigned himask = shift == 24 ? 0u : (0xffffffffu << (shift + 8));
#pragma unroll
            for (int q8 = 0; q8 < 4; ++q8) if (q8 * 8 <= nreg) {
#pragma unroll
              for (int i8 = 0; i8 < 8; ++i8) { const unsigned k_ = key[q8 * 8 + i8]; const bool c_ = ((k_ & himask) == prefix) && (k_ != 0u);
                __hip_atomic_fetch_add(hist + (c_ ? ((k_ >> shift) & 255u) : 384u + (unsigned)lane), 1u, __ATOMIC_RELAXED, __HIP_MEMORY_SCOPE_WORKGROUP); } }
            LDS_WAIT(); asm volatile("" ::: "memory");
            const u32x4 h4 = *(const LAS u32x4*)(hist + 4 * lane);
            const int sl = (int)(h4.x + h4.y + h4.z + h4.w);
            int S = sl;
            S += __builtin_amdgcn_update_dpp(0, S, 0x101, 0xf, 0xf, true);
            S += __builtin_amdgcn_update_dpp(0, S, 0x102, 0xf, 0xf, true);
            S += __builtin_amdgcn_update_dpp(0, S, 0x104, 0xf, 0xf, true);
            S += __builtin_amdgcn_update_dpp(0, S, 0x108, 0xf, 0xf, true);
            { const int r1 = __builtin_amdgcn_readlane(S, 16), r2 = __builtin_amdgcn_readlane(S, 32), r3 = __builtin_amdgcn_readlane(S, 48);
              S += (lane < 16 ? r1 : 0) + (lane < 32 ? r2 : 0) + (lane < 48 ? r3 : 0); }
            const unsigned long long mk = __ballot(S >= need);
            const int Ls = 63 - __builtin_clzll(mk);
            const int above = S - sl;
            int bsel = 0, cab = above;
            { const int c3 = above + (int)h4.w, c2 = c3 + (int)h4.z, c1 = c2 + (int)h4.y;
              if (c3 >= need) { bsel = 3; cab = above; } else if (c2 >= need) { bsel = 2; cab = c3; } else if (c1 >= need) { bsel = 1; cab = c2; } else { bsel = 0; cab = c1; } }
            const int Bs = __builtin_amdgcn_readlane(bsel, Ls), Ca = __builtin_amdgcn_readlane(cab, Ls);
            prefix |= (unsigned)(4 * Ls + Bs) << shift; need -= Ca;
            LDS_WAIT(); asm volatile("" ::: "memory");
        }
        const unsigned thr = prefix;
        int bg = 0, be = TOPK - need;
#pragma unroll
        for (int q8 = 0; q8 < 4; ++q8) if (q8 * 8 <= nreg) {
#pragma unroll
          for (int i8 = 0; i8 < 8; ++i8) { const int i = q8 * 8 + i8; const unsigned k_ = key[i];
            const bool pg = k_ > thr, pe = k_ == thr;
            const unsigned long long mg = __ballot(pg), me = __ballot(pe);
            const int cg = (int)__builtin_amdgcn_mbcnt_hi((unsigned)(mg >> 32), __builtin_amdgcn_mbcnt_lo((unsigned)mg, 0u));
            const int ce = (int)__builtin_amdgcn_mbcnt_hi((unsigned)(me >> 32), __builtin_amdgcn_mbcnt_lo((unsigned)me, 0u));
            const int pose = be + ce;
            const int slot = pg ? bg + cg : ((pe && pose < TOPK) ? pose : 384 + lane);
            sl[slot] = (unsigned short)(i * 64 + lane);
            bg += __popcll(mg); be += __popcll(me); } }
        LDS_WAIT(); asm volatile("" ::: "memory");
        if (lane < 32) *((u32x4*)sel + lane) = *((const LAS u32x4*)sl + lane);
        LDS_WAIT(); asm volatile("" ::: "memory");
    }
}

__device__ __forceinline__ int rel_bucket(int n) {
    if (n < 16) return n;
    int b = 16;
    b += (n >= 19); b += (n >= 21); b += (n >= 24); b += (n >= 27); b += (n >= 31); b += (n >= 35); b += (n >= 40); b += (n >= 46);
    b += (n >= 52); b += (n >= 59); b += (n >= 67); b += (n >= 77); b += (n >= 87); b += (n >= 99); b += (n >= 113);
    return b;
}

typedef short s16x4 __attribute__((ext_vector_type(4)));
typedef unsigned short u16x4 __attribute__((ext_vector_type(4)));

__device__ __forceinline__ void phase_indexer2(const Frame& F, const Args& a) {
    unsigned char* ws = F.ws;
    const bf16_t* QI = (const bf16_t*)(ws + WS_S + S_QIDX); const bf16_t* KI = (const bf16_t*)(ws + WS_KIDX); const float* WI = (const float*)(ws + WS_WIDX);
    float* IDX = (float*)(ws + WS_S + S_INDEX);
    const int lane = F.lane, w = F.wave, r16 = lane & 15, g = lane >> 4;
    const float idx_scale = 0.08838834764831845f;
    const int nunits = NB * (SEQ / 16);
    for (int i = 0; i * F.G + F.vcu < nunits; ++i) {
        const int u = i * F.G + F.vcu; const int b = u / (SEQ / 16); int tq = u % (SEQ / 16); if (i & 1) tq = (SEQ / 16 - 1) - tq;
        const size_t row0 = (size_t)b * SEQ + tq * 16;
        __syncthreads();
        { bf16x8 qv[8];
#pragma unroll
          for (int k = 0; k < 8; ++k) { const int f = w * 8 + k, h = f >> 2, ks = f & 3; qv[k] = *(const bf16x8*)(QI + (row0 + r16) * 2048 + h * 128 + 32 * ks + 8 * g); }
          __builtin_amdgcn_sched_barrier(0);
#pragma unroll
          for (int k = 0; k < 8; ++k) *(LAS bf16x8*)(F.lds + (w * 8 + k) * 1024 + lane * 16) = qv[k]; }
        float wq[16];
#pragma unroll
        for (int h4 = 0; h4 < 4; ++h4) { const f32x4 t4 = *(const f32x4*)(WI + (row0 + r16) * 16 + h4 * 4); wq[h4 * 4] = t4[0]; wq[h4 * 4 + 1] = t4[1]; wq[h4 * 4 + 2] = t4[2]; wq[h4 * 4 + 3] = t4[3]; }
        __syncthreads();
        const int npair = (tq >> 1) + 1;
        for (int kp = w; kp < npair; kp += 8) {
            bf16x8 ka[2][4];
#pragma unroll
            for (int t2 = 0; t2 < 2; ++t2)
#pragma unroll
                for (int ks = 0; ks < 4; ++ks) ka[t2][ks] = *(const bf16x8*)(KI + ((size_t)b * SEQ + kp * 32 + t2 * 16 + r16) * 128 + 32 * ks + 8 * g);
            f32x4 acc0 = {0.f, 0.f, 0.f, 0.f}, acc1 = {0.f, 0.f, 0.f, 0.f};
            bf16x8 qb[2][4];
#pragma unroll
            for (int ks = 0; ks < 4; ++ks) qb[0][ks] = *(const LAS bf16x8*)(F.lds + ks * 1024 + lane * 16);
#pragma unroll
            for (int h = 0; h < 16; ++h) {
                __builtin_amdgcn_sched_barrier(0);
                if (h + 1 < 16) {
#pragma unroll
                    for (int ks = 0; ks < 4; ++ks) qb[(h + 1) & 1][ks] = *(const LAS bf16x8*)(F.lds + ((h + 1) * 4 + ks) * 1024 + lane * 16); }
                __builtin_amdgcn_sched_barrier(0);
                f32x4 c0 = {0.f, 0.f, 0.f, 0.f}, c1 = {0.f, 0.f, 0.f, 0.f};
#pragma unroll
                for (int ks = 0; ks < 4; ++ks) { c0 = __builtin_amdgcn_mfma_f32_16x16x32_bf16(ka[0][ks], qb[h & 1][ks], c0, 0, 0, 0); c1 = __builtin_amdgcn_mfma_f32_16x16x32_bf16(ka[1][ks], qb[h & 1][ks], c1, 0, 0, 0); }
                const float wh = wq[h];
#pragma unroll
                for (int j = 0; j < 4; ++j) { acc0[j] += wh * fmaxf(c0[j], 0.f); acc1[j] += wh * fmaxf(c1[j], 0.f); }
            }
            float* op = IDX + (row0 + r16) * SEQ + kp * 32 + 4 * g;
            *(f32x4*)op = acc0 * idx_scale; *(f32x4*)(op + 16) = acc1 * idx_scale;
        }
    }
}


typedef short bf16x4 __attribute__((ext_vector_type(4)));
__device__ __forceinline__ void phase_attn5(const Frame& F, const Args& a, int j) {
    unsigned char* ws = F.ws;
    const bf16_t* QLT = (const bf16_t*)(ws + WS_S + S_QLAT); const bf16_t* KV = (const bf16_t*)(ws + WS_CKV);
    const unsigned short* SEL = (const unsigned short*)(ws + WS_SEL); bf16_t* OL = (bf16_t*)(ws + WS_S + S_OLAT);
    const float* RB = a.in[I_RELB];
    const int lane = F.lane, w = F.wave;
    constexpr int KROW = 1056, WBUF = 16 * KROW;
    LAS unsigned char* const L0 = F.lds;
    LAS unsigned char* const kvs = L0 + w * WBUF;
    LAS float* const rbs = (LAS float*)(L0 + 8 * WBUF);
    LAS unsigned char* const btab = (LAS unsigned char*)(rbs + 512);
    LAS float* const bmax = (LAS float*)(btab + 2048);
    LAS float* const gmx = bmax + 16;
    const float att_scale = 0.08838834764831845f;
    __syncthreads();
    rbs[F.tid] = RB[F.tid];
#pragma unroll
    for (int q = 0; q < 4; ++q) btab[F.tid * 4 + q] = (unsigned char)rel_bucket(F.tid * 4 + q);
    { const float gv = wave_max(fabsf(a.in[I_D_KVN][(size_t)j * KVL + F.tid]), lane); if (lane == 0) gmx[w] = gv; }
    __syncthreads();
    if (F.tid < 16) { float mx = rbs[F.tid];
#pragma unroll
        for (int bk = 1; bk < 32; ++bk) mx = fmaxf(mx, rbs[bk * 16 + F.tid]);
        bmax[F.tid] = mx; }
    __syncthreads();
    const bool affine = (F.G % 8 == 0) && (SEQ % (F.G / 8) == 0);
    const int per = affine ? F.G / 8 : 1;
    const int nit = affine ? SEQ / per : (T - F.vcu + F.G - 1) / F.G;
#pragma unroll 1
    for (int it = w; it < nit; it += 8) {
        int ln_ = lane; asm volatile("" : "+v"(ln_));
        const int r16 = ln_ & 15, gq = ln_ >> 4;
        const unsigned alo = (unsigned)(size_t)(kvs + (4 * gq + (r16 >> 2)) * KROW + (4 * (ln_ & 3)) * 2);
        const int m = affine ? (F.vcu / per) * SEQ + (F.vcu % per) + per * it : F.vcu + it * F.G;
        const int t = m & (SEQ - 1), nk = t + 1 < TOPK ? t + 1 : TOPK, nch = (nk + 15) >> 4;
        const char* kvb = (const char*)KV + (size_t)(m / SEQ) * SEQ * (KVL * 2);
        const unsigned short* sel = SEL + (size_t)m * TOPK;
        bf16x8 qf[16]; float ss = 0.f;
#pragma unroll
        for (int hq = 0; hq < 2; ++hq) { u32x2 q8[8];
#pragma unroll
          for (int s = 0; s < 8; ++s) q8[s] = *(const u32x2*)((const unsigned char*)QLT + ((size_t)m * NH + r16) * KVL + 32 * (8 * hq + s) + 8 * gq);
          __builtin_amdgcn_sched_barrier(0);
#pragma unroll
          for (int s = 0; s < 8; ++s) { const f32x2 a0 = __builtin_amdgcn_cvt_pk_f32_fp8((int)q8[s].x, false), a1 = __builtin_amdgcn_cvt_pk_f32_fp8((int)q8[s].x, true), a2 = __builtin_amdgcn_cvt_pk_f32_fp8((int)q8[s].y, false), a3 = __builtin_amdgcn_cvt_pk_f32_fp8((int)q8[s].y, true);
              ss += (a0[0] * a0[0] + a0[1] * a0[1]) + (a1[0] * a1[0] + a1[1] * a1[1]) + (a2[0] * a2[0] + a2[1] * a2[1]) + (a3[0] * a3[0] + a3[1] * a3[1]);
              u32x4 pk; pk.x = pk2(a0[0], a0[1]); pk.y = pk2(a1[0], a1[1]); pk.z = pk2(a2[0], a2[1]); pk.w = pk2(a3[0], a3[1]); qf[8 * hq + s] = __builtin_bit_cast(bf16x8, pk); }
          __builtin_amdgcn_sched_barrier(0); }
        ss *= (1.0f / 256.0f);
        ss += shx(ss, 16, lane); ss += shx(ss, 32, lane);
        float kvn = gmx[0];
#pragma unroll
        for (int q = 1; q < 8; ++q) kvn = fmaxf(kvn, gmx[q]);
        kvn *= 22.62741699796952f * 1.01f;
        const float Mref = fminf(sqrtf(ss) * kvn * att_scale, 60.0f) + bmax[r16];
        f32x4 oacc[32];
#pragma unroll
        for (int dt = 0; dt < 32; ++dt) oacc[dt] = (f32x4){0.f, 0.f, 0.f, 0.f};
        float Lw = 0.f;
        int selv = (r16 < nk) ? (int)sel[r16] : 0;
        u16x4 s4 = *(const u16x4*)(sel + 4 * gq);
#pragma unroll 1
        for (int c = 0; c < nch; ++c) {
            const int kn = (c + 1) * 16 + r16; int selvn = 0; u16x4 s4n = s4;
            if (c + 1 < nch) { selvn = (kn < nk) ? (int)sel[kn] : 0; s4n = *(const u16x4*)(sel + (c + 1) * 16 + 4 * gq); }
#pragma unroll
            for (int i = 0; i < 16; ++i) { const unsigned off = ((unsigned)__builtin_amdgcn_readlane(selv, i) << 10) + (unsigned)lane * 16u;
                __builtin_amdgcn_global_load_lds((const unsigned*)(kvb + off), (LAS unsigned*)(kvs + i * KROW), 16, 0, 0); }
            asm volatile("s_waitcnt vmcnt(0)" ::: "memory");
            f32x4 st0 = {0.f, 0.f, 0.f, 0.f}, st1 = {0.f, 0.f, 0.f, 0.f};
#pragma unroll
            for (int sg = 0; sg < 4; ++sg) { bf16x8 a4[4];
#pragma unroll
                for (int u = 0; u < 4; ++u) a4[u] = *(const LAS bf16x8*)(kvs + r16 * KROW + 64 * (4 * sg + u) + 16 * gq);
                __builtin_amdgcn_sched_barrier(0);
                st0 = __builtin_amdgcn_mfma_f32_16x16x32_bf16(a4[0], qf[4 * sg], st0, 0, 0, 0); st1 = __builtin_amdgcn_mfma_f32_16x16x32_bf16(a4[1], qf[4 * sg + 1], st1, 0, 0, 0);
                st0 = __builtin_amdgcn_mfma_f32_16x16x32_bf16(a4[2], qf[4 * sg + 2], st0, 0, 0, 0); st1 = __builtin_amdgcn_mfma_f32_16x16x32_bf16(a4[3], qf[4 * sg + 3], st1, 0, 0, 0);
                __builtin_amdgcn_sched_barrier(0); }
            const f32x4 st = st0 + st1;
            float p[4]; bool vv[4]; int bk[4]; float bb[4];
#pragma unroll
            for (int e = 0; e < 4; ++e) { vv[e] = (c * 16 + 4 * gq + e) < nk; const int d = vv[e] ? t - (int)s4[e] : 0; bk[e] = (int)btab[d]; }
            __builtin_amdgcn_sched_barrier(0);
#pragma unroll
            for (int e = 0; e < 4; ++e) bb[e] = rbs[bk[e] * NH + r16];
            __builtin_amdgcn_sched_barrier(0);
#pragma unroll
            for (int e = 0; e < 4; ++e) { const float pe = __expf(st[e] * (att_scale * 0.0625f) + bb[e] - Mref); p[e] = vv[e] ? pe : 0.f; }
            Lw += (p[0] + p[1]) + (p[2] + p[3]);
            u32x2 pw; pw.x = pk2(p[0], p[1]); pw.y = pk2(p[2], p[3]);
            const bf16x4 pf = __builtin_bit_cast(bf16x4, pw);
#pragma unroll
            for (int q8 = 0; q8 < 4; ++q8) {
                bf16x4 ka[8];
                if (q8 == 0) asm volatile("ds_read_b64_tr_b16 %0, %8\n\tds_read_b64_tr_b16 %1, %8 offset:32\n\tds_read_b64_tr_b16 %2, %8 offset:64\n\tds_read_b64_tr_b16 %3, %8 offset:96\n\tds_read_b64_tr_b16 %4, %8 offset:128\n\tds_read_b64_tr_b16 %5, %8 offset:160\n\tds_read_b64_tr_b16 %6, %8 offset:192\n\tds_read_b64_tr_b16 %7, %8 offset:224\n\ts_waitcnt lgkmcnt(0)"
                    : "=&v"(ka[0]), "=&v"(ka[1]), "=&v"(ka[2]), "=&v"(ka[3]), "=&v"(ka[4]), "=&v"(ka[5]), "=&v"(ka[6]), "=&v"(ka[7]) : "v"(alo) : "memory");
                if (q8 == 1) asm volatile("ds_read_b64_tr_b16 %0, %8 offset:256\n\tds_read_b64_tr_b16 %1, %8 offset:288\n\tds_read_b64_tr_b16 %2, %8 offset:320\n\tds_read_b64_tr_b16 %3, %8 offset:352\n\tds_read_b64_tr_b16 %4, %8 offset:384\n\tds_read_b64_tr_b16 %5, %8 offset:416\n\tds_read_b64_tr_b16 %6, %8 offset:448\n\tds_read_b64_tr_b16 %7, %8 offset:480\n\ts_waitcnt lgkmcnt(0)"
                    : "=&v"(ka[0]), "=&v"(ka[1]), "=&v"(ka[2]), "=&v"(ka[3]), "=&v"(ka[4]), "=&v"(ka[5]), "=&v"(ka[6]), "=&v"(ka[7]) : "v"(alo) : "memory");
                if (q8 == 2) asm volatile("ds_read_b64_tr_b16 %0, %8 offset:512\n\tds_read_b64_tr_b16 %1, %8 offset:544\n\tds_read_b64_tr_b16 %2, %8 offset:576\n\tds_read_b64_tr_b16 %3, %8 offset:608\n\tds_read_b64_tr_b16 %4, %8 offset:640\n\tds_read_b64_tr_b16 %5, %8 offset:672\n\tds_read_b64_tr_b16 %6, %8 offset:704\n\tds_read_b64_tr_b16 %7, %8 offset:736\n\ts_waitcnt lgkmcnt(0)"
                    : "=&v"(ka[0]), "=&v"(ka[1]), "=&v"(ka[2]), "=&v"(ka[3]), "=&v"(ka[4]), "=&v"(ka[5]), "=&v"(ka[6]), "=&v"(ka[7]) : "v"(alo) : "memory");
                if (q8 == 3) asm volatile("ds_read_b64_tr_b16 %0, %8 offset:768\n\tds_read_b64_tr_b16 %1, %8 offset:800\n\tds_read_b64_tr_b16 %2, %8 offset:832\n\tds_read_b64_tr_b16 %3, %8 offset:864\n\tds_read_b64_tr_b16 %4, %8 offset:896\n\tds_read_b64_tr_b16 %5, %8 offset:928\n\tds_read_b64_tr_b16 %6, %8 offset:960\n\tds_read_b64_tr_b16 %7, %8 offset:992\n\ts_waitcnt lgkmcnt(0)"
                    : "=&v"(ka[0]), "=&v"(ka[1]), "=&v"(ka[2]), "=&v"(ka[3]), "=&v"(ka[4]), "=&v"(ka[5]), "=&v"(ka[6]), "=&v"(ka[7]) : "v"(alo) : "memory");
#pragma unroll
                for (int e = 0; e < 8; ++e) oacc[q8 * 8 + e] = __builtin_amdgcn_mfma_f32_16x16x16bf16_1k(ka[e], pf, oacc[q8 * 8 + e], 0, 0, 0);
            }
            selv = selvn; s4 = s4n;
        }
        Lw += shx(Lw, 16, lane); Lw += shx(Lw, 32, lane);
        const float inv = 1.0f / Lw;
        int m2_ = m; asm volatile("" : "+s"(m2_));
        bf16_t* op = OL + (size_t)m2_ * (NH * KVL) + r16 * KVL + 4 * gq;
#pragma unroll
        for (int dt = 0; dt < 32; ++dt) { u32x2 o; o.x = pk2(oacc[dt][0] * inv, oacc[dt][1] * inv); o.y = pk2(oacc[dt][2] * inv, oacc[dt][3] * inv); *(u32x2*)(op + 16 * dt) = o; }
    }
    __syncthreads();
}

constexpr int NWAVES = 8;
constexpr int PH_PER_LAYER = 16, N_PHASES = DEPTH * PH_PER_LAYER;
__global__ void __launch_bounds__(NWAVES * 64, 2) fwd(Args args) {
    extern __shared__ __attribute__((aligned(16))) unsigned char lds[];
    Frame F;
    F.lds = (LAS unsigned char*)lds;
    F.MISC = (volatile LAS unsigned*)(F.lds + MISC_OFF);
    F.tid = threadIdx.x; F.lane = F.tid & 63; F.wave = __builtin_amdgcn_readfirstlane(F.tid >> 6);
    F.G = gridDim.x; { const int bx = blockIdx.x; F.vcu = (F.G % 8 == 0) ? (bx % 8) * (F.G / 8) + bx / 8 : bx; }
    F.gw = F.vcu * NWAVES + F.wave; F.NGW = F.G * NWAVES;
    F.ctl = (gu32*)(args.ws + WS_CTL); F.ws = args.ws;
    for (int u = F.tid; u < (LDS_BYTES - LDSCTL_OFF) / 4; u += NWAVES * 64) ((LAS unsigned*)(F.lds + LDSCTL_OFF))[u] = 0u;
    __syncthreads();
    const int lo = args.ph_lo, hi = args.ph_hi;
    const bool single = (hi - lo) > 1;
    XcdBarrier bar; bar.bar = (unsigned*)(F.ctl + CW_BAR); bar.x = 0; bar.st = nullptr;
    if (single) bar = xcd_barrier_post((unsigned*)(F.ctl + CW_BAR), F.MISC + 8, F.tid);
#define IN(k) (lo <= (k) && (k) < hi)
#define SEAM() do { if (single) { int l2_; asm volatile("v_mbcnt_lo_u32_b32 %0, -1, 0\n\tv_mbcnt_hi_u32_b32 %0, -1, %0" : "=v"(l2_)); xcd_barrier(bar, (F.wave == 0 && l2_ == 0) ? 0 : 1); } } while (0)
    const int c = (int)blockIdx.x;
    const auto kargs = __builtin_amdgcn_kernarg_segment_ptr();
    const int wave0 = __builtin_amdgcn_readfirstlane((int)(threadIdx.x >> 6));
    static_assert(offsetof(Args, ws) == 0x108, "PHB reloads ws from kernarg offset 0x108");
#define PHB() unsigned char* ws; { unsigned long long w_; asm volatile("s_load_dwordx2 %0, %1, 0x108\n\ts_waitcnt lgkmcnt(0)" : "=s"(w_) : "s"(kargs) : "memory"); ws = (unsigned char*)(GAS unsigned char*)w_;     \
        int ln_; asm volatile("v_mbcnt_lo_u32_b32 %0, -1, 0\n\tv_mbcnt_hi_u32_b32 %0, -1, %0" : "=v"(ln_)); \
        int wv_ = __builtin_amdgcn_readfirstlane(wave0); asm volatile("" : "+s"(wv_)); \
        F.tid = wv_ * 64 + ln_; F.lane = ln_; F.wave = wv_; F.gw = F.vcu * NWAVES + wv_; F.ws = ws; F.ctl = (gu32*)ws; }
#define TP_BEG(id) do { } while (0)
#define TP_END() do { } while (0)
    for (int li = -1; li < DEPTH; ++li) {
        const int pb = li * PH_PER_LAYER, j = li >> 1;
        if (li >= 0) {
        if ((li & 1) == 0) {
            if (PON(1) && IN(pb + 1)) for (int rp_ = 0; rp_ < 1 + (int)PREP(1); ++rp_) { TP_BEG(1); PHB();
                pg8::Gemm g{(const bf16_t*)(ws + WS_H16), (const bf16_t*)(ws + WS_WMIX + WM_S5_IN), D, D, D, 0, 0}; pg8::SchedGrid S{T / 256, D / 256, 1, F.G, c};
                pg8::EpiStoreBf16 E{(bf16_t*)(ws + WS_S + S_U16), D, 0, 0, 0};
                pg8::gemm_phase(F.lds, g, S, E, F.wave, F.lane); SEAM(); TP_END(); }
            if (PON(2) && IN(pb + 2)) for (int rp_ = 0; rp_ < 1 + (int)PREP(2); ++rp_) { TP_BEG(2); PHB(); phase_ssm2(F, args); SEAM(); TP_END(); }
            if (PON(3) && IN(pb + 3)) for (int rp_ = 0; rp_ < 1 + (int)PREP(3); ++rp_) { TP_BEG(3); PHB();
                pg8::Gemm g{(const bf16_t*)(ws + WS_S + S_Z16), (const bf16_t*)(ws + WS_WMIX + WM_S5_GLU), D, D, D, 0, 0}; pg8::SchedGrid S{T / 256, D / 256, 1, F.G, c};
                pg8::EpiGlu E{(const bf16_t*)(ws + WS_S + S_Z16), (bf16_t*)(ws + WS_S + S_ZZ16), D};
                pg8::gemm_phase(F.lds, g, S, E, F.wave, F.lane); SEAM(); TP_END(); }
            if (PON(4) && IN(pb + 4)) for (int rp_ = 0; rp_ < 1 + (int)PREP(4); ++rp_) { TP_BEG(4); PHB();
                pg8::Gemm g{(const bf16_t*)(ws + WS_S + S_ZZ16), (const bf16_t*)(ws + WS_WMIX + WM_S5_OUT), D, D, D, 0, 0}; pg8::SchedGrid S{T / 256, D / 256, 1, F.G, c};
                pg8::EpiResid E{(bf16_t*)(ws + WS_H16), D, DN_ALPHA};
                pg8::gemm_phase(F.lds, g, S, E, F.wave, F.lane); SEAM(); TP_END(); }
        } else {
            if (PON(17) && IN(pb + 1)) for (int rp_ = 0; rp_ < 1 + (int)PREP(17); ++rp_) { TP_BEG(17); PHB();
                pg8::Gemm g{(const bf16_t*)(ws + WS_H16), (const bf16_t*)(ws + WS_WMIX + WM_D_IN), D, D, D, 0, 0}; pg8::SchedGrid S{T / 256, 4, 1, F.G, c};
                pg8::EpiDsaIn E{(bf16_t*)(ws + WS_CQ), (bf16_t*)(ws + WS_CKV), (bf16_t*)(ws + WS_KIDX), (float*)(ws + WS_WIDX), 0};
                pg8::gemm_phase(F.lds, g, S, E, F.wave, F.lane);
                SEAM(); TP_END(); }
            if (PON(18) && IN(pb + 2)) for (int rp_ = 0; rp_ < 1 + (int)PREP(18); ++rp_) { TP_BEG(18); PHB(); phase_rms(F, args, j); SEAM(); TP_END(); }
            if (PON(19) && IN(pb + 3)) for (int rp_ = 0; rp_ < 1 + (int)PREP(19); ++rp_) { TP_BEG(19); PHB();
                { const int ntail = T / 256;
                  pg8::Gemm g{(const bf16_t*)(ws + WS_H16), (const bf16_t*)(ws + WS_WMIX + WM_D_IN) + (size_t)4 * 256 * D, D, D, D, 0, 0}; pg8::SchedGrid S{ntail, 1, 1, F.G, c};
                  pg8::EpiDsaIn E{(bf16_t*)(ws + WS_CQ), (bf16_t*)(ws + WS_CKV), (bf16_t*)(ws + WS_KIDX), (float*)(ws + WS_WIDX), 4};
                  pg8::gemm_phase(F.lds, g, S, E, F.wave, F.lane); }
                pg8::Gemm g{(const bf16_t*)(ws + WS_CQ), (const bf16_t*)(ws + WS_WMIX + WM_D_Q), QL, QL, QL, 0, 0};
                pg8::SchedGridSplit S{pg8::SchedGrid{T / 256, 4096 / 256, 1, F.G, c}, (T / 256 < F.G) ? T / 256 : 0, 4};
                pg8::EpiStoreBf16 E{(bf16_t*)(ws + WS_S + S_Q16), 2048, 0, 2048, (size_t)(S_QIDX - S_Q16) / 2};
                pg8::gemm_phase(F.lds, g, S, E, F.wave, F.lane); SEAM(); TP_END(); }
            if (PON(20) && IN(pb + 4)) for (int rp_ = 0; rp_ < 1 + (int)PREP(20); ++rp_) { TP_BEG(20); PHB();
                pg8::Gemm g{(const bf16_t*)(ws + WS_S + S_Q16), (const bf16_t*)(ws + WS_WMIX + WM_D_UK), 2048, 128, 128, 128, 512 * 128}; pg8::SchedGrid S{T / 256, 512 / 256, 16, F.G, c};
                pg8::EpiStoreFp8 E{(unsigned char*)(ws + WS_S + S_QLAT), NH * KVL, 512};
                pg8::gemm_phase(F.lds, g, S, E, F.wave, F.lane); TP_END(); }
            if (PON(21) && IN(pb + 5)) for (int rp_ = 0; rp_ < 1 + (int)PREP(21); ++rp_) { TP_BEG(21); PHB(); phase_indexer2(F, args); SEAM(); TP_END(); }
            if (PON(22) && IN(pb + 6)) for (int rp_ = 0; rp_ < 1 + (int)PREP(22); ++rp_) { TP_BEG(22); PHB(); phase_topk(F, args); SEAM(); TP_END(); }
            if (PON(23) && IN(pb + 7)) for (int rp_ = 0; rp_ < 1 + (int)PREP(23); ++rp_) { TP_BEG(23); PHB(); phase_attn5(F, args, j); SEAM(); TP_END(); }
            if (PON(24) && IN(pb + 8)) for (int rp_ = 0; rp_ < 1 + (int)PREP(24); ++rp_) { TP_BEG(24); PHB();
                pg8::Gemm g{(const bf16_t*)(ws + WS_S + S_OLAT), (const bf16_t*)(ws + WS_WMIX + WM_D_UV), NH * KVL, 1024, 1024, 1024, 256 * 1024}; pg8::SchedGrid S{T / 256, 1, 8, F.G, c};
                pg8::EpiStoreBf16 E{(bf16_t*)(ws + WS_S + S_O16), D, 256, 0, 0};
                pg8::gemm_phase(F.lds, g, S, E, F.wave, F.lane); SEAM(); TP_END(); }
            if (PON(25) && IN(pb + 9)) for (int rp_ = 0; rp_ < 1 + (int)PREP(25); ++rp_) { TP_BEG(25); PHB();
                pg8::Gemm g{(const bf16_t*)(ws + WS_S + S_O16), (const bf16_t*)(ws + WS_WMIX + WM_D_OUT), D, D, D, 0, 0}; pg8::SchedGrid S{T / 256, D / 256, 1, F.G, c};
                pg8::EpiResid E{(bf16_t*)(ws + WS_H16), D, DN_ALPHA};
                pg8::gemm_phase(F.lds, g, S, E, F.wave, F.lane); SEAM(); TP_END(); }
        }
        if (PON(15) && IN(pb + 15)) for (int rp_ = 0; rp_ < 1 + (int)PREP(15); ++rp_) { TP_BEG(15); PHB(); phase_router(F, args, li); SEAM(); TP_END(); }
        if (PON(12) && IN(pb + 12)) for (int rp_ = 0; rp_ < 1 + (int)PREP(12); ++rp_) { TP_BEG(12); PHB();
            moe_table(F, li);
            const LAS int* tab = (const LAS int*)(F.lds + MOETAB_OFF);
            unsigned* dep = (unsigned*)(F.ctl + CW_DEP + li * 192 * 16);
            { pg8::SchedMoe S{tab, 1, F.G, F.vcu};
              LAS int* gtok = (LAS int*)(F.lds + RING_BYTES);
              { const unsigned* LIST = (const unsigned*)(ws + WS_LIST);
#pragma unroll
                for (int ui = 0; ui < 3; ++ui) { pg8::Unit u; if (S.next(ui, u) && F.tid < 256) { const int slot = u.pm * 256 + F.tid - tab[1 + u.pb];
                      gtok[ui * 256 + F.tid] = slot < tab[34 + u.pb] ? (int)(LIST[(size_t)u.pb * T + slot] & 0x7fffffffu) : 0; } } }
              __syncthreads();
              pg8::Gemm g{(const bf16_t*)(ws + WS_H16), (const bf16_t*)(ws + WS_WMOE + WE_GU), D, D, D, 0, 512 * D};
              pg8::EpiMoe1 E{(bf16_t*)(ws + WS_S + S_HMID), (const float*)(ws + WS_GWL), tab, dep};
              pg8::gemm_phase<pg8::EpiMoe1, pg8::SchedMoe, true>(F.lds, g, S, E, F.wave, F.lane, gtok); }
            { pg8::Gemm g{(const bf16_t*)(ws + WS_S + S_HMID), (const bf16_t*)(ws + WS_WMOE + WE_DN), FF, FF, FF, 0, D * FF}; pg8::SchedMoe2 S{tab, dep, F.G, F.vcu};
              pg8::EpiMoe2 E{(unsigned char*)(ws + WS_S + S_Y0), (unsigned char*)(ws + WS_S + S_Y1), (const unsigned*)(ws + WS_LIST), tab};
              pg8::gemm_phase(F.lds, g, S, E, F.wave, F.lane); }
            SEAM(); TP_END(); }
        }
        if (PON(14)) for (int rp_ = 0; rp_ < 1 + (int)PREP(14); ++rp_) { TP_BEG(14); PHB(); if (li >= 0) phase_ln<1>(F, args, li, F.gw, F.NGW, T);
            if (li + 1 < DEPTH) phase_conv(F, args, li + 1);
            SEAM(); TP_END(); }
    }
#undef IN
#undef SEAM
#undef PHB
}

extern "C" void kernel_launch(void* const* d_in, const int* in_sizes, int n_in, void* d_out, int out_size, void* d_ws, size_t ws_size, hipStream_t stream) {
    static int grid = 0;
    if (grid == 0) {
        if (n_in != 32 || out_size != T * D || ws_size < WS_END) { fprintf(stderr, "kernel_launch: unexpected problem (n_in %d, out %d, ws %zu)\n", n_in, out_size, ws_size); grid = -1; return; }
        int dev = 0, cus = 0, per_cu = 0;
        if (hipGetDevice(&dev) != hipSuccess || hipDeviceGetAttribute(&cus, hipDeviceAttributeMultiprocessorCount, dev) != hipSuccess) { grid = -1; return; }
        if (hipFuncSetAttribute((const void*)fwd, hipFuncAttributeMaxDynamicSharedMemorySize, LDS_BYTES) != hipSuccess) { fprintf(stderr, "kernel_launch: hipFuncSetAttribute failed\n"); grid = -1; return; }
        if (hipOccupancyMaxActiveBlocksPerMultiprocessor(&per_cu, (const void*)fwd, NWAVES * 64, LDS_BYTES) != hipSuccess || per_cu < 1) fprintf(stderr, "kernel_launch: occupancy query reports %d\n", per_cu);
        (void)hipGetLastError();
        grid = cus;
    }
    if (grid < 0) return;
    (void)hipMemsetAsync((char*)d_ws + WS_CTL, 0, CTL_ZERO_BYTES, stream);
    Args a{};
    for (int i = 0; i < 32; ++i) a.in[i] = (const float*)d_in[i];
    a.out = (float*)d_out; a.ws = (unsigned char*)d_ws;
    a.ph_lo = 0; a.ph_hi = N_PHASES;
    hipLaunchKernelGGL(fwd, dim3(grid), dim3(NWAVES * 64), LDS_BYTES, stream, a);
}
```

```cpp
#include <hip/hip_runtime.h>
#include <cstdio>
#include <cstdint>
#include <cstddef>


#ifndef MK_PHMASK
#define MK_PHMASK 0xffffffffu
#endif
#define PON(k) (((MK_PHMASK) >> (k)) & 1u)
#ifndef MK_REPEAT
#define MK_REPEAT 0u
#endif
#define PREP(k) (((MK_REPEAT) >> (k)) & 1u)
#define LAS __attribute__((address_space(3)))
#define GAS __attribute__((address_space(1)))
typedef unsigned short bf16_t;
typedef short bf16x8 __attribute__((ext_vector_type(8)));
typedef float f32x4 __attribute__((ext_vector_type(4)));
typedef float f32x2 __attribute__((ext_vector_type(2)));
typedef unsigned u32x4 __attribute__((ext_vector_type(4)));
typedef unsigned u32x2 __attribute__((ext_vector_type(2)));
typedef GAS unsigned gu32;

constexpr int NB = 8, SEQ = 2048, T = NB * SEQ, D = 2048, DEPTH = 4;
constexpr int S5G = 128, S5P = 16, S5N = 64;
constexpr int NH = 16, HD = 128, QL = 512, KVL = 512, IDXD = 128, TOPK = 256;
constexpr int DSA_IN = QL + KVL + IDXD + NH;
constexpr int DSA_IN_PAD = 1280;
constexpr int NE = 32, EPG = 8, NG = 4, FF = 256;
constexpr float LN_EPS = 1e-5f, RMS_EPS = 1e-6f;
constexpr float DN_ALPHA = 1.6817928305074290f;
constexpr int MAXPOS = 40960;

constexpr size_t MiB = 1u << 20;
constexpr size_t WS_CTL = 0, CTL_ZERO_BYTES = 1 * MiB;
constexpr size_t WS_RT = 1 * MiB;
constexpr size_t WS_S5C = 2 * MiB;
constexpr size_t WS_LIST = 4 * MiB;
constexpr size_t WS_GWL = 6 * MiB;
constexpr size_t WS_TPOS = 8 * MiB;
constexpr size_t WS_GPOS = 9 * MiB;
constexpr size_t WS_WIDX = 10 * MiB;
constexpr size_t WS_KIDX = 12 * MiB;
constexpr size_t WS_SEL = 16 * MiB;
constexpr size_t WS_CQ = 24 * MiB;
constexpr size_t WS_CKV = 40 * MiB;
constexpr size_t WS_WMIX = 56 * MiB;
constexpr size_t WS_WMOE = 88 * MiB;
constexpr size_t WS_H32 = 184 * MiB;
constexpr size_t WS_H16 = 312 * MiB;
constexpr size_t WS_S = 376 * MiB;
constexpr size_t WS_S5T = 888 * MiB;
constexpr size_t S5T_FD = 0, S5T_WS = 2 * MiB, S5T_WY = 10 * MiB, S5T_A16 = 18 * MiB;
constexpr size_t WS_END = 908 * MiB;
constexpr size_t WM_S5_IN = 0, WM_S5_GLU = 8 * MiB, WM_S5_OUT = 16 * MiB;
constexpr size_t WM_D_IN = 0  , WM_D_Q = 6 * MiB  , WM_D_UK = 10 * MiB  , WM_D_UV = 14 * MiB  , WM_D_OUT = 18 * MiB  ;
constexpr size_t WE_GU = 0, WE_DN = 64 * MiB;
constexpr size_t S_U16 = 0, S_Z16 = 64 * MiB, S_ZZ16 = 128 * MiB;
constexpr size_t S_QLAT = 0, S_O16 = 0, S_Q16 = 256 * MiB, S_QIDX = 320 * MiB, S_INDEX = 384 * MiB, S_OLAT = 256 * MiB;
constexpr size_t S_XS = 0, S_HMID = 160 * MiB, S_Y0 = 192 * MiB, S_Y1 = 256 * MiB, S_H16LO = 320 * MiB;
constexpr int CW_TMO = 0, CW_CODE = 1, CW_BAR = 4096, CW_CNT = 16384, CW_DEP = 65536;

constexpr int RING_BYTES = 131072;
constexpr int LDSCTL_OFF = 159744, MISC_OFF = LDSCTL_OFF + 320;
constexpr int MOETAB_OFF = LDSCTL_OFF + 1024;
constexpr int LDS_BYTES = 163840;

#define RLX_AGENT __ATOMIC_RELAXED, __HIP_MEMORY_SCOPE_AGENT
#define LDS_WAIT() asm volatile("s_waitcnt lgkmcnt(0)" ::: "memory")
#define VM_WAIT() asm volatile("s_waitcnt vmcnt(0)" ::: "memory")

__device__ __forceinline__ unsigned f2bf(float f) { unsigned u = __builtin_bit_cast(unsigned, f); return (u + 0x7fffu + ((u >> 16) & 1u)) >> 16; }
__device__ __forceinline__ unsigned pk2(float lo, float hi) { return f2bf(lo) | (f2bf(hi) << 16); }
__device__ __forceinline__ float bf2f(unsigned b) { return __builtin_bit_cast(float, b << 16); }
__device__ __forceinline__ float bflo(unsigned w) { return __builtin_bit_cast(float, w << 16); }
__device__ __forceinline__ float bfhi(unsigned w) { return __builtin_bit_cast(float, w & 0xffff0000u); }
__device__ __forceinline__ int shx_i(int v, int o, int lane) { return __builtin_amdgcn_ds_bpermute((lane ^ o) << 2, v); }
__device__ __forceinline__ float shx(float v, int o, int lane) { return __builtin_bit_cast(float, __builtin_amdgcn_ds_bpermute((lane ^ o) << 2, __builtin_bit_cast(int, v))); }
#define DPP_F(x, ctrl) __builtin_bit_cast(float, __builtin_amdgcn_update_dpp(0, __builtin_bit_cast(int, (x)), (ctrl), 0xf, 0xf, false))
__device__ __forceinline__ float wave_sum(float v, int lane) {
    (void)lane;
    float t = v;
    t += DPP_F(t, 0xB1);
    t += DPP_F(t, 0x4E);
    t += DPP_F(t, 0x141);
    t += DPP_F(t, 0x140);
    const float s0 = __builtin_bit_cast(float, __builtin_amdgcn_readlane(__builtin_bit_cast(int, t), 0)), s1 = __builtin_bit_cast(float, __builtin_amdgcn_readlane(__builtin_bit_cast(int, t), 16));
    const float s2 = __builtin_bit_cast(float, __builtin_amdgcn_readlane(__builtin_bit_cast(int, t), 32)), s3 = __builtin_bit_cast(float, __builtin_amdgcn_readlane(__builtin_bit_cast(int, t), 48));
    return (s0 + s1) + (s2 + s3);
}
__device__ __forceinline__ float wave_max(float v, int lane) {
#pragma unroll
    for (int o = 1; o < 64; o <<= 1) v = fmaxf(v, shx(v, o, lane));
    return v;
}

namespace pg8 {
constexpr int BM = 256, BK = 64, HALF = 128, HTB = HALF * BK * 2, STAGE_BYTES = 8 * HTB, NXCD = 8, WGM = 8;
__host__ __device__ __forceinline__ int lds_byte(int r, int c) { const int st = (r >> 4) * 2 + (c >> 5), rr = r & 15, cc = c & 31, ob = rr * 64 + cc * 2; return st * 1024 + (ob ^ (((ob >> 9) & 1) << 5)); }
__host__ __device__ __forceinline__ void stage_rc(int b, int& R, int& C) { const int st = b / 1024, sb = b % 1024, swz = sb ^ (((sb >> 9) & 1) << 5); R = (st >> 1) * 16 + swz / 64; C = (st & 1) * 32 + (swz % 64) / 2; }
__host__ __device__ __forceinline__ int perm32(int rho) { const int n = rho >> 4, i = rho & 15; return 8 * (i >> 2) + 4 * n + (i & 3); }

struct Unit { int pm, pn, pb; };
struct Gemm { const bf16_t* A; const bf16_t* Bt; int lda, ldb, K; long long sA, sB; };

struct SchedGrid {
    int nM, nN, nB, G, c;
    __device__ __forceinline__ bool next(int i, Unit& u) const { return unit((long)i * G + c, u); }
    __device__ __forceinline__ bool unit(long L, Unit& u) const {
        const int per = nM * nN, nwg = per * nB; if (L >= nwg) return false;
        int wgid = (int)L; { const int q = nwg / NXCD, r = nwg % NXCD, xcd = wgid % NXCD, off = wgid / NXCD; wgid = (xcd < r ? xcd * (q + 1) : r * (q + 1) + (xcd - r) * q) + off; }
        u.pb = wgid / per; const int w = wgid % per;
        const int nig = WGM * nN, gid = w / nig, fm = gid * WGM, gsz = (nM - fm) < WGM ? (nM - fm) : WGM;
        u.pm = fm + ((w % nig) % gsz); u.pn = (w % nig) / gsz; return true;
    }
};
struct SchedGridSplit {
    SchedGrid base; int thr, KA;
    __device__ __forceinline__ bool next(int i, Unit& u) const {
        const int G = base.G, c = base.c, U2 = base.nM * base.nN * base.nB, nl = G - thr;
        const int NA = (KA * nl < U2) ? KA * nl : U2;
        long L;
        if (c >= thr) { const int q = c - thr; const int ra = q < NA ? (NA - q + nl - 1) / nl : 0;
            L = i < ra ? (long)q + (long)i * nl : (long)NA + c + (long)(i - ra) * G; }
        else L = (long)NA + c + (long)i * G;
        return base.unit(L, u);
    }
};
struct SchedMoe {
    const LAS int* tab; int sh  , G, c;
    __device__ __forceinline__ bool next(int i, Unit& u) const {
        const int nmt = __builtin_amdgcn_readfirstlane(tab[0]); const long L = (long)i * G + c; if (L >= ((long)nmt << sh)) return false;
        const int mt = (int)(L >> sh); u.pm = mt; u.pn = (int)(L & ((1 << sh) - 1)); u.pb = __builtin_amdgcn_readfirstlane((int)((const LAS unsigned char*)(tab + 66))[mt]); return true;
    }
};

struct SchedMoe2 {
    const LAS int* tab; unsigned* dep; int G, c;
    static constexpr int KA = 4;
    __device__ __forceinline__ bool next(int i, Unit& u) const {
        const int nmt = __builtin_amdgcn_readfirstlane(tab[0]); const int U1 = nmt << 1, U2 = nmt << 3;
        const int maxu = (U1 + G - 1) / G, thr = U1 - G * (maxu - 1), nl = G - thr;
        const int NA = (KA * nl < U2) ? KA * nl : U2;
        long L;
        if (c >= thr) { const int q = c - thr; const int ra = q < NA ? (NA - q + nl - 1) / nl : 0;
            L = i < ra ? (long)q + (long)i * nl : (long)NA + c + (long)(i - ra) * G; }
        else L = (long)NA + c + (long)i * G;
        if (L >= U2) return false;
        const int mt = (int)(L >> 3); u.pm = mt; u.pn = (int)(L & 7); u.pb = __builtin_amdgcn_readfirstlane((int)((const LAS unsigned char*)(tab + 66))[mt]);
        unsigned sp = 0u;
        while (__hip_atomic_load(dep + 16 * mt, __ATOMIC_RELAXED, __HIP_MEMORY_SCOPE_AGENT) < 2u) { __builtin_amdgcn_s_sleep(2); if (++sp > (1u << 20)) break; }
        asm volatile("" ::: "memory");
        return true;
    }
};

__device__ __forceinline__ unsigned cvt_pk_bf16(float lo, float hi) { unsigned r; asm volatile("v_cvt_pk_bf16_f32 %0, %1, %2" : "=v"(r) : "v"(lo), "v"(hi)); return r; }

struct EpiStoreBf16 {
    static constexpr bool PERM = true; static constexpr bool SIGNAL = false;
    bf16_t* O; int ldc; int bcol; int split_cols; size_t split_stride;
    __device__ __forceinline__ void operator()(const f32x4 (&acc)[2][2][4][2], const Unit& u, int wr, int wc, int fr, int fq) const {
        const int row0 = u.pm * BM + wr * 64 + fr; int colt = u.pn * BM; bf16_t* base = O + (size_t)u.pb * bcol;
        if (split_cols) { const int t = colt / split_cols; base += (size_t)t * split_stride; colt -= t * split_cols; }
        const int col0 = colt + wc * 32 + 8 * fq;
#pragma unroll
        for (int ai = 0; ai < 2; ++ai)
#pragma unroll
            for (int m = 0; m < 4; ++m) { bf16_t* rowp = base + (size_t)(row0 + ai * HALF + m * 16) * ldc + col0;
#pragma unroll
                for (int bj = 0; bj < 2; ++bj) { const f32x4 v0 = acc[ai][bj][m][0], v1 = acc[ai][bj][m][1];
                    u32x4 w; w.x = cvt_pk_bf16(v0[0], v0[1]); w.y = cvt_pk_bf16(v0[2], v0[3]); w.z = cvt_pk_bf16(v1[0], v1[1]); w.w = cvt_pk_bf16(v1[2], v1[3]);
                    *(u32x4*)(rowp + bj * HALF) = w; } }
    }
};
struct EpiStoreFp8 {
    static constexpr bool PERM = true; static constexpr bool SIGNAL = false;
    unsigned char* O; int ldc; int bcol;
    __device__ __forceinline__ void operator()(const f32x4 (&acc)[2][2][4][2], const Unit& u, int wr, int wc, int fr, int fq) const {
        const int row0 = u.pm * BM + wr * 64 + fr; unsigned char* base = O + (size_t)u.pb * bcol;
        const int col0 = u.pn * BM + wc * 32 + 8 * fq;
#pragma unroll
        for (int ai = 0; ai < 2; ++ai)
#pragma unroll
            for (int m = 0; m < 4; ++m) { unsigned char* rowp = base + (size_t)(row0 + ai * HALF + m * 16) * ldc + col0;
#pragma unroll
                for (int bj = 0; bj < 2; ++bj) { const f32x4 v0 = acc[ai][bj][m][0] * 16.0f, v1 = acc[ai][bj][m][1] * 16.0f;
                    int p0 = __builtin_amdgcn_cvt_pk_fp8_f32(v0[0], v0[1], 0, false); p0 = __builtin_amdgcn_cvt_pk_fp8_f32(v0[2], v0[3], p0, true);
                    int p1 = __builtin_amdgcn_cvt_pk_fp8_f32(v1[0], v1[1], 0, false); p1 = __builtin_amdgcn_cvt_pk_fp8_f32(v1[2], v1[3], p1, true);
                    u32x2 w; w.x = (unsigned)p0; w.y = (unsigned)p1; *(u32x2*)(rowp + bj * HALF) = w; } }
    }
};
struct EpiGlu {
    static constexpr bool PERM = true; static constexpr bool SIGNAL = false;
    const bf16_t* Z; bf16_t* O; int ldc;
    __device__ __forceinline__ void operator()(const f32x4 (&acc)[2][2][4][2], const Unit& u, int wr, int wc, int fr, int fq) const {
        const int row0 = u.pm * BM + wr * 64 + fr, col0 = u.pn * BM + wc * 32 + 8 * fq;
        u32x4 zv[2][4][2];
#pragma unroll
        for (int ai = 0; ai < 2; ++ai)
#pragma unroll
            for (int m = 0; m < 4; ++m)
#pragma unroll
                for (int bj = 0; bj < 2; ++bj) zv[ai][m][bj] = *(const u32x4*)(Z + (size_t)(row0 + ai * HALF + m * 16) * ldc + col0 + bj * HALF);
        __builtin_amdgcn_sched_barrier(0);
#pragma unroll
        for (int ai = 0; ai < 2; ++ai) {
#pragma unroll
            for (int m = 0; m < 4; ++m) { const size_t ro = (size_t)(row0 + ai * HALF + m * 16) * ldc + col0;
#pragma unroll
                for (int bj = 0; bj < 2; ++bj) { const f32x4 v0 = acc[ai][bj][m][0], v1 = acc[ai][bj][m][1];
                    const u32x4 z = zv[ai][m][bj];
                    float r[8]; const float a[8] = {v0[0], v0[1], v0[2], v0[3], v1[0], v1[1], v1[2], v1[3]};
                    const float zz[8] = {bflo(z.x), bfhi(z.x), bflo(z.y), bfhi(z.y), bflo(z.z), bfhi(z.z), bflo(z.w), bfhi(z.w)};
#pragma unroll
                    for (int j = 0; j < 8; ++j) r[j] = zz[j] / (1.0f + __expf(-a[j]));
                    u32x4 w; w.x = cvt_pk_bf16(r[0], r[1]); w.y = cvt_pk_bf16(r[2], r[3]); w.z = cvt_pk_bf16(r[4], r[5]); w.w = cvt_pk_bf16(r[6], r[7]);
                    *(u32x4*)(O + ro + bj * HALF) = w; } }
            __builtin_amdgcn_sched_barrier(0);
        }
    }
};
struct EpiResid {
    static constexpr bool PERM = true; static constexpr bool SIGNAL = false;
    bf16_t* H; int ldc; float alpha;
    __device__ __forceinline__ void operator()(const f32x4 (&acc)[2][2][4][2], const Unit& u, int wr, int wc, int fr, int fq) const {
        const int row0 = u.pm * BM + wr * 64 + fr, col0 = u.pn * BM + wc * 32 + 8 * fq;
        u32x4 hv[2][4][2];
#pragma unroll
        for (int ai = 0; ai < 2; ++ai)
#pragma unroll
            for (int m = 0; m < 4; ++m)
#pragma unroll
                for (int bj = 0; bj < 2; ++bj) hv[ai][m][bj] = *(const u32x4*)(H + (size_t)(row0 + ai * HALF + m * 16) * ldc + col0 + bj * HALF);
        __builtin_amdgcn_sched_barrier(0);
#pragma unroll
        for (int ai = 0; ai < 2; ++ai) {
#pragma unroll
            for (int m = 0; m < 4; ++m) { bf16_t* rowp = H + (size_t)(row0 + ai * HALF + m * 16) * ldc + col0;
#pragma unroll
                for (int bj = 0; bj < 2; ++bj) { const f32x4 v0 = acc[ai][bj][m][0], v1 = acc[ai][bj][m][1]; const u32x4 h = hv[ai][m][bj];
                    u32x4 w; w.x = cvt_pk_bf16(bflo(h.x) * alpha + v0[0], bfhi(h.x) * alpha + v0[1]); w.y = cvt_pk_bf16(bflo(h.y) * alpha + v0[2], bfhi(h.y) * alpha + v0[3]);
                    w.z = cvt_pk_bf16(bflo(h.z) * alpha + v1[0], bfhi(h.z) * alpha + v1[1]); w.w = cvt_pk_bf16(bflo(h.w) * alpha + v1[2], bfhi(h.w) * alpha + v1[3]);
                    *(u32x4*)(rowp + bj * HALF) = w; } }
            __builtin_amdgcn_sched_barrier(0);
        }
    }
};
struct EpiDsaIn {
    static constexpr bool PERM = true; static constexpr bool SIGNAL = false;
    bf16_t* CQ; bf16_t* CKV; bf16_t* KIDX; float* WIDX; int pn0;
    __device__ __forceinline__ void operator()(const f32x4 (&acc)[2][2][4][2], const Unit& u0, int wr, int wc, int fr, int fq) const {
        Unit u = u0; u.pn += pn0;
        const int row0 = u.pm * BM + wr * 64 + fr, cb = wc * 32 + 8 * fq;
#pragma unroll
        for (int ai = 0; ai < 2; ++ai)
#pragma unroll
            for (int m = 0; m < 4; ++m) { const size_t row = (size_t)(row0 + ai * HALF + m * 16);
#pragma unroll
                for (int bj = 0; bj < 2; ++bj) { const f32x4 v0 = acc[ai][bj][m][0], v1 = acc[ai][bj][m][1];
                    u32x4 w; w.x = cvt_pk_bf16(v0[0], v0[1]); w.y = cvt_pk_bf16(v0[2], v0[3]); w.z = cvt_pk_bf16(v1[0], v1[1]); w.w = cvt_pk_bf16(v1[2], v1[3]);
                    if (u.pn < 2) *(u32x4*)(CQ + row * 512 + u.pn * 256 + bj * HALF + cb) = w;
                    else if (u.pn < 4) *(u32x4*)(CKV + row * 512 + (u.pn - 2) * 256 + bj * HALF + cb) = w;
                    else if (bj == 0) *(u32x4*)(KIDX + row * 128 + cb) = w;
                    else if (cb < 16) { *(f32x4*)(WIDX + row * 16 + cb) = v0 * 0.25f; *(f32x4*)(WIDX + row * 16 + cb + 4) = v1 * 0.25f; } } }
    }
};
struct EpiMoe1 {
    static constexpr bool PERM = true; static constexpr bool SIGNAL = true;
    bf16_t* HM; const float* GWL; const LAS int* tab; unsigned* dep;
    __device__ __forceinline__ void operator()(const f32x4 (&acc)[2][2][4][2], const Unit& u, int wr, int wc, int fr, int fq) const {
        const int row0 = u.pm * BM + wr * 64 + fr, cb = u.pn * 128 + wc * 32 + 8 * fq;
        const int poff = tab[1 + u.pb], cnt = tab[34 + u.pb];
        float gwv[2][4];
#pragma unroll
        for (int ai = 0; ai < 2; ++ai)
#pragma unroll
            for (int m = 0; m < 4; ++m) { const int slot = row0 + ai * HALF + m * 16 - poff; gwv[ai][m] = slot < cnt ? GWL[(size_t)u.pb * T + slot] : 0.f; }
        __builtin_amdgcn_sched_barrier(0);
#pragma unroll
        for (int ai = 0; ai < 2; ++ai)
#pragma unroll
            for (int m = 0; m < 4; ++m) { const int pos = row0 + ai * HALF + m * 16; const float gw = gwv[ai][m];
                const f32x4 g0 = acc[ai][0][m][0], g1 = acc[ai][0][m][1], u0 = acc[ai][1][m][0], u1 = acc[ai][1][m][1];
                const float g[8] = {g0[0], g0[1], g0[2], g0[3], g1[0], g1[1], g1[2], g1[3]}, uu[8] = {u0[0], u0[1], u0[2], u0[3], u1[0], u1[1], u1[2], u1[3]}; float r[8];
#pragma unroll
                for (int j = 0; j < 8; ++j) r[j] = g[j] / (1.0f + __expf(-g[j])) * uu[j] * gw;
                u32x4 w; w.x = cvt_pk_bf16(r[0], r[1]); w.y = cvt_pk_bf16(r[2], r[3]); w.z = cvt_pk_bf16(r[4], r[5]); w.w = cvt_pk_bf16(r[6], r[7]);
                *(u32x4*)(HM + (size_t)pos * 256 + cb) = w; }
    }
};
struct EpiMoe2 {
    static constexpr bool PERM = true; static constexpr bool SIGNAL = false;
    unsigned char* Y0; unsigned char* Y1; const unsigned* LIST; const LAS int* tab;
    __device__ __forceinline__ void operator()(const f32x4 (&acc)[2][2][4][2], const Unit& u, int wr, int wc, int fr, int fq) const {
        const int row0 = u.pm * BM + wr * 64 + fr, col0 = u.pn * BM + wc * 32 + 8 * fq;
        const int poff = tab[1 + u.pb], cnt = tab[34 + u.pb];
        unsigned tkv2[2][4];
#pragma unroll
        for (int ai = 0; ai < 2; ++ai)
#pragma unroll
          for (int m = 0; m < 4; ++m) { const int slot = row0 + ai * HALF + m * 16 - poff; tkv2[ai][m] = slot < cnt ? LIST[(size_t)u.pb * T + slot] : 0xffffffffu; }
        __builtin_amdgcn_sched_barrier(0);
#pragma unroll
        for (int ai = 0; ai < 2; ++ai) {
#pragma unroll
            for (int m = 0; m < 4; ++m) { const unsigned tk = tkv2[ai][m];
                if (tk != 0xffffffffu) { unsigned char* rowp = ((tk >> 31) ? Y1 : Y0) + (size_t)(tk & 0x7fffffffu) * D + col0;
#pragma unroll
                    for (int bj = 0; bj < 2; ++bj) { const f32x4 v0 = acc[ai][bj][m][0] * 16.0f, v1 = acc[ai][bj][m][1] * 16.0f;
                        int p0 = __builtin_amdgcn_cvt_pk_fp8_f32(v0[0], v0[1], 0, false); p0 = __builtin_amdgcn_cvt_pk_fp8_f32(v0[2], v0[3], p0, true);
                        int p1 = __builtin_amdgcn_cvt_pk_fp8_f32(v1[0], v1[1], 0, false); p1 = __builtin_amdgcn_cvt_pk_fp8_f32(v1[2], v1[3], p1, true);
                        u32x2 w; w.x = (unsigned)p0; w.y = (unsigned)p1; *(u32x2*)(rowp + bj * HALF) = w; } } }
        }
    }
};

template <class Epi, class Sched, bool GATHER = false>
__device__ __forceinline__ void gemm_phase(LAS unsigned char* lds, const Gemm g, const Sched& S, const Epi& E, int wid, int lane, const LAS int* gtok = nullptr) {
    const int tid = wid * 64 + lane, wr = wid >> 2, wc = wid & 3, fr = lane & 15, fq = lane >> 4;
    const int K = g.K, nt = K / BK;
    unsigned voffA[2], voffB[2];
#pragma unroll
    for (int i = 0; i < 2; ++i) { int R, C; stage_rc(tid * 16 + i * 8192, R, C); const int Rb = Epi::PERM ? ((R & ~31) + perm32(R & 31)) : R;
        voffA[i] = GATHER ? (unsigned)(R * 65536 + C * 2) : (unsigned)(R * g.lda + C) * 2u; voffB[i] = (unsigned)(Rb * g.ldb + C) * 2u; }
    const size_t kstep = (size_t)(BK * 2);
    const size_t hstepA = GATHER ? 0 : (size_t)HALF * g.lda * 2, hstepB = (size_t)HALF * g.ldb * 2;
    unsigned vc[2][2], vn[2][2];
#define PG8_GTOK(dst, ui_) do { _Pragma("unroll") for (int h_ = 0; h_ < 2; ++h_) _Pragma("unroll") for (int i_ = 0; i_ < 2; ++i_) \
        dst[h_][i_] = (unsigned)gtok[(ui_) * 256 + h_ * HALF + (int)(voffA[i_] >> 16)] * (unsigned)(g.lda * 2) + (voffA[i_] & 0xffffu); } while (0)
    const unsigned ldsw = (unsigned)wid * 1024u;
    const int aoff = lds_byte(wr * 64 + fr, fq * 8), boff = lds_byte(wc * 32 + fr, fq * 8);
#define PG8_SA(b, h) (((b) * 2 + (h)) * HTB)
#define PG8_SB(b, h) ((4 + (b) * 2 + (h)) * HTB)
#define PG8_STAGE(bufoff, gbase, voff) do { _Pragma("unroll") for (int _i = 0; _i < 2; ++_i) \
        __builtin_amdgcn_global_load_lds((const unsigned*)((const char*)(gbase) + (voff)[_i]), (LAS unsigned*)(lds + (bufoff) + ldsw + _i * 8192), 16, 0, 0); } while (0)
#define PG8_LDA(dst, b, h) do { _Pragma("unroll") for (int m = 0; m < 4; ++m) _Pragma("unroll") for (int k = 0; k < 2; ++k) dst[m][k] = *(const LAS bf16x8*)(lds + PG8_SA(b, h) + aoff + m * 2048 + k * 1024); } while (0)
#define PG8_LDB(dst, b, h) do { _Pragma("unroll") for (int n = 0; n < 2; ++n) _Pragma("unroll") for (int k = 0; k < 2; ++k) dst[n][k] = *(const LAS bf16x8*)(lds + PG8_SB(b, h) + boff + n * 2048 + k * 1024); } while (0)
#define PG8_MMA(ai, bj, At, Bt) do { __builtin_amdgcn_s_setprio(1); _Pragma("unroll") for (int m = 0; m < 4; ++m) _Pragma("unroll") for (int n = 0; n < 2; ++n) _Pragma("unroll") for (int k = 0; k < 2; ++k) \
        acc[ai][bj][m][n] = __builtin_amdgcn_mfma_f32_16x16x32_bf16(Bt[n][k], At[m][k], acc[ai][bj][m][n], 0, 0, 0); __builtin_amdgcn_s_setprio(0); } while (0)
#define PG8_WAIT_V(n) asm volatile("s_waitcnt vmcnt(" #n ")" ::: "memory")
#define PG8_WAIT_L(n) asm volatile("s_waitcnt lgkmcnt(" #n ")" ::: "memory")
#define PG8_BAR __builtin_amdgcn_s_barrier()
#define PG8_SCHED __builtin_amdgcn_sched_barrier(0)
#define PG8_TA(u) (GATHER ? (const char*)g.A : (const char*)g.A + ((size_t)(u).pb * (size_t)g.sA + (size_t)(u).pm * BM * (size_t)g.lda) * 2)
#define PG8_STAGE_A(bufoff, gbase, h, nx) do { if constexpr (GATHER) { unsigned vo_[2] = {(nx) ? vn[h][0] : vc[h][0], (nx) ? vn[h][1] : vc[h][1]}; PG8_STAGE(bufoff, gbase, vo_); } else { PG8_STAGE(bufoff, (gbase) + (h) * hstepA, voffA); } } while (0)
#define PG8_TB(u) ((const char*)g.Bt + ((size_t)(u).pb * (size_t)g.sB + (size_t)(u).pn * BM * (size_t)g.ldb) * 2)
    Unit cur, nxt; int ui = 0;
    if (!S.next(0, cur)) return;
    f32x4 acc[2][2][4][2];
#pragma unroll
    for (int a = 0; a < 2; ++a)
#pragma unroll
        for (int b = 0; b < 2; ++b)
#pragma unroll
            for (int m = 0; m < 4; ++m)
#pragma unroll
                for (int n = 0; n < 2; ++n) acc[a][b][m][n] = (f32x4){0.f, 0.f, 0.f, 0.f};
    bf16x8 At[4][2], B0[2][2], B1[2][2];
    const char* cA = PG8_TA(cur); const char* cB = PG8_TB(cur);
    if constexpr (GATHER) { PG8_GTOK(vc, 0); PG8_GTOK(vn, 0); }
    PG8_STAGE(PG8_SB(0, 0), cB, voffB); PG8_STAGE(PG8_SB(0, 1), cB + hstepB, voffB); PG8_STAGE_A(PG8_SA(0, 0), cA, 0, false); PG8_STAGE_A(PG8_SA(0, 1), cA, 1, false);
    if (wr == 1) PG8_BAR;
    PG8_WAIT_V(2); PG8_BAR;
    PG8_STAGE(PG8_SB(1, 0), cB + kstep, voffB); PG8_STAGE_A(PG8_SA(1, 0), cA + kstep, 0, false); PG8_STAGE(PG8_SB(1, 1), cB + hstepB + kstep, voffB);
    PG8_WAIT_V(6); PG8_BAR;
    for (;;) {
        const bool has_next = S.next(ui + 1, nxt);
        const char* nA = has_next ? PG8_TA(nxt) : cA; const char* nB = has_next ? PG8_TB(nxt) : cB;
        for (int t = 0; t < nt; t += 2) {
            const bool last = (t == nt - 2);
            const char* a1 = cA + (size_t)(t + 1) * kstep;
            const char* a2 = last ? nA : cA + (size_t)(t + 2) * kstep; const char* b2 = last ? nB : cB + (size_t)(t + 2) * kstep;
            const char* a3 = a2 + kstep; const char* b3 = b2 + kstep;
            if constexpr (GATHER) { if (last && has_next) PG8_GTOK(vn, ui + 1); }
            PG8_LDB(B0, 0, 0); PG8_LDB(B1, 0, 1); PG8_SCHED; PG8_LDA(At, 0, 0); PG8_STAGE_A(PG8_SA(1, 1), a1, 1, false);
            PG8_WAIT_V(8); PG8_WAIT_L(0); PG8_BAR; PG8_MMA(0, 0, At, B0); PG8_MMA(0, 1, At, B1); PG8_BAR; PG8_SCHED;
            PG8_LDA(At, 0, 1); PG8_STAGE(PG8_SB(0, 0), b2, voffB); PG8_STAGE(PG8_SB(0, 1), b2 + hstepB, voffB); PG8_STAGE_A(PG8_SA(0, 0), a2, 0, last);
            PG8_WAIT_V(8); PG8_WAIT_L(0); PG8_BAR; PG8_MMA(1, 0, At, B0); PG8_MMA(1, 1, At, B1); PG8_BAR; PG8_SCHED;
            PG8_LDB(B0, 1, 0); PG8_LDB(B1, 1, 1); PG8_SCHED; PG8_LDA(At, 1, 0); PG8_STAGE_A(PG8_SA(0, 1), a2, 1, last);
            PG8_WAIT_V(8); PG8_WAIT_L(0); PG8_BAR; PG8_MMA(0, 0, At, B0); PG8_MMA(0, 1, At, B1); PG8_BAR; PG8_SCHED;
            PG8_LDA(At, 1, 1); PG8_STAGE(PG8_SB(1, 0), b3, voffB); PG8_STAGE(PG8_SB(1, 1), b3 + hstepB, voffB); PG8_STAGE_A(PG8_SA(1, 0), a3, 0, last);
            PG8_WAIT_V(8); PG8_WAIT_L(0); PG8_BAR; PG8_MMA(1, 0, At, B0); PG8_MMA(1, 1, At, B1); PG8_BAR; PG8_SCHED;
        }
        if (wr == 0) PG8_BAR;
        { int l2_; asm volatile("v_mbcnt_lo_u32_b32 %0, -1, 0\n\tv_mbcnt_hi_u32_b32 %0, -1, %0" : "=v"(l2_)); E(acc, cur, wr, wc, l2_ & 15, l2_ >> 4);
          if constexpr (Epi::SIGNAL) { PG8_WAIT_V(0); PG8_BAR;
              if (wid == 0 && l2_ == 0) { __builtin_amdgcn_fence(__ATOMIC_RELEASE, "agent"); (void)__hip_atomic_fetch_add(E.dep + 16 * cur.pm, 1u, __ATOMIC_RELAXED, __HIP_MEMORY_SCOPE_AGENT); } } }
        if (!has_next) break;
#pragma unroll
        for (int a = 0; a < 2; ++a)
#pragma unroll
            for (int b = 0; b < 2; ++b)
#pragma unroll
                for (int m = 0; m < 4; ++m)
#pragma unroll
                    for (int n = 0; n < 2; ++n) acc[a][b][m][n] = (f32x4){0.f, 0.f, 0.f, 0.f};
        cur = nxt; cA = nA; cB = nB; ++ui;
        if constexpr (GATHER) { _Pragma("unroll") for (int h_ = 0; h_ < 2; ++h_) _Pragma("unroll") for (int i_ = 0; i_ < 2; ++i_) vc[h_][i_] = vn[h_][i_]; }
        if (wr == 1) PG8_BAR;
    }
    PG8_WAIT_V(0);
    PG8_BAR;
#undef PG8_SA
#undef PG8_SB
#undef PG8_STAGE
#undef PG8_LDA
#undef PG8_LDB
#undef PG8_MMA
#undef PG8_WAIT_V
#undef PG8_WAIT_L
#undef PG8_BAR
#undef PG8_SCHED
#undef PG8_TA
#undef PG8_STAGE_A
#undef PG8_GTOK
#undef PG8_TB
}
}

#define XB_TMO      128
#define XB_XCNT(j)  (256  + 64 * (j))
#define XB_XSUB(j)  (1280 + 64 * (j))
#define XB_XGEN(j)  (2304 + 64 * (j))
#define XB_TOP      3328
#define XB_TOPGEN   3392
#define XCD_BAR_WORDS 3456
#define XB_SPIN_CAP (1u << 18)
__device__ __forceinline__ unsigned xb_ld(unsigned* p)              { return __hip_atomic_load(p, __ATOMIC_RELAXED, __HIP_MEMORY_SCOPE_AGENT); }
__device__ __forceinline__ unsigned xb_add(unsigned* p, unsigned v) { return __hip_atomic_fetch_add(p, v, __ATOMIC_RELAXED, __HIP_MEMORY_SCOPE_AGENT); }
__device__ __forceinline__ unsigned xb_xcc_id() { return (unsigned)__builtin_amdgcn_s_getreg((3 << 11) | 20) & 0xFu; }
#define XB_SPIN(cond, bar) do { unsigned _sp = 0; while (cond) { __builtin_amdgcn_s_sleep(1); \
    if ((++_sp & 255u) == 0u) { if (xb_ld(&(bar)[XB_TMO])) break; if (_sp > XB_SPIN_CAP) { atomicAdd(&(bar)[XB_TMO], 1u); break; } } } } while (0)
struct XcdBarrier { unsigned* bar; unsigned x; volatile LAS unsigned* st; };
__device__ __forceinline__ XcdBarrier xcd_barrier_post(unsigned* bar, volatile LAS unsigned* st, int tid) {
    XcdBarrier b; b.bar = bar; b.x = xb_xcc_id(); b.st = st;
    if (tid == 0) (void)xb_add(&bar[XB_XCNT(b.x)], 1u);
    return b;
}
__device__ __forceinline__ void xcd_barrier_complete(unsigned* bar, unsigned x, unsigned& nloc, unsigned& nx) {
    const unsigned G = gridDim.x * gridDim.y * gridDim.z;
    unsigned sum, cnt, mine, sp = 0u;
    for (;;) {
        sum = 0u; cnt = 0u; mine = 0u;
#pragma unroll
        for (unsigned j = 0; j < 16; ++j) { const unsigned c = xb_ld(&bar[XB_XCNT(j)]); sum += c; cnt += (c > 0u) ? 1u : 0u; mine = (j == x) ? c : mine; }
        if (sum == G) break;
        __builtin_amdgcn_s_sleep(1);
        if ((++sp & 255u) == 0u) { if (xb_ld(&bar[XB_TMO])) break; if (sp > XB_SPIN_CAP) { atomicAdd(&bar[XB_TMO], 1u); break; } }
    }
    nloc = mine > 0u ? mine : 1u; nx = cnt > 0u ? cnt : 1u;
}
__device__ __forceinline__ void xcd_barrier(const XcdBarrier& b, int tid) {
    asm volatile("s_waitcnt vmcnt(0)" ::: "memory");
    __syncthreads();
    if (tid == 0) {
        unsigned* bar; { unsigned long long bb_ = (unsigned long long)b.bar; asm volatile("" : "+s"(bb_)); bar = (unsigned*)(GAS unsigned*)bb_; }
        __builtin_amdgcn_s_waitcnt(0);
        unsigned nloc = b.st[0], nx = b.st[1];
        if (nloc == 0u) { xcd_barrier_complete(bar, b.x, nloc, nx); b.st[0] = nloc; b.st[1] = nx; }
        const unsigned old = xb_add(&bar[XB_XSUB(b.x)], 1u);
        const unsigned gen = old / nloc;
        if (old + 1u == (gen + 1u) * nloc) {
            __builtin_amdgcn_fence(__ATOMIC_RELEASE, "agent");
            asm volatile("s_waitcnt vmcnt(0)" ::: "memory");
            const unsigned og = xb_add(&bar[XB_TOP], 1u);
            const unsigned tg = og / nx;
            if (og + 1u == (tg + 1u) * nx) xb_add(&bar[XB_TOPGEN], 1u);
            else XB_SPIN(xb_ld(&bar[XB_TOPGEN]) == tg, bar);
            __builtin_amdgcn_fence(__ATOMIC_ACQUIRE, "agent");
            asm volatile("s_waitcnt vmcnt(0)" ::: "memory");
        } else {
            XB_SPIN(xb_ld(&bar[XB_TOPGEN]) == gen, bar);
            __builtin_amdgcn_fence(__ATOMIC_ACQUIRE, "agent");
            asm volatile("s_waitcnt vmcnt(0)" ::: "memory");
        }
    }
    __syncthreads();
}

struct Args { const float* in[32]; float* out; unsigned char* ws; int ph_lo, ph_hi; };
struct Frame {
    LAS unsigned char* lds;
    volatile LAS unsigned* MISC;
    gu32* ctl;
    int tid, lane, wave, G, vcu, gw, NGW;
    unsigned char* ws;
};
enum { I_X = 0, I_RELB, I_S5_WIN, I_S5_ARE, I_S5_AIM, I_S5_LOGDT, I_S5_BRE, I_S5_BIM, I_S5_CRE, I_S5_CIM, I_S5_D, I_S5_WGLU, I_S5_WOUT,
       I_D_WIN, I_D_QN, I_D_KVN, I_D_WUQ, I_D_WQIDX, I_D_WUK, I_D_WUV, I_D_WOUT,
       I_M_WG, I_M_BG, I_M_WE, I_M_BE, I_M_WGATE, I_M_WUP, I_M_WDOWN, I_LNM_G, I_LNM_B, I_LNF_G, I_LNF_B };

__device__ __forceinline__ void tr_item(const float* src, int ldS, int nvalid, bf16_t* dst, int ldD, long zoff, bool zfill, LAS float* scr, int lane) {
    const int nn = lane & 31; const bool ok = nn < nvalid;
    const float* sp = src + (size_t)(lane >> 5) * ldS + nn; const size_t st2 = (size_t)2 * ldS;
#pragma unroll
    for (int hb = 0; hb < 2; ++hb) {
        float tv[16];
#pragma unroll
        for (int i = 0; i < 16; ++i) { tv[i] = ok ? *sp : 0.f; sp += st2; }
        __builtin_amdgcn_sched_barrier(0);
#pragma unroll
        for (int i = 0; i < 16; ++i) scr[(2 * (hb * 16 + i) + (lane >> 5)) * 33 + nn] = tv[i];
        __builtin_amdgcn_sched_barrier(0);
    }
    LDS_WAIT(); asm volatile("" ::: "memory");
    const int c = lane & 7;
#pragma unroll
    for (int j = 0; j < 4; ++j) { const int n = (lane >> 3) + 8 * j; const LAS float* s = scr + (8 * c) * 33 + n;
        u32x4 o; o.x = pk2(s[0 * 33], s[1 * 33]); o.y = pk2(s[2 * 33], s[3 * 33]); o.z = pk2(s[4 * 33], s[5 * 33]); o.w = pk2(s[6 * 33], s[7 * 33]);
        *(GAS u32x4*)(dst + (size_t)n * ldD + 8 * c) = o;
        if (zfill) *(GAS u32x4*)(dst + zoff + (size_t)n * ldD + 8 * c) = (u32x4){0u, 0u, 0u, 0u}; }
    LDS_WAIT(); asm volatile("" ::: "memory");
}

__device__ __forceinline__ void s5_tables(const Frame& F, const Args& a, int j) {
    unsigned char* ws = F.ws;
    LAS f32x2* PW = (LAS f32x2*)F.lds;
    LAS f32x2* BBs = PW + 17 * 64;
    LAS f32x2* Cs = BBs + 1024;
    LAS float* Ks = (LAS float*)(Cs + 1024);
    for (int item = F.vcu; item < 2 * S5G; item += F.G) {
        const int g = item >> 1, half = item & 1;
        __syncthreads();
        const float dt = expf(a.in[I_S5_LOGDT][j * S5G + g]);
        for (int idx = F.tid; idx < 17 * 64; idx += 512) { const int k = idx >> 6, n = idx & 63;
            const float are = fminf(a.in[I_S5_ARE][((size_t)j * S5G + g) * S5N + n], -1e-4f), aim = a.in[I_S5_AIM][((size_t)j * S5G + g) * S5N + n];
            const float x = are * dt * (float)k, y = aim * dt * (float)k; float sy, cy; sincosf(y, &sy, &cy); const float ex = expf(x);
            PW[idx] = (f32x2){ex * cy, ex * sy}; }
        for (int idx = F.tid; idx < 1024; idx += 512) { const int n = idx >> 4;
            const float are = fminf(a.in[I_S5_ARE][((size_t)j * S5G + g) * S5N + n], -1e-4f), aim = a.in[I_S5_AIM][((size_t)j * S5G + g) * S5N + n];
            const float x = are * dt, y = aim * dt; float sy, cy; sincosf(y, &sy, &cy); const float ex = expf(x), sh = sinf(0.5f * y);
            const float nr = expm1f(x) * cy - 2.0f * sh * sh, ni = ex * sy, den = are * are + aim * aim;
            const float cr = (nr * are + ni * aim) / den, ci = (ni * are - nr * aim) / den;
            const float br = a.in[I_S5_BRE][(((size_t)j * S5G + g) * S5N) * S5P + idx], bi = a.in[I_S5_BIM][(((size_t)j * S5G + g) * S5N) * S5P + idx];
            BBs[idx] = (f32x2){cr * br - ci * bi, cr * bi + ci * br}; }
        for (int idx = F.tid; idx < 1024; idx += 512) Cs[idx] = (f32x2){a.in[I_S5_CRE][((size_t)j * S5G + g) * S5P * S5N + idx], a.in[I_S5_CIM][((size_t)j * S5G + g) * S5P * S5N + idx]};
        __syncthreads();
        { const int lag = F.tid >> 5, p = (F.tid >> 1) & 15, qh = F.tid & 1; float kacc[8];
#pragma unroll
          for (int q = 0; q < 8; ++q) kacc[q] = 0.f;
#pragma unroll 4
          for (int n = 0; n < S5N; ++n) { const f32x2 c = Cs[p * 64 + n], w = PW[lag * 64 + n];
              const float tr = c.x * w.x - c.y * w.y, ti = c.x * w.y + c.y * w.x;
              const LAS f32x4* bq = (const LAS f32x4*)(BBs + n * 16 + qh * 8);
#pragma unroll
              for (int q2 = 0; q2 < 4; ++q2) { const f32x4 b2 = bq[q2]; kacc[2 * q2] += tr * b2[0] - ti * b2[1]; kacc[2 * q2 + 1] += tr * b2[2] - ti * b2[3]; } }
#pragma unroll
          for (int q = 0; q < 8; ++q) { float v = kacc[q]; if (lag == 0 && p == qh * 8 + q) v += a.in[I_S5_D][((size_t)j * S5G + g) * S5P + p]; Ks[(lag * 16 + p) * 16 + qh * 8 + q] = v; } }
        __syncthreads();
        bf16_t* FD = (bf16_t*)(ws + WS_S5T + S5T_FD) + (size_t)g * 16 * 512; bf16_t* WS_ = (bf16_t*)(ws + WS_S5T + S5T_WS) + (size_t)g * 128 * 256; bf16_t* WY = (bf16_t*)(ws + WS_S5T + S5T_WY) + (size_t)g * 256 * 128;
        for (int idx = F.tid; idx < 8 * 512; idx += 512) { const int d = 8 * half + (idx >> 9), l = (idx >> 3) & 63, jj = idx & 7, p = l & 15, gq = l >> 4;
            float v = 0.f; if (gq < 2) v = Ks[(d * 16 + p) * 16 + 8 * gq + jj]; else if (d >= 1) v = Ks[((d - 1) * 16 + p) * 16 + 8 * (gq - 2) + jj];
            FD[(size_t)d * 512 + (idx & 511)] = (bf16_t)f2bf(v); }
        for (int idx = F.tid; idx < 64 * 256; idx += 512) { const int R = 64 * half + (idx >> 8), k = idx & 255, n = R >> 1, c = R & 1, s_ = k >> 4, q = k & 15;
            const f32x2 w = PW[(15 - s_) * 64 + n], bq = BBs[n * 16 + q];
            const float v = c ? (w.x * bq.y + w.y * bq.x) : (w.x * bq.x - w.y * bq.y);
            WS_[(size_t)R * 256 + k] = (bf16_t)f2bf(v); }
        for (int idx = F.tid; idx < 128 * 128; idx += 512) { const int R = 128 * half + (idx >> 7), k = idx & 127, t = R >> 4, p = R & 15, n = k >> 1, c = k & 1;
            const f32x2 cc = Cs[p * 64 + n], w = PW[(t + 1) * 64 + n];
            const float v = c ? -(cc.x * w.y + cc.y * w.x) : (cc.x * w.x - cc.y * w.y);
            WY[(size_t)R * 128 + k] = (bf16_t)f2bf(v); }
        if (half == 0 && F.tid < 64) ((f32x2*)(ws + WS_S5T + S5T_A16))[g * 64 + F.tid] = PW[16 * 64 + F.tid];
    }
    __syncthreads();
}

struct CvItem { const float* src; bf16_t* dst; int ldS, ldD, nvalid, zoff; };
__device__ __forceinline__ int conv_nmix(int li) { return (li & 1) == 0 ? 3 * 2048 : (1280 + 1024 + 512 + 512 + 2048); }
__device__ __forceinline__ CvItem conv_item(const Args& a, unsigned char* ws, int li, int r) {
    const int j = li >> 1; const bool s5 = (li & 1) == 0; const int nmix = conv_nmix(li);
    CvItem I; I.nvalid = 32; I.zoff = 0;
    if (r < nmix) {
        if (s5) { const int mat = r / 2048, item = r % 2048, kb = item / 64, nb = item % 64;
            const float* W = a.in[mat == 0 ? I_S5_WIN : (mat == 1 ? I_S5_WGLU : I_S5_WOUT)] + (size_t)j * D * D;
            I.src = W + (size_t)(kb * 64) * D + nb * 32; I.ldS = D; I.dst = (bf16_t*)(ws + WS_WMIX + (size_t)mat * 8 * MiB) + (size_t)(nb * 32) * D + kb * 64; I.ldD = D; return I; }
        if (r < 1280) { const int kb = r / 40, nb = r % 40; const float* W = a.in[I_D_WIN] + (size_t)j * D * DSA_IN;
            int nv = DSA_IN - nb * 32; nv = nv < 0 ? 0 : (nv > 32 ? 32 : nv);
            I.src = W + (size_t)(kb * 64) * DSA_IN + (nv ? nb * 32 : 0); I.ldS = DSA_IN; I.nvalid = nv;        I.dst = (bf16_t*)(ws + WS_WMIX + WM_D_IN) + (size_t)(nb * 32) * D + kb * 64; I.ldD = D; return I; }
        r -= 1280;
        if (r < 1024) { const int mat = r / 512, item = r % 512, kb = item / 64, nb = item % 64;
            const float* W = a.in[mat == 0 ? I_D_WUQ : I_D_WQIDX] + (size_t)j * QL * 2048;
            I.src = W + (size_t)(kb * 64) * 2048 + nb * 32; I.ldS = 2048; I.dst = (bf16_t*)(ws + WS_WMIX + WM_D_Q) + (size_t)(mat * 2048 + nb * 32) * QL + kb * 64; I.ldD = QL; return I; }
        r -= 1024;
        if (r < 512) { const int h = r / 32, item = r % 32, kb = item / 16, nb = item % 16;
            const float* W = a.in[I_D_WUK] + ((size_t)j * NH + h) * HD * KVL;
            I.src = W + (size_t)(kb * 64) * KVL + nb * 32; I.ldS = KVL; I.dst = (bf16_t*)(ws + WS_WMIX + WM_D_UK) + (size_t)h * 512 * 128 + (size_t)(nb * 32) * 128 + kb * 64; I.ldD = 128; return I; }
        r -= 512;
        if (r < 512) { const int h = r / 32, item = r % 32, kb = item / 4, nb = item % 4, p = h >> 1, hh = h & 1;
            const float* W = a.in[I_D_WUV] + ((size_t)j * NH + h) * KVL * HD;
            I.src = W + (size_t)(kb * 64) * HD + nb * 32; I.ldS = HD; I.dst = (bf16_t*)(ws + WS_WMIX + WM_D_UV) + (size_t)p * 256 * 1024 + (size_t)(hh * 128 + nb * 32) * 1024 + hh * 512 + kb * 64; I.ldD = 1024;
            I.zoff = hh ? -512 : 512; return I; }
        r -= 512;
        { const int kb = r / 64, nb = r % 64; const float* W = a.in[I_D_WOUT] + (size_t)j * D * D;
          I.src = W + (size_t)(kb * 64) * D + nb * 32; I.ldS = D; I.dst = (bf16_t*)(ws + WS_WMIX + WM_D_OUT) + (size_t)(nb * 32) * D + kb * 64; I.ldD = D; return I; }
    }
    r -= nmix;
    if (r < 16384) { const int job = r / 128, item = r % 128, e = job >> 2, which = (job >> 1) & 1, fg = job & 1, kb = item / 4, nb = item % 4;
        const float* W = a.in[which ? I_M_WUP : I_M_WGATE] + ((size_t)li * NE + e) * D * FF;
        I.src = W + (size_t)(kb * 64) * FF + fg * 128 + nb * 32; I.ldS = FF; I.dst = (bf16_t*)(ws + WS_WMOE + WE_GU) + (size_t)e * 512 * D + (size_t)(fg * 256 + which * 128 + nb * 32) * D + kb * 64; I.ldD = D; return I; }
    r -= 16384;
    { const int e = r / 256, item = r % 256, kb = item / 64, nb = item % 64;
      const float* W = a.in[I_M_WDOWN] + ((size_t)li * NE + e) * FF * D;
      I.src = W + (size_t)(kb * 64) * D + nb * 32; I.ldS = D; I.dst = (bf16_t*)(ws + WS_WMOE + WE_DN) + (size_t)e * D * FF + (size_t)(nb * 32) * FF + kb * 64; I.ldD = FF; return I; }
}
__device__ __forceinline__ void conv_run(const Frame& F, const Args& a, int li, int r0, int r1, int first, int stride) {
    unsigned char* ws = F.ws;
    LAS float* scr = (LAS float*)(F.lds + F.wave * 16384);
    int r = r0 + first; if (r >= r1) return;
    const int lane = F.lane, nn = lane & 31, hi = lane >> 5, c = lane & 7;
    CvItem cur = conv_item(a, ws, li, r);
    float tv[32];
#define CV_LOAD(I_) do { const unsigned vo_ = ((unsigned)hi * (unsigned)(I_).ldS + (unsigned)(nn < (I_).nvalid ? nn : 0)) * 4u; const char* sb_ = (const char*)(I_).src; const size_t st2_ = (size_t)8 * (I_).ldS; \
        _Pragma("unroll") for (int i_ = 0; i_ < 32; ++i_) { tv[i_] = *(const float*)(sb_ + vo_); sb_ += st2_; } } while (0)
    CV_LOAD(cur);
    for (;;) {
        __builtin_amdgcn_sched_barrier(0);
        const bool okc = nn < cur.nvalid;
#pragma unroll
        for (int i = 0; i < 32; ++i) scr[(2 * i + hi) * 33 + nn] = okc ? tv[i] : 0.f;
        __builtin_amdgcn_sched_barrier(0);
        r += stride; const bool more = r < r1;
        CvItem nxt = cur;
        if (more) { nxt = conv_item(a, ws, li, r); CV_LOAD(nxt); }
        __builtin_amdgcn_sched_barrier(0);
        LDS_WAIT(); asm volatile("" ::: "memory");
#pragma unroll
        for (int q = 0; q < 4; ++q) { const int n = (lane >> 3) + 8 * q; const LAS float* sl = scr + (8 * c) * 33 + n;
            u32x4 o; o.x = pk2(sl[0 * 33], sl[1 * 33]); o.y = pk2(sl[2 * 33], sl[3 * 33]); o.z = pk2(sl[4 * 33], sl[5 * 33]); o.w = pk2(sl[6 * 33], sl[7 * 33]);
            *(GAS u32x4*)(cur.dst + (size_t)n * cur.ldD + 8 * c) = o;
            if (cur.zoff) { unsigned z0 = 0u; asm volatile("" : "+v"(z0)); *(GAS u32x4*)(cur.dst + cur.zoff + (size_t)n * cur.ldD + 8 * c) = (u32x4){z0, z0, z0, z0}; } }
        LDS_WAIT(); asm volatile("" ::: "memory");
        if (!more) break;
        cur = nxt;
    }
#undef CV_LOAD
}
__device__ __forceinline__ void phase_conv(const Frame& F, const Args& a, int li) {
    unsigned char* ws = F.ws;
    const int j = li >> 1; const bool s5 = (li & 1) == 0;
    if (s5) s5_tables(F, a, j);
    conv_run(F, a, li, 0, conv_nmix(li) + 24576, F.gw, F.NGW);
    if (li == 0) {
        const float* x = a.in[I_X]; bf16_t* h16 = (bf16_t*)(ws + WS_H16);
        for (int m = F.gw; m < T; m += F.NGW) {
            const f32x4* xr = (const f32x4*)(x + (size_t)m * D) + F.lane; u32x2* br = (u32x2*)(h16 + (size_t)m * D) + F.lane;
            f32x4 xv[8];
#pragma unroll
            for (int q = 0; q < 8; ++q) xv[q] = xr[64 * q];
            __builtin_amdgcn_sched_barrier(0);
#pragma unroll
            for (int q = 0; q < 8; ++q) { const f32x4 v = xv[q]; u32x2 w; w.x = pk2(v[0], v[1]); w.y = pk2(v[2], v[3]); br[64 * q] = w; }
        }
    }
    {
        const int gt = F.vcu * 512 + F.tid;
        if (gt < 48 * D) { const int n = gt / D, k = gt % D;
            const float v = n < NG ? a.in[I_M_WG][((size_t)li * D + k) * NG + n] : (n < NG + NE ? a.in[I_M_WE][((size_t)li * D + k) * NE + (n - NG)] : 0.f);
            const unsigned hi = f2bf(v); const unsigned lo = f2bf(v - bf2f(hi));
            bf16_t* RT = (bf16_t*)(ws + WS_RT); RT[gt] = (bf16_t)hi; RT[48 * D + gt] = (bf16_t)lo; }
    }
}

__device__ __forceinline__ void phase_ssm2(const Frame& F, const Args& a) {
    unsigned char* ws = F.ws;
    const bf16_t* U = (const bf16_t*)(ws + WS_S + S_U16); bf16_t* Z = (bf16_t*)(ws + WS_S + S_Z16);
    const int lane = F.lane, w = F.wave, r16 = lane & 15, gq = lane >> 4;
    constexpr int UP = 528, HP = 272;
    LAS unsigned char* Us = F.lds;
    LAS unsigned char* Hs = F.lds + 128 * UP;
    LAS unsigned char* Fs = Hs + 128 * HP;
    u32x4 uv[8], fv[2];
#define SSM_FETCH(un_) do { const int b_ = (un_) / S5G, g_ = (un_) % S5G; \
        _Pragma("unroll") for (int it = 0; it < 8; ++it) { const int idx = it * 512 + F.tid, t = idx >> 1, hf = idx & 1; uv[it] = *(const u32x4*)(U + (size_t)(b_ * SEQ + t) * D + g_ * S5P + hf * 8); } \
        _Pragma("unroll") for (int it = 0; it < 2; ++it) { const int idx = it * 512 + F.tid; fv[it] = *((const u32x4*)(ws + WS_S5T + S5T_FD + (size_t)g_ * 16384) + idx); } } while (0)
    if (F.vcu < NB * S5G) SSM_FETCH(F.vcu);
    for (int unit = F.vcu; unit < NB * S5G; unit += F.G) {
        const int b = unit / S5G, g = unit % S5G;
        __syncthreads();
        { __builtin_amdgcn_sched_barrier(0);
#pragma unroll
          for (int it = 0; it < 8; ++it) { const int idx = it * 512 + F.tid, t = idx >> 1, hf = idx & 1; *(LAS u32x4*)(Us + (t >> 4) * UP + (t & 15) * 32 + hf * 16) = uv[it]; }
#pragma unroll
          for (int it = 0; it < 2; ++it) { const int idx = it * 512 + F.tid; *(LAS u32x4*)(Fs + idx * 16) = fv[it]; } }
        const bf16_t* WSg = (const bf16_t*)(ws + WS_S5T + S5T_WS) + (size_t)g * 128 * 256; const bf16_t* WYg = (const bf16_t*)(ws + WS_S5T + S5T_WY) + (size_t)g * 256 * 128;
        bf16x8 wa[8];
#pragma unroll
        for (int ks = 0; ks < 8; ++ks) wa[ks] = *(const bf16x8*)(WSg + (size_t)(16 * w + r16) * 256 + 32 * ks + 8 * gq);
        __syncthreads();
#pragma unroll 2
        for (int nt = 0; nt < 8; ++nt) {
            f32x4 acc = {0.f, 0.f, 0.f, 0.f}; bf16x8 ub8[8];
#pragma unroll
            for (int ks = 0; ks < 8; ++ks) ub8[ks] = *(const LAS bf16x8*)(Us + (nt * 16 + r16) * UP + (2 * ks + (gq >> 1)) * 32 + (gq & 1) * 16);
            __builtin_amdgcn_sched_barrier(0);
#pragma unroll
            for (int ks = 0; ks < 8; ++ks) acc = __builtin_amdgcn_mfma_f32_16x16x32_bf16(wa[ks], ub8[ks], acc, 0, 0, 0);
            __builtin_amdgcn_sched_barrier(0);
            u32x2 o; o.x = pk2(acc[0], acc[1]); o.y = pk2(acc[2], acc[3]);
            *(LAS u32x2*)(Hs + (nt * 16 + r16) * HP + (16 * w + 4 * gq) * 2) = o;
        }
        __syncthreads();
        const int t0 = w, t1 = 15 - w;
        bf16x8 wy0[4], wy1[4];
#pragma unroll
        for (int ks = 0; ks < 4; ++ks) { wy0[ks] = *(const bf16x8*)(WYg + (size_t)(t0 * 16 + r16) * 128 + 32 * ks + 8 * gq); wy1[ks] = *(const bf16x8*)(WYg + (size_t)(t1 * 16 + r16) * 128 + 32 * ks + 8 * gq); }
        __builtin_amdgcn_sched_barrier(0);
        if (w == 0) {
            const f32x2 a16 = ((const f32x2*)(ws + WS_S5T + S5T_A16))[g * 64 + lane];
            float hr = 0.f, hi = 0.f;
#pragma unroll 1
            for (int c0 = 0; c0 < 128; c0 += 32) {
                unsigned sv[32];
#pragma unroll
                for (int c = 0; c < 32; ++c) sv[c] = *(const LAS unsigned*)(Hs + (c0 + c) * HP + lane * 4);
#pragma unroll
                for (int c = 0; c < 32; ++c) { const unsigned hp = pk2(hr, hi); const float sr = bflo(sv[c]), si = bfhi(sv[c]);
                    const float nr = a16.x * hr - a16.y * hi + sr, ni = a16.x * hi + a16.y * hr + si; hr = nr; hi = ni; sv[c] = hp; }
#pragma unroll
                for (int c = 0; c < 32; ++c) *(LAS unsigned*)(Hs + (c0 + c) * HP + lane * 4) = sv[c];
            }
        }
        __builtin_amdgcn_s_waitcnt(0x0F70);
        __builtin_amdgcn_sched_barrier(0);
        { const int un = unit + F.G < NB * S5G ? unit + F.G : unit; SSM_FETCH(un); }
        __builtin_amdgcn_sched_barrier(0);
        asm volatile("s_waitcnt lgkmcnt(0)" ::: "memory"); __builtin_amdgcn_s_barrier(); asm volatile("" ::: "memory");
        bf16x8 fa[4], fb[8];
#pragma unroll
        for (int sp = 0; sp < 4; ++sp) { const int da = t0 - 2 * sp; fa[sp] = *(const LAS bf16x8*)(Fs + (da > 0 ? da : 0) * 1024 + lane * 16); }
#pragma unroll
        for (int sp = 0; sp < 8; ++sp) { const int db = t1 - 2 * sp; fb[sp] = *(const LAS bf16x8*)(Fs + (db > 0 ? db : 0) * 1024 + lane * 16); }
#pragma unroll 1
        for (int nt = 0; nt < 8; ++nt) {
            f32x4 acc0 = {0.f, 0.f, 0.f, 0.f}, acc1 = {0.f, 0.f, 0.f, 0.f};
            bf16x8 ub8[8], hb4[4];
#pragma unroll
            for (int sp = 0; sp < 8; ++sp) ub8[sp] = *(const LAS bf16x8*)(Us + (nt * 16 + r16) * UP + (2 * sp + (gq >> 1)) * 32 + (gq & 1) * 16);
#pragma unroll
            for (int ks = 0; ks < 4; ++ks) hb4[ks] = *(const LAS bf16x8*)(Hs + (nt * 16 + r16) * HP + (32 * ks + 8 * gq) * 2);
            __builtin_amdgcn_sched_barrier(0);
#pragma unroll
            for (int ks = 0; ks < 4; ++ks) { acc0 = __builtin_amdgcn_mfma_f32_16x16x32_bf16(wy0[ks], hb4[ks], acc0, 0, 0, 0); acc1 = __builtin_amdgcn_mfma_f32_16x16x32_bf16(wy1[ks], hb4[ks], acc1, 0, 0, 0); }
#pragma unroll
            for (int sp = 0; sp < 4; ++sp) { if (2 * sp <= t0) acc0 = __builtin_amdgcn_mfma_f32_16x16x32_bf16(fa[sp], ub8[sp], acc0, 0, 0, 0); }
#pragma unroll
            for (int sp = 0; sp < 8; ++sp) { if (2 * sp <= t1) acc1 = __builtin_amdgcn_mfma_f32_16x16x32_bf16(fb[sp], ub8[sp], acc1, 0, 0, 0); }
            __builtin_amdgcn_sched_barrier(0);
            float z0[4], z1[4];
#pragma unroll
            for (int jj = 0; jj < 4; ++jj) { const float y0 = acc0[jj], y1 = acc1[jj];
                z0[jj] = y0 / (1.0f + __expf(-1.5957691216057308f * (y0 + 0.044715f * y0 * y0 * y0)));
                z1[jj] = y1 / (1.0f + __expf(-1.5957691216057308f * (y1 + 0.044715f * y1 * y1 * y1))); }
            const size_t rowb = (size_t)b * SEQ + 16 * (nt * 16 + r16);
            u32x2 o0, o1; o0.x = pk2(z0[0], z0[1]); o0.y = pk2(z0[2], z0[3]); o1.x = pk2(z1[0], z1[1]); o1.y = pk2(z1[2], z1[3]);
            *(u32x2*)(Z + (rowb + t0) * D + g * S5P + 4 * gq) = o0; *(u32x2*)(Z + (rowb + t1) * D + g * S5P + 4 * gq) = o1;
        }
    }
}

#undef SSM_FETCH
template <int MODE>
__device__ __forceinline__ void phase_ln(const Frame& F, const Args& a, int li, int m0, int mstep, int mend) {
    unsigned char* ws = F.ws;
    bf16_t* H16 = (bf16_t*)(ws + WS_H16);
    const float* gam = a.in[MODE == 0 ? I_LNM_G : I_LNF_G] + (size_t)li * D; const float* bet = a.in[MODE == 0 ? I_LNM_B : I_LNF_B] + (size_t)li * D;
    const bf16_t* Y0 = (const bf16_t*)(ws + WS_S + S_Y0); const bf16_t* Y1 = (const bf16_t*)(ws + WS_S + S_Y1);
    const int lane = F.lane;
    const bool last = (MODE == 1) && (li == DEPTH - 1);
    for (int m = m0; m < mend; m += mstep) {
        float v[4][8];
        const u32x4* xr = (const u32x4*)(H16 + (size_t)m * D) + lane;
#pragma unroll
        for (int q = 0; q < 4; ++q) { const u32x4 p = xr[64 * q]; v[q][0] = bflo(p.x); v[q][1] = bfhi(p.x); v[q][2] = bflo(p.y); v[q][3] = bfhi(p.y); v[q][4] = bflo(p.z); v[q][5] = bfhi(p.z); v[q][6] = bflo(p.w); v[q][7] = bfhi(p.w); }
        if (MODE == 1) {
            const u32x2* y0 = (const u32x2*)((const unsigned char*)Y0 + (size_t)m * D) + lane; const u32x2* y1 = (const u32x2*)((const unsigned char*)Y1 + (size_t)m * D) + lane;
            u32x2 pa[4], pb[4];
#pragma unroll
            for (int q = 0; q < 4; ++q) { pa[q] = y0[64 * q]; pb[q] = y1[64 * q]; }
            __builtin_amdgcn_sched_barrier(0);
#pragma unroll
            for (int q = 0; q < 4; ++q) {
                const f32x2 a0 = __builtin_amdgcn_cvt_pk_f32_fp8((int)pa[q].x, false), a1 = __builtin_amdgcn_cvt_pk_f32_fp8((int)pa[q].x, true), a2 = __builtin_amdgcn_cvt_pk_f32_fp8((int)pa[q].y, false), a3 = __builtin_amdgcn_cvt_pk_f32_fp8((int)pa[q].y, true);
                const f32x2 b0 = __builtin_amdgcn_cvt_pk_f32_fp8((int)pb[q].x, false), b1 = __builtin_amdgcn_cvt_pk_f32_fp8((int)pb[q].x, true), b2 = __builtin_amdgcn_cvt_pk_f32_fp8((int)pb[q].y, false), b3 = __builtin_amdgcn_cvt_pk_f32_fp8((int)pb[q].y, true);
                v[q][0] = v[q][0] * DN_ALPHA + (a0[0] + b0[0]) * 0.0625f; v[q][1] = v[q][1] * DN_ALPHA + (a0[1] + b0[1]) * 0.0625f;
                v[q][2] = v[q][2] * DN_ALPHA + (a1[0] + b1[0]) * 0.0625f; v[q][3] = v[q][3] * DN_ALPHA + (a1[1] + b1[1]) * 0.0625f;
                v[q][4] = v[q][4] * DN_ALPHA + (a2[0] + b2[0]) * 0.0625f; v[q][5] = v[q][5] * DN_ALPHA + (a2[1] + b2[1]) * 0.0625f;
                v[q][6] = v[q][6] * DN_ALPHA + (a3[0] + b3[0]) * 0.0625f; v[q][7] = v[q][7] * DN_ALPHA + (a3[1] + b3[1]) * 0.0625f; }
        }
        float s = 0.f;
#pragma unroll
        for (int q = 0; q < 4; ++q)
#pragma unroll
            for (int e = 0; e < 8; ++e) s += v[q][e];
        const float mean = wave_sum(s, lane) * (1.0f / D); float s2 = 0.f;
#pragma unroll
        for (int q = 0; q < 4; ++q)
#pragma unroll
            for (int e = 0; e < 8; ++e) { v[q][e] -= mean; s2 += v[q][e] * v[q][e]; }
        const float rstd = 1.0f / sqrtf(wave_sum(s2, lane) * (1.0f / D) + LN_EPS);
#pragma unroll
        for (int q = 0; q < 4; ++q) { const f32x4 g0 = *((const f32x4*)gam + 2 * (lane + 64 * q)), g1 = *((const f32x4*)gam + 2 * (lane + 64 * q) + 1), b0 = *((const f32x4*)bet + 2 * (lane + 64 * q)), b1 = *((const f32x4*)bet + 2 * (lane + 64 * q) + 1);
#pragma unroll
            for (int e = 0; e < 4; ++e) { v[q][e] = v[q][e] * rstd * g0[e] + b0[e]; v[q][4 + e] = v[q][4 + e] * rstd * g1[e] + b1[e]; } }
        if (last) {
            f32x4* o = (f32x4*)(a.out + (size_t)m * D) + 2 * lane;
#pragma unroll
            for (int q = 0; q < 4; ++q) { o[128 * q] = (f32x4){v[q][0], v[q][1], v[q][2], v[q][3]}; o[128 * q + 1] = (f32x4){v[q][4], v[q][5], v[q][6], v[q][7]}; }
        } else {
            u32x4* ob = (u32x4*)(H16 + (size_t)m * D) + lane;
#pragma unroll
            for (int q = 0; q < 4; ++q) { u32x4 w; w.x = pk2(v[q][0], v[q][1]); w.y = pk2(v[q][2], v[q][3]); w.z = pk2(v[q][4], v[q][5]); w.w = pk2(v[q][6], v[q][7]); ob[64 * q] = w;
 }
        }
    }
}

__device__ __forceinline__ void phase_router(const Frame& F, const Args& a, int li) {
    unsigned char* ws = F.ws;
    const bf16_t* XH = (const bf16_t*)(ws + WS_H16);
    const bf16_t* WH = (const bf16_t*)(ws + WS_RT);
    const int lane = F.lane, r16 = lane & 15, g = lane >> 4, wq = F.wave & 3, kh = F.wave >> 2;
    LAS float* lb = (LAS float*)(F.lds + F.wave * 4096);
    const LAS float* lbp = (const LAS float*)(F.lds + (F.wave ^ 4) * 4096);
    for (int t0 = 0; t0 < T / 16; t0 += F.G * 4) {
        { const int rb = (t0 + F.vcu * 4) * 16 + F.wave * 8; const int re = rb + 8 < T ? rb + 8 : T; phase_ln<0>(F, a, li, rb, 1, re); }
        asm volatile("s_waitcnt vmcnt(0)" ::: "memory"); __syncthreads();
        const int tile = t0 + F.vcu * 4 + wq; const bool act = tile < T / 16;
        f32x4 acc[3];
#pragma unroll
        for (int n = 0; n < 3; ++n) acc[n] = (f32x4){0.f, 0.f, 0.f, 0.f};
        if (act) {
            const bf16_t* xh = XH + ((size_t)tile * 16 + r16) * D + 8 * g + kh * (D / 2);
            const bf16_t* wh = WH + (size_t)r16 * D + 8 * g + kh * (D / 2);
            bf16x8 ah[2][4], bh[2][4][3];
#define RT_LOAD(buf, s0) do { _Pragma("unroll") for (int u_ = 0; u_ < 4; ++u_) { ah[buf][u_] = *(const bf16x8*)(xh + 32 * ((s0) + u_)); \
                _Pragma("unroll") for (int n_ = 0; n_ < 3; ++n_) bh[buf][u_][n_] = *(const bf16x8*)(wh + (size_t)(n_ * 16) * D + 32 * ((s0) + u_)); } } while (0)
#define RT_MMA(buf) do { _Pragma("unroll") for (int u_ = 0; u_ < 4; ++u_) _Pragma("unroll") for (int n_ = 0; n_ < 3; ++n_) acc[n_] = __builtin_amdgcn_mfma_f32_16x16x32_bf16(ah[buf][u_], bh[buf][u_][n_], acc[n_], 0, 0, 0); } while (0)
            RT_LOAD(0, 0);
#pragma unroll 1
            for (int s0 = 0; s0 < D / 64; s0 += 8) {
                __builtin_amdgcn_sched_barrier(0);
                RT_LOAD(1, s0 + 4);
                __builtin_amdgcn_sched_barrier(0);
                RT_MMA(0);
                __builtin_amdgcn_sched_barrier(0);
                if (s0 + 8 < D / 64) RT_LOAD(0, s0 + 8);
                __builtin_amdgcn_sched_barrier(0);
                RT_MMA(1);
            }
#undef RT_LOAD
#undef RT_MMA
        }
#pragma unroll
        for (int n = 0; n < 3; ++n)
#pragma unroll
            for (int j = 0; j < 4; ++j) lb[(4 * g + j) * 52 + n * 16 + r16] = acc[n][j];
        __syncthreads();
        LAS unsigned* bc = (LAS unsigned*)(F.lds + 8 * 4096);
        if (F.tid < 64) bc[F.tid] = 0u;
        __syncthreads();
        int e1 = 0, e2 = 0; float w1 = 0.f, w2 = 0.f; unsigned l1 = 0u, l2 = 0u; const bool dec = act && kh == 0 && lane < 16;
        if (dec) {
            const LAS float* L = lb + lane * 52; const LAS float* L2 = lbp + lane * 52;
            float lg[NG];
#pragma unroll
            for (int q = 0; q < NG; ++q) lg[q] = L[q] + L2[q] + a.in[I_M_BG][li * NG + q];
            int gi = 0; float gm = lg[0];
#pragma unroll
            for (int q = 1; q < NG; ++q) if (lg[q] > gm) { gm = lg[q]; gi = q; }
            float gs = 0.f;
#pragma unroll
            for (int q = 0; q < NG; ++q) gs += __expf(lg[q] - gm);
            const float gp = 1.0f / gs;
            float el[EPG];
#pragma unroll
            for (int i = 0; i < EPG; ++i) el[i] = L[NG + gi * EPG + i] + L2[NG + gi * EPG + i] + a.in[I_M_BE][li * NE + gi * EPG + i];
            int i1 = 0; float m1 = el[0];
#pragma unroll
            for (int i = 1; i < EPG; ++i) if (el[i] > m1) { m1 = el[i]; i1 = i; }
            int i2 = -1; float m2 = -3.0e38f; asm volatile("" : "+v"(m2));
#pragma unroll
            for (int i = 0; i < EPG; ++i) if (i != i1 && el[i] > m2) { m2 = el[i]; i2 = i; }
            w1 = gp / (1.0f + __expf(m2 - m1)); w2 = gp / (1.0f + __expf(m1 - m2));
            e1 = gi * EPG + i1; e2 = gi * EPG + i2;
            l1 = __hip_atomic_fetch_add(bc + e1, 1u, __ATOMIC_RELAXED, __HIP_MEMORY_SCOPE_WORKGROUP);
            l2 = __hip_atomic_fetch_add(bc + e2, 1u, __ATOMIC_RELAXED, __HIP_MEMORY_SCOPE_WORKGROUP);
        }
        __syncthreads();
        if (F.tid < NE) { const unsigned n = bc[F.tid]; bc[32 + F.tid] = n ? __hip_atomic_fetch_add(F.ctl + CW_CNT + (li * NE + F.tid) * 64, n, RLX_AGENT) : 0u; }
        __syncthreads();
        if (dec) {
            const int m = tile * 16 + lane;
            unsigned* LIST = (unsigned*)(ws + WS_LIST); float* GWL = (float*)(ws + WS_GWL);
            const unsigned s1 = bc[32 + e1] + l1, s2_ = bc[32 + e2] + l2;
            LIST[(size_t)e1 * T + s1] = (unsigned)m; GWL[(size_t)e1 * T + s1] = w1;
            LIST[(size_t)e2 * T + s2_] = (unsigned)m | 0x80000000u; GWL[(size_t)e2 * T + s2_] = w2;
        }
        __syncthreads();
    }
}

__device__ __forceinline__ void moe_table(const Frame& F, int li) {
    LAS int* tab = (LAS int*)(F.lds + MOETAB_OFF);
    __syncthreads();
    if (F.tid < 64) {
        const int e = F.lane; const int c = (e < NE) ? (int)__hip_atomic_load(F.ctl + CW_CNT + (li * NE + e) * 64, RLX_AGENT) : 0; const int nt = (c + 255) >> 8;
        int incl = nt;
#pragma unroll
        for (int o = 1; o < 32; o <<= 1) { const int v = __builtin_amdgcn_ds_bpermute(((e - o) & 63) << 2, incl); if (e >= o) incl += v; }
        const int excl = incl - nt;
        if (e < NE) { tab[1 + e] = excl * 256; tab[34 + e] = c;
#pragma nounroll
            for (int k = 0; k < nt; ++k) ((LAS unsigned char*)(tab + 66))[excl + k] = (unsigned char)e; }
        if (e == NE - 1) { tab[33] = incl * 256; tab[0] = incl; }
    }
    __syncthreads();
}
__device__ __forceinline__ void phase_rms(const Frame& F, const Args& a, int j) {
    unsigned char* ws = F.ws;
    const int lane = F.lane;
    for (int it0 = F.gw * 4; it0 < 2 * T; it0 += F.NGW * 4) {
        u32x4 w[4]; bf16_t* X[4]; const float* gn[4];
#pragma unroll
        for (int r = 0; r < 4; ++r) { const int it = it0 + r; const int which = it >= T, m = it - which * T;
            X[r] = (bf16_t*)(ws + (which ? WS_CKV : WS_CQ)) + (size_t)m * 512; gn[r] = a.in[which ? I_D_KVN : I_D_QN] + (size_t)j * 512;
            w[r] = *((const u32x4*)X[r] + lane); }
#pragma unroll
        for (int r = 0; r < 4; ++r) {
            float x[8] = {bflo(w[r].x), bfhi(w[r].x), bflo(w[r].y), bfhi(w[r].y), bflo(w[r].z), bfhi(w[r].z), bflo(w[r].w), bfhi(w[r].w)};
            float s = 0.f;
#pragma unroll
            for (int q = 0; q < 8; ++q) s += x[q] * x[q];
            const float rs = 1.0f / sqrtf(wave_sum(s, lane) * (1.0f / 512.0f) + RMS_EPS);
            const f32x4 g0 = *((const f32x4*)gn[r] + 2 * lane), g1 = *((const f32x4*)gn[r] + 2 * lane + 1);
            u32x4 o; o.x = pk2(x[0] * rs * g0[0], x[1] * rs * g0[1]); o.y = pk2(x[2] * rs * g0[2], x[3] * rs * g0[3]);
            o.z = pk2(x[4] * rs * g1[0], x[5] * rs * g1[1]); o.w = pk2(x[6] * rs * g1[2], x[7] * rs * g1[3]);
            *((u32x4*)X[r] + lane) = o;
        }
    }
}

__device__ __forceinline__ void phase_topk(const Frame& F, const Args& a) {
    unsigned char* ws = F.ws;
    const float* IDX = (const float*)(ws + WS_S + S_INDEX); unsigned short* SEL = (unsigned short*)(ws + WS_SEL);
    const int lane = F.lane;
    LAS unsigned* hist = (LAS unsigned*)(F.lds + F.wave * 2048);
    LAS unsigned short* sl = (LAS unsigned short*)(F.lds + F.wave * 2048 + 1024);
    for (int i0 = 0; i0 * F.NGW < T; ++i0) {
        const int m = i0 * F.NGW + (F.gw + i0 * 257) % F.NGW; if (m >= T) continue;
        const int t = m % SEQ; unsigned short* sel = SEL + (size_t)m * TOPK;
        if (t < TOPK) { for (int k = lane; k <= t; k += 64) sel[k] = (unsigned short)k; continue; }
        unsigned key[32];
        const float* row = IDX + (size_t)m * SEQ;
        const int nreg = t >> 6;
#pragma unroll
        for (int i = 0; i < 32; ++i) { const int s = i * 64 + lane; key[i] = (s <= t) ? __builtin_bit_cast(unsigned, row[s]) : 0x7fffffffu; }
        __builtin_amdgcn_sched_barrier(0);
#pragma unroll
        for (int i = 0; i < 32; ++i) { const unsigned u = key[i]; key[i] = (u == 0x7fffffffu) ? 0u : ((u & 0x80000000u) ? ~u : (u | 0x80000000u)); }
        unsigned prefix = 0u; int need = TOPK;
#pragma unroll 1
        for (int shift = 24; shift >= 0; shift -= 8) {
            { unsigned z_ = 0u; asm volatile("" : "+v"(z_)); *(LAS u32x4*)(hist + 4 * lane) = (u32x4){z_, z_, z_, z_}; }
            const unsigned himask = shift == 24 ? 0u : (0xffffffffu << (shift + 8));
#pragma unroll
            for (int q8 = 0; q8 < 4; ++q8) if (q8 * 8 <= nreg) {
#pragma unroll
              for (int i8 = 0; i8 < 8; ++i8) { const unsigned k_ = key[q8 * 8 + i8]; const bool c_ = ((k_ & himask) == prefix) && (k_ != 0u);
                __hip_atomic_fetch_add(hist + (c_ ? ((k_ >> shift) & 255u) : 384u + (unsigned)lane), 1u, __ATOMIC_RELAXED, __HIP_MEMORY_SCOPE_WORKGROUP); } }
            LDS_WAIT(); asm volatile("" ::: "memory");
            const u32x4 h4 = *(const LAS u32x4*)(hist + 4 * lane);
            const int sl = (int)(h4.x + h4.y + h4.z + h4.w);
            int S = sl;
            S += __builtin_amdgcn_update_dpp(0, S, 0x101, 0xf, 0xf, true);
            S += __builtin_amdgcn_update_dpp(0, S, 0x102, 0xf, 0xf, true);
            S += __builtin_amdgcn_update_dpp(0, S, 0x104, 0xf, 0xf, true);
            S += __builtin_amdgcn_update_dpp(0, S, 0x108, 0xf, 0xf, true);
            { const int r1 = __builtin_amdgcn_readlane(S, 16), r2 = __builtin_amdgcn_readlane(S, 32), r3 = __builtin_amdgcn_readlane(S, 48);
              S += (lane < 16 ? r1 : 0) + (lane < 32 ? r2 : 0) + (lane < 48 ? r3 : 0); }
            const unsigned long long mk = __ballot(S >= need);
            const int Ls = 63 - __builtin_clzll(mk);
            const int above = S - sl;
            int bsel = 0, cab = above;
            { const int c3 = above + (int)h4.w, c2 = c3 + (int)h4.z, c1 = c2 + (int)h4.y;
              if (c3 >= need) { bsel = 3; cab = above; } else if (c2 >= need) { bsel = 2; cab = c3; } else if (c1 >= need) { bsel = 1; cab = c2; } else { bsel = 0; cab = c1; } }
            const int Bs = __builtin_amdgcn_readlane(bsel, Ls), Ca = __builtin_amdgcn_readlane(cab, Ls);
            const int hsel = bsel == 3 ? (int)h4.w : (bsel == 2 ? (int)h4.z : (bsel == 1 ? (int)h4.y : (int)h4.x));
            const int Hb = __builtin_amdgcn_readlane(hsel, Ls);
            prefix |= (unsigned)(4 * Ls + Bs) << shift; need -= Ca;
            LDS_WAIT(); asm volatile("" ::: "memory");
            if (shift > 0 && Hb == need && prefix != 0u) { prefix -= 1u; need = 0; break; }
        }
        const unsigned thr = prefix;
        int base = 0;
        const unsigned long long lt = (1ull << lane) - 1ull;
#pragma unroll
        for (int i = 0; i < 32; ++i) if (i <= nreg) { const bool p = key[i] > thr; const unsigned long long mk = __ballot(p);
            if (p) sl[base + __popcll(mk & lt)] = (unsigned short)(i * 64 + lane);
            base += __popcll(mk); }
        int taken = 0;
#pragma unroll
        for (int i = 0; i < 32; ++i) if (i <= nreg) { const bool p = key[i] == thr; const unsigned long long mk = __ballot(p);
            const int pos = taken + __popcll(mk & lt);
            if (p && pos < need) sl[base + pos] = (unsigned short)(i * 64 + lane);
            taken += __popcll(mk); }
        LDS_WAIT(); asm volatile("" ::: "memory");
        if (lane < 32) *((u32x4*)sel + lane) = *((const LAS u32x4*)sl + lane);
        LDS_WAIT(); asm volatile("" ::: "memory");
    }
}

__device__ __forceinline__ int rel_bucket(int n) {
    if (n < 16) return n;
    int b = 16;
    b += (n >= 19); b += (n >= 21); b += (n >= 24); b += (n >= 27); b += (n >= 31); b += (n >= 35); b += (n >= 40); b += (n >= 46);
    b += (n >= 52); b += (n >= 59); b += (n >= 67); b += (n >= 77); b += (n >= 87); b += (n >= 99); b += (n >= 113);
    return b;
}

typedef short s16x4 __attribute__((ext_vector_type(4)));
typedef unsigned short u16x4 __attribute__((ext_vector_type(4)));

__device__ __forceinline__ void phase_indexer2(const Frame& F, const Args& a) {
    unsigned char* ws = F.ws;
    const bf16_t* QI = (const bf16_t*)(ws + WS_S + S_QIDX); const bf16_t* KI = (const bf16_t*)(ws + WS_KIDX); const float* WI = (const float*)(ws + WS_WIDX);
    float* IDX = (float*)(ws + WS_S + S_INDEX);
    const int lane = F.lane, w = F.wave, r16 = lane & 15, g = lane >> 4;
    const float idx_scale = 0.08838834764831845f;
    const int nunits = NB * (SEQ / 16);
    for (int i = 0; i * F.G + F.vcu < nunits; ++i) {
        const int u = i * F.G + F.vcu; const int b = u / (SEQ / 16); int tq = u % (SEQ / 16); if (i & 1) tq = (SEQ / 16 - 1) - tq;
        const size_t row0 = (size_t)b * SEQ + tq * 16;
        __syncthreads();
        { bf16x8 qv[8];
#pragma unroll
          for (int k = 0; k < 8; ++k) { const int f = w * 8 + k, h = f >> 2, ks = f & 3; qv[k] = *(const bf16x8*)(QI + (row0 + r16) * 2048 + h * 128 + 32 * ks + 8 * g); }
          __builtin_amdgcn_sched_barrier(0);
#pragma unroll
          for (int k = 0; k < 8; ++k) *(LAS bf16x8*)(F.lds + (w * 8 + k) * 1024 + lane * 16) = qv[k]; }
        float wq[16];
#pragma unroll
        for (int h4 = 0; h4 < 4; ++h4) { const f32x4 t4 = *(const f32x4*)(WI + (row0 + r16) * 16 + h4 * 4); wq[h4 * 4] = t4[0]; wq[h4 * 4 + 1] = t4[1]; wq[h4 * 4 + 2] = t4[2]; wq[h4 * 4 + 3] = t4[3]; }
        __syncthreads();
        const int npair = (tq >> 1) + 1;
        for (int kp = w; kp < npair; kp += 8) {
            bf16x8 ka[2][4];
#pragma unroll
            for (int t2 = 0; t2 < 2; ++t2)
#pragma unroll
                for (int ks = 0; ks < 4; ++ks) ka[t2][ks] = *(const bf16x8*)(KI + ((size_t)b * SEQ + kp * 32 + t2 * 16 + r16) * 128 + 32 * ks + 8 * g);
            f32x4 acc0 = {0.f, 0.f, 0.f, 0.f}, acc1 = {0.f, 0.f, 0.f, 0.f};
            bf16x8 qb[2][4];
#pragma unroll
            for (int ks = 0; ks < 4; ++ks) qb[0][ks] = *(const LAS bf16x8*)(F.lds + ks * 1024 + lane * 16);
#pragma unroll
            for (int h = 0; h < 16; ++h) {
                __builtin_amdgcn_sched_barrier(0);
                if (h + 1 < 16) {
#pragma unroll
                    for (int ks = 0; ks < 4; ++ks) qb[(h + 1) & 1][ks] = *(const LAS bf16x8*)(F.lds + ((h + 1) * 4 + ks) * 1024 + lane * 16); }
                __builtin_amdgcn_sched_barrier(0);
                f32x4 c0 = {0.f, 0.f, 0.f, 0.f}, c1 = {0.f, 0.f, 0.f, 0.f};
#pragma unroll
                for (int ks = 0; ks < 4; ++ks) { c0 = __builtin_amdgcn_mfma_f32_16x16x32_bf16(ka[0][ks], qb[h & 1][ks], c0, 0, 0, 0); c1 = __builtin_amdgcn_mfma_f32_16x16x32_bf16(ka[1][ks], qb[h & 1][ks], c1, 0, 0, 0); }
                const float wh = wq[h];
#pragma unroll
                for (int j = 0; j < 4; ++j) { acc0[j] += wh * fmaxf(c0[j], 0.f); acc1[j] += wh * fmaxf(c1[j], 0.f); }
            }
            float* op = IDX + (row0 + r16) * SEQ + kp * 32 + 4 * g;
            *(f32x4*)op = acc0 * idx_scale; *(f32x4*)(op + 16) = acc1 * idx_scale;
        }
    }
}


typedef short bf16x4 __attribute__((ext_vector_type(4)));
__device__ __forceinline__ void phase_attn5(const Frame& F, const Args& a, int j) {
    unsigned char* ws = F.ws;
    const bf16_t* QLT = (const bf16_t*)(ws + WS_S + S_QLAT); const bf16_t* KV = (const bf16_t*)(ws + WS_CKV);
    const unsigned short* SEL = (const unsigned short*)(ws + WS_SEL); bf16_t* OL = (bf16_t*)(ws + WS_S + S_OLAT);
    const float* RB = a.in[I_RELB];
    const int lane = F.lane, w = F.wave;
    constexpr int KROW = 1056, WBUF = 16 * KROW;
    LAS unsigned char* const L0 = F.lds;
    LAS unsigned char* const kvs = L0 + w * WBUF;
    LAS float* const rbs = (LAS float*)(L0 + 8 * WBUF);
    LAS unsigned char* const btab = (LAS unsigned char*)(rbs + 512);
    LAS float* const bmax = (LAS float*)(btab + 2048);
    LAS float* const gmx = bmax + 16;
    const float att_scale = 0.08838834764831845f;
    __syncthreads();
    rbs[F.tid] = RB[F.tid];
#pragma unroll
    for (int q = 0; q < 4; ++q) btab[F.tid * 4 + q] = (unsigned char)rel_bucket(F.tid * 4 + q);
    { const float gv = wave_max(fabsf(a.in[I_D_KVN][(size_t)j * KVL + F.tid]), lane); if (lane == 0) gmx[w] = gv; }
    __syncthreads();
    if (F.tid < 16) { float mx = rbs[F.tid];
#pragma unroll
        for (int bk = 1; bk < 32; ++bk) mx = fmaxf(mx, rbs[bk * 16 + F.tid]);
        bmax[F.tid] = mx; }
    __syncthreads();
    const bool affine = (F.G % 8 == 0) && (SEQ % (F.G / 8) == 0);
    const int per = affine ? F.G / 8 : 1;
    const int nit = affine ? SEQ / per : (T - F.vcu + F.G - 1) / F.G;
#pragma unroll 1
    for (int it = w; it < nit; it += 8) {
        int ln_ = lane; asm volatile("" : "+v"(ln_));
        const int r16 = ln_ & 15, gq = ln_ >> 4;
        const unsigned alo = (unsigned)(size_t)(kvs + (4 * gq + (r16 >> 2)) * KROW + (4 * (ln_ & 3)) * 2);
        const int m = affine ? (F.vcu / per) * SEQ + (F.vcu % per) + per * it : F.vcu + it * F.G;
        const int t = m & (SEQ - 1), nk = t + 1 < TOPK ? t + 1 : TOPK, nch = (nk + 15) >> 4;
        const char* kvb = (const char*)KV + (size_t)(m / SEQ) * SEQ * (KVL * 2);
        const unsigned short* sel = SEL + (size_t)m * TOPK;
        bf16x8 qf[16]; float ss = 0.f;
#pragma unroll
        for (int hq = 0; hq < 2; ++hq) { u32x2 q8[8];
#pragma unroll
          for (int s = 0; s < 8; ++s) q8[s] = *(const u32x2*)((const unsigned char*)QLT + ((size_t)m * NH + r16) * KVL + 32 * (8 * hq + s) + 8 * gq);
          __builtin_amdgcn_sched_barrier(0);
#pragma unroll
          for (int s = 0; s < 8; ++s) { const f32x2 a0 = __builtin_amdgcn_cvt_pk_f32_fp8((int)q8[s].x, false), a1 = __builtin_amdgcn_cvt_pk_f32_fp8((int)q8[s].x, true), a2 = __builtin_amdgcn_cvt_pk_f32_fp8((int)q8[s].y, false), a3 = __builtin_amdgcn_cvt_pk_f32_fp8((int)q8[s].y, true);
              ss += (a0[0] * a0[0] + a0[1] * a0[1]) + (a1[0] * a1[0] + a1[1] * a1[1]) + (a2[0] * a2[0] + a2[1] * a2[1]) + (a3[0] * a3[0] + a3[1] * a3[1]);
              u32x4 pk; pk.x = pk2(a0[0], a0[1]); pk.y = pk2(a1[0], a1[1]); pk.z = pk2(a2[0], a2[1]); pk.w = pk2(a3[0], a3[1]); qf[8 * hq + s] = __builtin_bit_cast(bf16x8, pk); }
          __builtin_amdgcn_sched_barrier(0); }
        ss *= (1.0f / 256.0f);
        ss += shx(ss, 16, lane); ss += shx(ss, 32, lane);
        float kvn = gmx[0];
#pragma unroll
        for (int q = 1; q < 8; ++q) kvn = fmaxf(kvn, gmx[q]);
        kvn *= 22.62741699796952f * 1.01f;
        const float Mref = fminf(sqrtf(ss) * kvn * att_scale, 60.0f) + bmax[r16];
        f32x4 oacc[32];
#pragma unroll
        for (int dt = 0; dt < 32; ++dt) oacc[dt] = (f32x4){0.f, 0.f, 0.f, 0.f};
        float Lw = 0.f;
        int selv = (r16 < nk) ? (int)sel[r16] : 0;
        u16x4 s4 = *(const u16x4*)(sel + 4 * gq);
#pragma unroll 1
        for (int c = 0; c < nch; ++c) {
            const int kn = (c + 1) * 16 + r16; int selvn = 0; u16x4 s4n = s4;
            if (c + 1 < nch) { selvn = (kn < nk) ? (int)sel[kn] : 0; s4n = *(const u16x4*)(sel + (c + 1) * 16 + 4 * gq); }
#pragma unroll
            for (int i = 0; i < 16; ++i) { const unsigned off = ((unsigned)__builtin_amdgcn_readlane(selv, i) << 10) + (unsigned)lane * 16u;
                __builtin_amdgcn_global_load_lds((const unsigned*)(kvb + off), (LAS unsigned*)(kvs + i * KROW), 16, 0, 0); }
            asm volatile("s_waitcnt vmcnt(0)" ::: "memory");
            f32x4 st0 = {0.f, 0.f, 0.f, 0.f}, st1 = {0.f, 0.f, 0.f, 0.f};
#pragma unroll
            for (int sg = 0; sg < 4; ++sg) { bf16x8 a4[4];
#pragma unroll
                for (int u = 0; u < 4; ++u) a4[u] = *(const LAS bf16x8*)(kvs + r16 * KROW + 64 * (4 * sg + u) + 16 * gq);
                __builtin_amdgcn_sched_barrier(0);
                st0 = __builtin_amdgcn_mfma_f32_16x16x32_bf16(a4[0], qf[4 * sg], st0, 0, 0, 0); st1 = __builtin_amdgcn_mfma_f32_16x16x32_bf16(a4[1], qf[4 * sg + 1], st1, 0, 0, 0);
                st0 = __builtin_amdgcn_mfma_f32_16x16x32_bf16(a4[2], qf[4 * sg + 2], st0, 0, 0, 0); st1 = __builtin_amdgcn_mfma_f32_16x16x32_bf16(a4[3], qf[4 * sg + 3], st1, 0, 0, 0);
                __builtin_amdgcn_sched_barrier(0); }
            const f32x4 st = st0 + st1;
            float p[4]; bool vv[4]; int bk[4]; float bb[4];
#pragma unroll
            for (int e = 0; e < 4; ++e) { vv[e] = (c * 16 + 4 * gq + e) < nk; const int d = vv[e] ? t - (int)s4[e] : 0; bk[e] = (int)btab[d]; }
            __builtin_amdgcn_sched_barrier(0);
#pragma unroll
            for (int e = 0; e < 4; ++e) bb[e] = rbs[bk[e] * NH + r16];
            __builtin_amdgcn_sched_barrier(0);
#pragma unroll
            for (int e = 0; e < 4; ++e) { const float pe = __expf(st[e] * (att_scale * 0.0625f) + bb[e] - Mref); p[e] = vv[e] ? pe : 0.f; }
            Lw += (p[0] + p[1]) + (p[2] + p[3]);
            u32x2 pw; pw.x = pk2(p[0], p[1]); pw.y = pk2(p[2], p[3]);
            const bf16x4 pf = __builtin_bit_cast(bf16x4, pw);
#pragma unroll
            for (int q8 = 0; q8 < 4; ++q8) {
                bf16x4 ka[8];
                if (q8 == 0) asm volatile("ds_read_b64_tr_b16 %0, %8\n\tds_read_b64_tr_b16 %1, %8 offset:32\n\tds_read_b64_tr_b16 %2, %8 offset:64\n\tds_read_b64_tr_b16 %3, %8 offset:96\n\tds_read_b64_tr_b16 %4, %8 offset:128\n\tds_read_b64_tr_b16 %5, %8 offset:160\n\tds_read_b64_tr_b16 %6, %8 offset:192\n\tds_read_b64_tr_b16 %7, %8 offset:224\n\ts_waitcnt lgkmcnt(0)"
                    : "=&v"(ka[0]), "=&v"(ka[1]), "=&v"(ka[2]), "=&v"(ka[3]), "=&v"(ka[4]), "=&v"(ka[5]), "=&v"(ka[6]), "=&v"(ka[7]) : "v"(alo) : "memory");
                if (q8 == 1) asm volatile("ds_read_b64_tr_b16 %0, %8 offset:256\n\tds_read_b64_tr_b16 %1, %8 offset:288\n\tds_read_b64_tr_b16 %2, %8 offset:320\n\tds_read_b64_tr_b16 %3, %8 offset:352\n\tds_read_b64_tr_b16 %4, %8 offset:384\n\tds_read_b64_tr_b16 %5, %8 offset:416\n\tds_read_b64_tr_b16 %6, %8 offset:448\n\tds_read_b64_tr_b16 %7, %8 offset:480\n\ts_waitcnt lgkmcnt(0)"
                    : "=&v"(ka[0]), "=&v"(ka[1]), "=&v"(ka[2]), "=&v"(ka[3]), "=&v"(ka[4]), "=&v"(ka[5]), "=&v"(ka[6]), "=&v"(ka[7]) : "v"(alo) : "memory");
                if (q8 == 2) asm volatile("ds_read_b64_tr_b16 %0, %8 offset:512\n\tds_read_b64_tr_b16 %1, %8 offset:544\n\tds_read_b64_tr_b16 %2, %8 offset:576\n\tds_read_b64_tr_b16 %3, %8 offset:608\n\tds_read_b64_tr_b16 %4, %8 offset:640\n\tds_read_b64_tr_b16 %5, %8 offset:672\n\tds_read_b64_tr_b16 %6, %8 offset:704\n\tds_read_b64_tr_b16 %7, %8 offset:736\n\ts_waitcnt lgkmcnt(0)"
                    : "=&v"(ka[0]), "=&v"(ka[1]), "=&v"(ka[2]), "=&v"(ka[3]), "=&v"(ka[4]), "=&v"(ka[5]), "=&v"(ka[6]), "=&v"(ka[7]) : "v"(alo) : "memory");
                if (q8 == 3) asm volatile("ds_read_b64_tr_b16 %0, %8 offset:768\n\tds_read_b64_tr_b16 %1, %8 offset:800\n\tds_read_b64_tr_b16 %2, %8 offset:832\n\tds_read_b64_tr_b16 %3, %8 offset:864\n\tds_read_b64_tr_b16 %4, %8 offset:896\n\tds_read_b64_tr_b16 %5, %8 offset:928\n\tds_read_b64_tr_b16 %6, %8 offset:960\n\tds_read_b64_tr_b16 %7, %8 offset:992\n\ts_waitcnt lgkmcnt(0)"
                    : "=&v"(ka[0]), "=&v"(ka[1]), "=&v"(ka[2]), "=&v"(ka[3]), "=&v"(ka[4]), "=&v"(ka[5]), "=&v"(ka[6]), "=&v"(ka[7]) : "v"(alo) : "memory");
#pragma unroll
                for (int e = 0; e < 8; ++e) oacc[q8 * 8 + e] = __builtin_amdgcn_mfma_f32_16x16x16bf16_1k(ka[e], pf, oacc[q8 * 8 + e], 0, 0, 0);
            }
            selv = selvn; s4 = s4n;
        }
        Lw += shx(Lw, 16, lane); Lw += shx(Lw, 32, lane);
        const float inv = 1.0f / Lw;
        int m2_ = m; asm volatile("" : "+s"(m2_));
        bf16_t* op = OL + (size_t)m2_ * (NH * KVL) + r16 * KVL + 4 * gq;
#pragma unroll
        for (int dt = 0; dt < 32; ++dt) { u32x2 o; o.x = pk2(oacc[dt][0] * inv, oacc[dt][1] * inv); o.y = pk2(oacc[dt][2] * inv, oacc[dt][3] * inv); *(u32x2*)(op + 16 * dt) = o; }
    }
    __syncthreads();
}

constexpr int NWAVES = 8;
constexpr int PH_PER_LAYER = 16, N_PHASES = DEPTH * PH_PER_LAYER;
__global__ void __launch_bounds__(NWAVES * 64, 2) fwd(Args args) {
    extern __shared__ __attribute__((aligned(16))) unsigned char lds[];
    Frame F;
    F.lds = (LAS unsigned char*)lds;
    F.MISC = (volatile LAS unsigned*)(F.lds + MISC_OFF);
    F.tid = threadIdx.x; F.lane = F.tid & 63; F.wave = __builtin_amdgcn_readfirstlane(F.tid >> 6);
    F.G = gridDim.x; { const int bx = blockIdx.x; F.vcu = (F.G % 8 == 0) ? (bx % 8) * (F.G / 8) + bx / 8 : bx; }
    F.gw = F.vcu * NWAVES + F.wave; F.NGW = F.G * NWAVES;
    F.ctl = (gu32*)(args.ws + WS_CTL); F.ws = args.ws;
    for (int u = F.tid; u < (LDS_BYTES - LDSCTL_OFF) / 4; u += NWAVES * 64) ((LAS unsigned*)(F.lds + LDSCTL_OFF))[u] = 0u;
    __syncthreads();
    const int lo = args.ph_lo, hi = args.ph_hi;
    const bool single = (hi - lo) > 1;
    XcdBarrier bar; bar.bar = (unsigned*)(F.ctl + CW_BAR); bar.x = 0; bar.st = nullptr;
    if (single) bar = xcd_barrier_post((unsigned*)(F.ctl + CW_BAR), F.MISC + 8, F.tid);
#define IN(k) (lo <= (k) && (k) < hi)
#define SEAM() do { if (single) { int l2_; asm volatile("v_mbcnt_lo_u32_b32 %0, -1, 0\n\tv_mbcnt_hi_u32_b32 %0, -1, %0" : "=v"(l2_)); xcd_barrier(bar, (F.wave == 0 && l2_ == 0) ? 0 : 1); } } while (0)
    const int c = (int)blockIdx.x;
    const auto kargs = __builtin_amdgcn_kernarg_segment_ptr();
    const int wave0 = __builtin_amdgcn_readfirstlane((int)(threadIdx.x >> 6));
    static_assert(offsetof(Args, ws) == 0x108, "PHB reloads ws from kernarg offset 0x108");
#define PHB() unsigned char* ws; { unsigned long long w_; asm volatile("s_load_dwordx2 %0, %1, 0x108\n\ts_waitcnt lgkmcnt(0)" : "=s"(w_) : "s"(kargs) : "memory"); ws = (unsigned char*)(GAS unsigned char*)w_;     \
        int ln_; asm volatile("v_mbcnt_lo_u32_b32 %0, -1, 0\n\tv_mbcnt_hi_u32_b32 %0, -1, %0" : "=v"(ln_)); \
        int wv_ = __builtin_amdgcn_readfirstlane(wave0); asm volatile("" : "+s"(wv_)); \
        F.tid = wv_ * 64 + ln_; F.lane = ln_; F.wave = wv_; F.gw = F.vcu * NWAVES + wv_; F.ws = ws; F.ctl = (gu32*)ws; }
#define TP_BEG(id) do { } while (0)
#define TP_END() do { } while (0)
    for (int li = -1; li < DEPTH; ++li) {
        const int pb = li * PH_PER_LAYER, j = li >> 1;
        if (li >= 0) {
        if ((li & 1) == 0) {
            if (PON(1) && IN(pb + 1)) for (int rp_ = 0; rp_ < 1 + (int)PREP(1); ++rp_) { TP_BEG(1); PHB();
                pg8::Gemm g{(const bf16_t*)(ws + WS_H16), (const bf16_t*)(ws + WS_WMIX + WM_S5_IN), D, D, D, 0, 0}; pg8::SchedGrid S{T / 256, D / 256, 1, F.G, c};
                pg8::EpiStoreBf16 E{(bf16_t*)(ws + WS_S + S_U16), D, 0, 0, 0};
                pg8::gemm_phase(F.lds, g, S, E, F.wave, F.lane); SEAM(); TP_END(); }
            if (PON(2) && IN(pb + 2)) for (int rp_ = 0; rp_ < 1 + (int)PREP(2); ++rp_) { TP_BEG(2); PHB(); phase_ssm2(F, args); SEAM(); TP_END(); }
            if (PON(3) && IN(pb + 3)) for (int rp_ = 0; rp_ < 1 + (int)PREP(3); ++rp_) { TP_BEG(3); PHB();
                pg8::Gemm g{(const bf16_t*)(ws + WS_S + S_Z16), (const bf16_t*)(ws + WS_WMIX + WM_S5_GLU), D, D, D, 0, 0}; pg8::SchedGrid S{T / 256, D / 256, 1, F.G, c};
                pg8::EpiGlu E{(const bf16_t*)(ws + WS_S + S_Z16), (bf16_t*)(ws + WS_S + S_ZZ16), D};
                pg8::gemm_phase(F.lds, g, S, E, F.wave, F.lane); SEAM(); TP_END(); }
            if (PON(4) && IN(pb + 4)) for (int rp_ = 0; rp_ < 1 + (int)PREP(4); ++rp_) { TP_BEG(4); PHB();
                pg8::Gemm g{(const bf16_t*)(ws + WS_S + S_ZZ16), (const bf16_t*)(ws + WS_WMIX + WM_S5_OUT), D, D, D, 0, 0}; pg8::SchedGrid S{T / 256, D / 256, 1, F.G, c};
                pg8::EpiResid E{(bf16_t*)(ws + WS_H16), D, DN_ALPHA};
                pg8::gemm_phase(F.lds, g, S, E, F.wave, F.lane); SEAM(); TP_END(); }
        } else {
            if (PON(17) && IN(pb + 1)) for (int rp_ = 0; rp_ < 1 + (int)PREP(17); ++rp_) { TP_BEG(17); PHB();
                pg8::Gemm g{(const bf16_t*)(ws + WS_H16), (const bf16_t*)(ws + WS_WMIX + WM_D_IN), D, D, D, 0, 0}; pg8::SchedGrid S{T / 256, 4, 1, F.G, c};
                pg8::EpiDsaIn E{(bf16_t*)(ws + WS_CQ), (bf16_t*)(ws + WS_CKV), (bf16_t*)(ws + WS_KIDX), (float*)(ws + WS_WIDX), 0};
                pg8::gemm_phase(F.lds, g, S, E, F.wave, F.lane);
                SEAM(); TP_END(); }
            if (PON(18) && IN(pb + 2)) for (int rp_ = 0; rp_ < 1 + (int)PREP(18); ++rp_) { TP_BEG(18); PHB(); phase_rms(F, args, j); SEAM(); TP_END(); }
            if (PON(19) && IN(pb + 3)) for (int rp_ = 0; rp_ < 1 + (int)PREP(19); ++rp_) { TP_BEG(19); PHB();
                { const int ntail = T / 256;
                  pg8::Gemm g{(const bf16_t*)(ws + WS_H16), (const bf16_t*)(ws + WS_WMIX + WM_D_IN) + (size_t)4 * 256 * D, D, D, D, 0, 0}; pg8::SchedGrid S{ntail, 1, 1, F.G, c};
                  pg8::EpiDsaIn E{(bf16_t*)(ws + WS_CQ), (bf16_t*)(ws + WS_CKV), (bf16_t*)(ws + WS_KIDX), (float*)(ws + WS_WIDX), 4};
                  pg8::gemm_phase(F.lds, g, S, E, F.wave, F.lane); }
                pg8::Gemm g{(const bf16_t*)(ws + WS_CQ), (const bf16_t*)(ws + WS_WMIX + WM_D_Q), QL, QL, QL, 0, 0};
                pg8::SchedGridSplit S{pg8::SchedGrid{T / 256, 4096 / 256, 1, F.G, c}, (T / 256 < F.G) ? T / 256 : 0, 4};
                pg8::EpiStoreBf16 E{(bf16_t*)(ws + WS_S + S_Q16), 2048, 0, 2048, (size_t)(S_QIDX - S_Q16) / 2};
                pg8::gemm_phase(F.lds, g, S, E, F.wave, F.lane); SEAM(); TP_END(); }
            if (PON(20) && IN(pb + 4)) for (int rp_ = 0; rp_ < 1 + (int)PREP(20); ++rp_) { TP_BEG(20); PHB();
                pg8::Gemm g{(const bf16_t*)(ws + WS_S + S_Q16), (const bf16_t*)(ws + WS_WMIX + WM_D_UK), 2048, 128, 128, 128, 512 * 128}; pg8::SchedGrid S{T / 256, 512 / 256, 16, F.G, c};
                pg8::EpiStoreFp8 E{(unsigned char*)(ws + WS_S + S_QLAT), NH * KVL, 512};
                pg8::gemm_phase(F.lds, g, S, E, F.wave, F.lane); TP_END(); }
            if (PON(21) && IN(pb + 5)) for (int rp_ = 0; rp_ < 1 + (int)PREP(21); ++rp_) { TP_BEG(21); PHB(); phase_indexer2(F, args); SEAM(); TP_END(); }
            if (PON(22) && IN(pb + 6)) for (int rp_ = 0; rp_ < 1 + (int)PREP(22); ++rp_) { TP_BEG(22); PHB(); phase_topk(F, args); SEAM(); TP_END(); }
            if (PON(23) && IN(pb + 7)) for (int rp_ = 0; rp_ < 1 + (int)PREP(23); ++rp_) { TP_BEG(23); PHB(); phase_attn5(F, args, j); SEAM(); TP_END(); }
            if (PON(24) && IN(pb + 8)) for (int rp_ = 0; rp_ < 1 + (int)PREP(24); ++rp_) { TP_BEG(24); PHB();
                pg8::Gemm g{(const bf16_t*)(ws + WS_S + S_OLAT), (const bf16_t*)(ws + WS_WMIX + WM_D_UV), NH * KVL, 1024, 1024, 1024, 256 * 1024}; pg8::SchedGrid S{T / 256, 1, 8, F.G, c};
                pg8::EpiStoreBf16 E{(bf16_t*)(ws + WS_S + S_O16), D, 256, 0, 0};
                pg8::gemm_phase(F.lds, g, S, E, F.wave, F.lane); SEAM(); TP_END(); }
            if (PON(25) && IN(pb + 9)) for (int rp_ = 0; rp_ < 1 + (int)PREP(25); ++rp_) { TP_BEG(25); PHB();
                pg8::Gemm g{(const bf16_t*)(ws + WS_S + S_O16), (const bf16_t*)(ws + WS_WMIX + WM_D_OUT), D, D, D, 0, 0}; pg8::SchedGrid S{T / 256, D / 256, 1, F.G, c};
                pg8::EpiResid E{(bf16_t*)(ws + WS_H16), D, DN_ALPHA};
                pg8::gemm_phase(F.lds, g, S, E, F.wave, F.lane); SEAM(); TP_END(); }
        }
        if (PON(15) && IN(pb + 15)) for (int rp_ = 0; rp_ < 1 + (int)PREP(15); ++rp_) { TP_BEG(15); PHB(); phase_router(F, args, li); SEAM(); TP_END(); }
        if (PON(12) && IN(pb + 12)) for (int rp_ = 0; rp_ < 1 + (int)PREP(12); ++rp_) { TP_BEG(12); PHB();
            moe_table(F, li);
            const LAS int* tab = (const LAS int*)(F.lds + MOETAB_OFF);
            unsigned* dep = (unsigned*)(F.ctl + CW_DEP + li * 192 * 16);
            { pg8::SchedMoe S{tab, 1, F.G, F.vcu};
              LAS int* gtok = (LAS int*)(F.lds + RING_BYTES);
              { const unsigned* LIST = (const unsigned*)(ws + WS_LIST);
#pragma unroll
                for (int ui = 0; ui < 3; ++ui) { pg8::Unit u; if (S.next(ui, u) && F.tid < 256) { const int slot = u.pm * 256 + F.tid - tab[1 + u.pb];
                      gtok[ui * 256 + F.tid] = slot < tab[34 + u.pb] ? (int)(LIST[(size_t)u.pb * T + slot] & 0x7fffffffu) : 0; } } }
              __syncthreads();
              pg8::Gemm g{(const bf16_t*)(ws + WS_H16), (const bf16_t*)(ws + WS_WMOE + WE_GU), D, D, D, 0, 512 * D};
              pg8::EpiMoe1 E{(bf16_t*)(ws + WS_S + S_HMID), (const float*)(ws + WS_GWL), tab, dep};
              pg8::gemm_phase<pg8::EpiMoe1, pg8::SchedMoe, true>(F.lds, g, S, E, F.wave, F.lane, gtok); }
            { pg8::Gemm g{(const bf16_t*)(ws + WS_S + S_HMID), (const bf16_t*)(ws + WS_WMOE + WE_DN), FF, FF, FF, 0, D * FF}; pg8::SchedMoe2 S{tab, dep, F.G, F.vcu};
              pg8::EpiMoe2 E{(unsigned char*)(ws + WS_S + S_Y0), (unsigned char*)(ws + WS_S + S_Y1), (const unsigned*)(ws + WS_LIST), tab};
              pg8::gemm_phase(F.lds, g, S, E, F.wave, F.lane); }
            SEAM(); TP_END(); }
        }
        if (PON(14)) for (int rp_ = 0; rp_ < 1 + (int)PREP(14); ++rp_) { TP_BEG(14); PHB(); if (li >= 0) phase_ln<1>(F, args, li, F.gw, F.NGW, T);
            if (li + 1 < DEPTH) phase_conv(F, args, li + 1);
            SEAM(); TP_END(); }
    }
#undef IN
#undef SEAM
#undef PHB
}

extern "C" void kernel_launch(void* const* d_in, const int* in_sizes, int n_in, void* d_out, int out_size, void* d_ws, size_t ws_size, hipStream_t stream) {
    static int grid = 0;
    if (grid == 0) {
        if (n_in != 32 || out_size != T * D || ws_size < WS_END) { fprintf(stderr, "kernel_launch: unexpected problem (n_in %d, out %d, ws %zu)\n", n_in, out_size, ws_size); grid = -1; return; }
        int dev = 0, cus = 0, per_cu = 0;
        if (hipGetDevice(&dev) != hipSuccess || hipDeviceGetAttribute(&cus, hipDeviceAttributeMultiprocessorCount, dev) != hipSuccess) { grid = -1; return; }
        if (hipFuncSetAttribute((const void*)fwd, hipFuncAttributeMaxDynamicSharedMemorySize, LDS_BYTES) != hipSuccess) { fprintf(stderr, "kernel_launch: hipFuncSetAttribute failed\n"); grid = -1; return; }
        if (hipOccupancyMaxActiveBlocksPerMultiprocessor(&per_cu, (const void*)fwd, NWAVES * 64, LDS_BYTES) != hipSuccess || per_cu < 1) fprintf(stderr, "kernel_launch: occupancy query reports %d\n", per_cu);
        (void)hipGetLastError();
        grid = cus;
    }
    if (grid < 0) return;
    (void)hipMemsetAsync((char*)d_ws + WS_CTL, 0, CTL_ZERO_BYTES, stream);
    Args a{};
    for (int i = 0; i < 32; ++i) a.in[i] = (const float*)d_in[i];
    a.out = (float*)d_out; a.ws = (unsigned char*)d_ws;
    a.ph_lo = 0; a.ph_hi = N_PHASES;
    hipLaunchKernelGGL(fwd, dim3(grid), dim3(NWAVES * 64), LDS_BYTES, stream, a);
}
```

```cpp
#include <hip/hip_runtime.h>
#include <cstdio>
#include <cstdint>
#include <cstddef>


#ifndef MK_PHMASK
#define MK_PHMASK 0xffffffffu
#endif
#define PON(k) (((MK_PHMASK) >> (k)) & 1u)
#ifndef MK_REPEAT
#define MK_REPEAT 0u
#endif
#define PREP(k) (((MK_REPEAT) >> (k)) & 1u)
#define LAS __attribute__((address_space(3)))
#define GAS __attribute__((address_space(1)))
typedef unsigned short bf16_t;
typedef short bf16x8 __attribute__((ext_vector_type(8)));
typedef float f32x4 __attribute__((ext_vector_type(4)));
typedef float f32x2 __attribute__((ext_vector_type(2)));
typedef unsigned u32x4 __attribute__((ext_vector_type(4)));
typedef unsigned u32x2 __attribute__((ext_vector_type(2)));
typedef GAS unsigned gu32;

constexpr int NB = 8, SEQ = 2048, T = NB * SEQ, D = 2048, DEPTH = 4;
constexpr int S5G = 128, S5P = 16, S5N = 64;
constexpr int NH = 16, HD = 128, QL = 512, KVL = 512, IDXD = 128, TOPK = 256;
constexpr int DSA_IN = QL + KVL + IDXD + NH;
constexpr int DSA_IN_PAD = 1280;
constexpr int NE = 32, EPG = 8, NG = 4, FF = 256;
constexpr float LN_EPS = 1e-5f, RMS_EPS = 1e-6f;
constexpr float DN_ALPHA = 1.6817928305074290f;
constexpr int MAXPOS = 40960;

constexpr size_t MiB = 1u << 20;
constexpr size_t WS_CTL = 0, CTL_ZERO_BYTES = 1 * MiB;
constexpr size_t WS_RT = 1 * MiB;
constexpr size_t WS_S5C = 2 * MiB;
constexpr size_t WS_LIST = 4 * MiB;
constexpr size_t WS_GWL = 6 * MiB;
constexpr size_t WS_TPOS = 8 * MiB;
constexpr size_t WS_GPOS = 9 * MiB;
constexpr size_t WS_WIDX = 10 * MiB;
constexpr size_t WS_KIDX = 12 * MiB;
constexpr size_t WS_SEL = 16 * MiB;
constexpr size_t WS_CQ = 24 * MiB;
constexpr size_t WS_CKV = 40 * MiB;
constexpr size_t WS_WMIX = 56 * MiB;
constexpr size_t WS_WMOE = 88 * MiB;
constexpr size_t WS_H32 = 184 * MiB;
constexpr size_t WS_H16 = 312 * MiB;
constexpr size_t WS_S = 376 * MiB;
constexpr size_t WS_S5T = 888 * MiB;
constexpr size_t S5T_FD = 0, S5T_WS = 2 * MiB, S5T_WY = 10 * MiB, S5T_A16 = 18 * MiB;
constexpr size_t WS_END = 908 * MiB;
constexpr size_t WM_S5_IN = 0, WM_S5_GLU = 8 * MiB, WM_S5_OUT = 16 * MiB;
constexpr size_t WM_D_IN = 0  , WM_D_Q = 6 * MiB  , WM_D_UK = 10 * MiB  , WM_D_UV = 14 * MiB  , WM_D_OUT = 18 * MiB  ;
constexpr size_t WE_GU = 0, WE_DN = 64 * MiB;
constexpr size_t S_U16 = 0, S_Z16 = 64 * MiB, S_ZZ16 = 128 * MiB;
constexpr size_t S_QLAT = 0, S_O16 = 0, S_Q16 = 256 * MiB, S_QIDX = 320 * MiB, S_INDEX = 384 * MiB, S_OLAT = 256 * MiB;
constexpr size_t S_XS = 0, S_HMID = 160 * MiB, S_Y0 = 192 * MiB, S_Y1 = 256 * MiB, S_H16LO = 320 * MiB;
constexpr int CW_TMO = 0, CW_CODE = 1, CW_BAR = 4096, CW_CNT = 16384, CW_DEP = 65536;

constexpr int RING_BYTES = 131072;
constexpr int LDSCTL_OFF = 159744, MISC_OFF = LDSCTL_OFF + 320;
constexpr int MOETAB_OFF = LDSCTL_OFF + 1024;
constexpr int LDS_BYTES = 163840;

#define RLX_AGENT __ATOMIC_RELAXED, __HIP_MEMORY_SCOPE_AGENT
#define LDS_WAIT() asm volatile("s_waitcnt lgkmcnt(0)" ::: "memory")
#define VM_WAIT() asm volatile("s_waitcnt vmcnt(0)" ::: "memory")

__device__ __forceinline__ unsigned f2bf(float f) { unsigned u = __builtin_bit_cast(unsigned, f); return (u + 0x7fffu + ((u >> 16) & 1u)) >> 16; }
__device__ __forceinline__ unsigned pk2(float lo, float hi) { return f2bf(lo) | (f2bf(hi) << 16); }
__device__ __forceinline__ float bf2f(unsigned b) { return __builtin_bit_cast(float, b << 16); }
__device__ __forceinline__ float bflo(unsigned w) { return __builtin_bit_cast(float, w << 16); }
__device__ __forceinline__ float bfhi(unsigned w) { return __builtin_bit_cast(float, w & 0xffff0000u); }
__device__ __forceinline__ int shx_i(int v, int o, int lane) { return __builtin_amdgcn_ds_bpermute((lane ^ o) << 2, v); }
__device__ __forceinline__ float shx(float v, int o, int lane) { return __builtin_bit_cast(float, __builtin_amdgcn_ds_bpermute((lane ^ o) << 2, __builtin_bit_cast(int, v))); }
#define DPP_F(x, ctrl) __builtin_bit_cast(float, __builtin_amdgcn_update_dpp(0, __builtin_bit_cast(int, (x)), (ctrl), 0xf, 0xf, false))
__device__ __forceinline__ float wave_sum(float v, int lane) {
    (void)lane;
    float t = v;
    t += DPP_F(t, 0xB1);
    t += DPP_F(t, 0x4E);
    t += DPP_F(t, 0x141);
    t += DPP_F(t, 0x140);
    const float s0 = __builtin_bit_cast(float, __builtin_amdgcn_readlane(__builtin_bit_cast(int, t), 0)), s1 = __builtin_bit_cast(float, __builtin_amdgcn_readlane(__builtin_bit_cast(int, t), 16));
    const float s2 = __builtin_bit_cast(float, __builtin_amdgcn_readlane(__builtin_bit_cast(int, t), 32)), s3 = __builtin_bit_cast(float, __builtin_amdgcn_readlane(__builtin_bit_cast(int, t), 48));
    return (s0 + s1) + (s2 + s3);
}
__device__ __forceinline__ float wave_max(float v, int lane) {
#pragma unroll
    for (int o = 1; o < 64; o <<= 1) v = fmaxf(v, shx(v, o, lane));
    return v;
}

namespace pg8 {
constexpr int BM = 256, BK = 64, HALF = 128, HTB = HALF * BK * 2, STAGE_BYTES = 8 * HTB, NXCD = 8, WGM = 8;
__host__ __device__ __forceinline__ int lds_byte(int r, int c) { const int st = (r >> 4) * 2 + (c >> 5), rr = r & 15, cc = c & 31, ob = rr * 64 + cc * 2; return st * 1024 + (ob ^ (((ob >> 9) & 1) << 5)); }
__host__ __device__ __forceinline__ void stage_rc(int b, int& R, int& C) { const int st = b / 1024, sb = b % 1024, swz = sb ^ (((sb >> 9) & 1) << 5); R = (st >> 1) * 16 + swz / 64; C = (st & 1) * 32 + (swz % 64) / 2; }
__host__ __device__ __forceinline__ int perm32(int rho) { const int n = rho >> 4, i = rho & 15; return 8 * (i >> 2) + 4 * n + (i & 3); }

struct Unit { int pm, pn, pb; };
struct Gemm { const bf16_t* A; const bf16_t* Bt; int lda, ldb, K; long long sA, sB; };

struct SchedGrid {
    int nM, nN, nB, G, c;
    __device__ __forceinline__ bool next(int i, Unit& u) const { return unit((long)i * G + c, u); }
    __device__ __forceinline__ bool unit(long L, Unit& u) const {
        const int per = nM * nN, nwg = per * nB; if (L >= nwg) return false;
        int wgid = (int)L; { const int q = nwg / NXCD, r = nwg % NXCD, xcd = wgid % NXCD, off = wgid / NXCD; wgid = (xcd < r ? xcd * (q + 1) : r * (q + 1) + (xcd - r) * q) + off; }
        u.pb = wgid / per; const int w = wgid % per;
        const int nig = WGM * nN, gid = w / nig, fm = gid * WGM, gsz = (nM - fm) < WGM ? (nM - fm) : WGM;
        u.pm = fm + ((w % nig) % gsz); u.pn = (w % nig) / gsz; return true;
    }
};
struct SchedGridSplit {
    SchedGrid base; int thr, KA;
    __device__ __forceinline__ bool next(int i, Unit& u) const {
        const int G = base.G, c = base.c, U2 = base.nM * base.nN * base.nB, nl = G - thr;
        const int NA = (KA * nl < U2) ? KA * nl : U2;
        long L;
        if (c >= thr) { const int q = c - thr; const int ra = q < NA ? (NA - q + nl - 1) / nl : 0;
            L = i < ra ? (long)q + (long)i * nl : (long)NA + c + (long)(i - ra) * G; }
        else L = (long)NA + c + (long)i * G;
        return base.unit(L, u);
    }
};
struct SchedMoe {
    const LAS int* tab; int sh  , G, c;
    __device__ __forceinline__ bool next(int i, Unit& u) const {
        const int nmt = __builtin_amdgcn_readfirstlane(tab[0]); const long L = (long)i * G + c; if (L >= ((long)nmt << sh)) return false;
        const int mt = (int)(L >> sh); u.pm = mt; u.pn = (int)(L & ((1 << sh) - 1)); u.pb = __builtin_amdgcn_readfirstlane((int)((const LAS unsigned char*)(tab + 66))[mt]); return true;
    }
};

struct SchedMoe2 {
    const LAS int* tab; unsigned* dep; int G, c;
    static constexpr int KA = 4;
    __device__ __forceinline__ bool next(int i, Unit& u) const {
        const int nmt = __builtin_amdgcn_readfirstlane(tab[0]); const int U1 = nmt << 1, U2 = nmt << 3;
        const int maxu = (U1 + G - 1) / G, thr = U1 - G * (maxu - 1), nl = G - thr;
        const int NA = (KA * nl < U2) ? KA * nl : U2;
        long L;
        if (c >= thr) { const int q = c - thr; const int ra = q < NA ? (NA - q + nl - 1) / nl : 0;
            L = i < ra ? (long)q + (long)i * nl : (long)NA + c + (long)(i - ra) * G; }
        else L = (long)NA + c + (long)i * G;
        if (L >= U2) return false;
        const int mt = (int)(L >> 3); u.pm = mt; u.pn = (int)(L & 7); u.pb = __builtin_amdgcn_readfirstlane((int)((const LAS unsigned char*)(tab + 66))[mt]);
        unsigned sp = 0u;
        while (__hip_atomic_load(dep + 16 * mt, __ATOMIC_RELAXED, __HIP_MEMORY_SCOPE_AGENT) < 2u) { __builtin_amdgcn_s_sleep(2); if (++sp > (1u << 20)) break; }
        asm volatile("" ::: "memory");
        return true;
    }
};

__device__ __forceinline__ unsigned cvt_pk_bf16(float lo, float hi) { unsigned r; asm volatile("v_cvt_pk_bf16_f32 %0, %1, %2" : "=v"(r) : "v"(lo), "v"(hi)); return r; }

struct EpiStoreBf16 {
    static constexpr bool PERM = true; static constexpr bool SIGNAL = false;
    bf16_t* O; int ldc; int bcol; int split_cols; size_t split_stride;
    __device__ __forceinline__ void operator()(const f32x4 (&acc)[2][2][4][2], const Unit& u, int wr, int wc, int fr, int fq) const {
        const int row0 = u.pm * BM + wr * 64 + fr; int colt = u.pn * BM; bf16_t* base = O + (size_t)u.pb * bcol;
        if (split_cols) { const int t = colt / split_cols; base += (size_t)t * split_stride; colt -= t * split_cols; }
        const int col0 = colt + wc * 32 + 8 * fq;
#pragma unroll
        for (int ai = 0; ai < 2; ++ai)
#pragma unroll
            for (int m = 0; m < 4; ++m) { bf16_t* rowp = base + (size_t)(row0 + ai * HALF + m * 16) * ldc + col0;
#pragma unroll
                for (int bj = 0; bj < 2; ++bj) { const f32x4 v0 = acc[ai][bj][m][0], v1 = acc[ai][bj][m][1];
                    u32x4 w; w.x = cvt_pk_bf16(v0[0], v0[1]); w.y = cvt_pk_bf16(v0[2], v0[3]); w.z = cvt_pk_bf16(v1[0], v1[1]); w.w = cvt_pk_bf16(v1[2], v1[3]);
                    *(u32x4*)(rowp + bj * HALF) = w; } }
    }
};
struct EpiStoreFp8 {
    static constexpr bool PERM = true; static constexpr bool SIGNAL = false;
    unsigned char* O; int ldc; int bcol;
    __device__ __forceinline__ void operator()(const f32x4 (&acc)[2][2][4][2], const Unit& u, int wr, int wc, int fr, int fq) const {
        const int row0 = u.pm * BM + wr * 64 + fr; unsigned char* base = O + (size_t)u.pb * bcol;
        const int col0 = u.pn * BM + wc * 32 + 8 * fq;
#pragma unroll
        for (int ai = 0; ai < 2; ++ai)
#pragma unroll
            for (int m = 0; m < 4; ++m) { unsigned char* rowp = base + (size_t)(row0 + ai * HALF + m * 16) * ldc + col0;
#pragma unroll
                for (int bj = 0; bj < 2; ++bj) { const f32x4 v0 = acc[ai][bj][m][0] * 16.0f, v1 = acc[ai][bj][m][1] * 16.0f;
                    int p0 = __builtin_amdgcn_cvt_pk_fp8_f32(v0[0], v0[1], 0, false); p0 = __builtin_amdgcn_cvt_pk_fp8_f32(v0[2], v0[3], p0, true);
                    int p1 = __builtin_amdgcn_cvt_pk_fp8_f32(v1[0], v1[1], 0, false); p1 = __builtin_amdgcn_cvt_pk_fp8_f32(v1[2], v1[3], p1, true);
                    u32x2 w; w.x = (unsigned)p0; w.y = (unsigned)p1; *(u32x2*)(rowp + bj * HALF) = w; } }
    }
};
struct EpiGlu {
    static constexpr bool PERM = true; static constexpr bool SIGNAL = false;
    const bf16_t* Z; bf16_t* O; int ldc;
    __device__ __forceinline__ void operator()(const f32x4 (&acc)[2][2][4][2], const Unit& u, int wr, int wc, int fr, int fq) const {
        const int row0 = u.pm * BM + wr * 64 + fr, col0 = u.pn * BM + wc * 32 + 8 * fq;
        u32x4 zv[2][4][2];
#pragma unroll
        for (int ai = 0; ai < 2; ++ai)
#pragma unroll
            for (int m = 0; m < 4; ++m)
#pragma unroll
                for (int bj = 0; bj < 2; ++bj) zv[ai][m][bj] = *(const u32x4*)(Z + (size_t)(row0 + ai * HALF + m * 16) * ldc + col0 + bj * HALF);
        __builtin_amdgcn_sched_barrier(0);
#pragma unroll
        for (int ai = 0; ai < 2; ++ai) {
#pragma unroll
            for (int m = 0; m < 4; ++m) { const size_t ro = (size_t)(row0 + ai * HALF + m * 16) * ldc + col0;
#pragma unroll
                for (int bj = 0; bj < 2; ++bj) { const f32x4 v0 = acc[ai][bj][m][0], v1 = acc[ai][bj][m][1];
                    const u32x4 z = zv[ai][m][bj];
                    float r[8]; const float a[8] = {v0[0], v0[1], v0[2], v0[3], v1[0], v1[1], v1[2], v1[3]};
                    const float zz[8] = {bflo(z.x), bfhi(z.x), bflo(z.y), bfhi(z.y), bflo(z.z), bfhi(z.z), bflo(z.w), bfhi(z.w)};
#pragma unroll
                    for (int j = 0; j < 8; ++j) r[j] = zz[j] / (1.0f + __expf(-a[j]));
                    u32x4 w; w.x = cvt_pk_bf16(r[0], r[1]); w.y = cvt_pk_bf16(r[2], r[3]); w.z = cvt_pk_bf16(r[4], r[5]); w.w = cvt_pk_bf16(r[6], r[7]);
                    *(u32x4*)(O + ro + bj * HALF) = w; } }
            __builtin_amdgcn_sched_barrier(0);
        }
    }
};
struct EpiResid {
    static constexpr bool PERM = true; static constexpr bool SIGNAL = false;
    bf16_t* H; int ldc; float alpha;
    __device__ __forceinline__ void operator()(const f32x4 (&acc)[2][2][4][2], const Unit& u, int wr, int wc, int fr, int fq) const {
        const int row0 = u.pm * BM + wr * 64 + fr, col0 = u.pn * BM + wc * 32 + 8 * fq;
        u32x4 hv[2][4][2];
#pragma unroll
        for (int ai = 0; ai < 2; ++ai)
#pragma unroll
            for (int m = 0; m < 4; ++m)
#pragma unroll
                for (int bj = 0; bj < 2; ++bj) hv[ai][m][bj] = *(const u32x4*)(H + (size_t)(row0 + ai * HALF + m * 16) * ldc + col0 + bj * HALF);
        __builtin_amdgcn_sched_barrier(0);
#pragma unroll
        for (int ai = 0; ai < 2; ++ai) {
#pragma unroll
            for (int m = 0; m < 4; ++m) { bf16_t* rowp = H + (size_t)(row0 + ai * HALF + m * 16) * ldc + col0;
#pragma unroll
                for (int bj = 0; bj < 2; ++bj) { const f32x4 v0 = acc[ai][bj][m][0], v1 = acc[ai][bj][m][1]; const u32x4 h = hv[ai][m][bj];
                    u32x4 w; w.x = cvt_pk_bf16(bflo(h.x) * alpha + v0[0], bfhi(h.x) * alpha + v0[1]); w.y = cvt_pk_bf16(bflo(h.y) * alpha + v0[2], bfhi(h.y) * alpha + v0[3]);
                    w.z = cvt_pk_bf16(bflo(h.z) * alpha + v1[0], bfhi(h.z) * alpha + v1[1]); w.w = cvt_pk_bf16(bflo(h.w) * alpha + v1[2], bfhi(h.w) * alpha + v1[3]);
                    *(u32x4*)(rowp + bj * HALF) = w; } }
            __builtin_amdgcn_sched_barrier(0);
        }
    }
};
struct EpiDsaIn {
    static constexpr bool PERM = true; static constexpr bool SIGNAL = false;
    bf16_t* CQ; bf16_t* CKV; bf16_t* KIDX; float* WIDX; int pn0;
    __device__ __forceinline__ void operator()(const f32x4 (&acc)[2][2][4][2], const Unit& u0, int wr, int wc, int fr, int fq) const {
        Unit u = u0; u.pn += pn0;
        const int row0 = u.pm * BM + wr * 64 + fr, cb = wc * 32 + 8 * fq;
#pragma unroll
        for (int ai = 0; ai < 2; ++ai)
#pragma unroll
            for (int m = 0; m < 4; ++m) { const size_t row = (size_t)(row0 + ai * HALF + m * 16);
#pragma unroll
                for (int bj = 0; bj < 2; ++bj) { const f32x4 v0 = acc[ai][bj][m][0], v1 = acc[ai][bj][m][1];
                    u32x4 w; w.x = cvt_pk_bf16(v0[0], v0[1]); w.y = cvt_pk_bf16(v0[2], v0[3]); w.z = cvt_pk_bf16(v1[0], v1[1]); w.w = cvt_pk_bf16(v1[2], v1[3]);
                    if (u.pn < 2) *(u32x4*)(CQ + row * 512 + u.pn * 256 + bj * HALF + cb) = w;
                    else if (u.pn < 4) *(u32x4*)(CKV + row * 512 + (u.pn - 2) * 256 + bj * HALF + cb) = w;
                    else if (bj == 0) *(u32x4*)(KIDX + row * 128 + cb) = w;
                    else if (cb < 16) { *(f32x4*)(WIDX + row * 16 + cb) = v0 * 0.25f; *(f32x4*)(WIDX + row * 16 + cb + 4) = v1 * 0.25f; } } }
    }
};
struct EpiMoe1 {
    static constexpr bool PERM = true; static constexpr bool SIGNAL = true;
    bf16_t* HM; const float* GWL; const LAS int* tab; unsigned* dep;
    __device__ __forceinline__ void operator()(const f32x4 (&acc)[2][2][4][2], const Unit& u, int wr, int wc, int fr, int fq) const {
        const int row0 = u.pm * BM + wr * 64 + fr, cb = u.pn * 128 + wc * 32 + 8 * fq;
        const int poff = tab[1 + u.pb], cnt = tab[34 + u.pb];
        float gwv[2][4];
#pragma unroll
        for (int ai = 0; ai < 2; ++ai)
#pragma unroll
            for (int m = 0; m < 4; ++m) { const int slot = row0 + ai * HALF + m * 16 - poff; gwv[ai][m] = slot < cnt ? GWL[(size_t)u.pb * T + slot] : 0.f; }
        __builtin_amdgcn_sched_barrier(0);
#pragma unroll
        for (int ai = 0; ai < 2; ++ai)
#pragma unroll
            for (int m = 0; m < 4; ++m) { const int pos = row0 + ai * HALF + m * 16; const float gw = gwv[ai][m];
                const f32x4 g0 = acc[ai][0][m][0], g1 = acc[ai][0][m][1], u0 = acc[ai][1][m][0], u1 = acc[ai][1][m][1];
                const float g[8] = {g0[0], g0[1], g0[2], g0[3], g1[0], g1[1], g1[2], g1[3]}, uu[8] = {u0[0], u0[1], u0[2], u0[3], u1[0], u1[1], u1[2], u1[3]}; float r[8];
#pragma unroll
                for (int j = 0; j < 8; ++j) r[j] = g[j] / (1.0f + __expf(-g[j])) * uu[j] * gw;
                u32x4 w; w.x = cvt_pk_bf16(r[0], r[1]); w.y = cvt_pk_bf16(r[2], r[3]); w.z = cvt_pk_bf16(r[4], r[5]); w.w = cvt_pk_bf16(r[6], r[7]);
                *(u32x4*)(HM + (size_t)pos * 256 + cb) = w; }
    }
};
struct EpiMoe2 {
    static constexpr bool PERM = true; static constexpr bool SIGNAL = false;
    unsigned char* Y0; unsigned char* Y1; const unsigned* LIST; const LAS int* tab;
    __device__ __forceinline__ void operator()(const f32x4 (&acc)[2][2][4][2], const Unit& u, int wr, int wc, int fr, int fq) const {
        const int row0 = u.pm * BM + wr * 64 + fr, col0 = u.pn * BM + wc * 32 + 8 * fq;
        const int poff = tab[1 + u.pb], cnt = tab[34 + u.pb];
        unsigned tkv2[2][4];
#pragma unroll
        for (int ai = 0; ai < 2; ++ai)
#pragma unroll
          for (int m = 0; m < 4; ++m) { const int slot = row0 + ai * HALF + m * 16 - poff; tkv2[ai][m] = slot < cnt ? LIST[(size_t)u.pb * T + slot] : 0xffffffffu; }
        __builtin_amdgcn_sched_barrier(0);
#pragma unroll
        for (int ai = 0; ai < 2; ++ai) {
#pragma unroll
            for (int m = 0; m < 4; ++m) { const unsigned tk = tkv2[ai][m];
                if (tk != 0xffffffffu) { unsigned char* rowp = ((tk >> 31) ? Y1 : Y0) + (size_t)(tk & 0x7fffffffu) * D + col0;
#pragma unroll
                    for (int bj = 0; bj < 2; ++bj) { const f32x4 v0 = acc[ai][bj][m][0] * 16.0f, v1 = acc[ai][bj][m][1] * 16.0f;
                        int p0 = __builtin_amdgcn_cvt_pk_fp8_f32(v0[0], v0[1], 0, false); p0 = __builtin_amdgcn_cvt_pk_fp8_f32(v0[2], v0[3], p0, true);
                        int p1 = __builtin_amdgcn_cvt_pk_fp8_f32(v1[0], v1[1], 0, false); p1 = __builtin_amdgcn_cvt_pk_fp8_f32(v1[2], v1[3], p1, true);
                        u32x2 w; w.x = (unsigned)p0; w.y = (unsigned)p1; *(u32x2*)(rowp + bj * HALF) = w; } } }
        }
    }
};

template <class Epi, class Sched, bool GATHER = false>
__device__ __forceinline__ void gemm_phase(LAS unsigned char* lds, const Gemm g, const Sched& S, const Epi& E, int wid, int lane, const LAS int* gtok = nullptr) {
    const int tid = wid * 64 + lane, wr = wid >> 2, wc = wid & 3, fr = lane & 15, fq = lane >> 4;
    const int K = g.K, nt = K / BK;
    unsigned voffA[2], voffB[2];
#pragma unroll
    for (int i = 0; i < 2; ++i) { int R, C; stage_rc(tid * 16 + i * 8192, R, C); const int Rb = Epi::PERM ? ((R & ~31) + perm32(R & 31)) : R;
        voffA[i] = GATHER ? (unsigned)(R * 65536 + C * 2) : (unsigned)(R * g.lda + C) * 2u; voffB[i] = (unsigned)(Rb * g.ldb + C) * 2u; }
    const size_t kstep = (size_t)(BK * 2);
    const size_t hstepA = GATHER ? 0 : (size_t)HALF * g.lda * 2, hstepB = (size_t)HALF * g.ldb * 2;
    unsigned vc[2][2], vn[2][2];
#define PG8_GTOK(dst, ui_) do { _Pragma("unroll") for (int h_ = 0; h_ < 2; ++h_) _Pragma("unroll") for (int i_ = 0; i_ < 2; ++i_) \
        dst[h_][i_] = (unsigned)gtok[(ui_) * 256 + h_ * HALF + (int)(voffA[i_] >> 16)] * (unsigned)(g.lda * 2) + (voffA[i_] & 0xffffu); } while (0)
    const unsigned ldsw = (unsigned)wid * 1024u;
    const int aoff = lds_byte(wr * 64 + fr, fq * 8), boff = lds_byte(wc * 32 + fr, fq * 8);
#define PG8_SA(b, h) (((b) * 2 + (h)) * HTB)
#define PG8_SB(b, h) ((4 + (b) * 2 + (h)) * HTB)
#define PG8_STAGE(bufoff, gbase, voff) do { _Pragma("unroll") for (int _i = 0; _i < 2; ++_i) \
        __builtin_amdgcn_global_load_lds((const unsigned*)((const char*)(gbase) + (voff)[_i]), (LAS unsigned*)(lds + (bufoff) + ldsw + _i * 8192), 16, 0, 0); } while (0)
#define PG8_LDA(dst, b, h) do { _Pragma("unroll") for (int m = 0; m < 4; ++m) _Pragma("unroll") for (int k = 0; k < 2; ++k) dst[m][k] = *(const LAS bf16x8*)(lds + PG8_SA(b, h) + aoff + m * 2048 + k * 1024); } while (0)
#define PG8_LDB(dst, b, h) do { _Pragma("unroll") for (int n = 0; n < 2; ++n) _Pragma("unroll") for (int k = 0; k < 2; ++k) dst[n][k] = *(const LAS bf16x8*)(lds + PG8_SB(b, h) + boff + n * 2048 + k * 1024); } while (0)
#define PG8_MMA(ai, bj, At, Bt) do { __builtin_amdgcn_s_setprio(1); _Pragma("unroll") for (int m = 0; m < 4; ++m) _Pragma("unroll") for (int n = 0; n < 2; ++n) _Pragma("unroll") for (int k = 0; k < 2; ++k) \
        acc[ai][bj][m][n] = __builtin_amdgcn_mfma_f32_16x16x32_bf16(Bt[n][k], At[m][k], acc[ai][bj][m][n], 0, 0, 0); __builtin_amdgcn_s_setprio(0); } while (0)
#define PG8_WAIT_V(n) asm volatile("s_waitcnt vmcnt(" #n ")" ::: "memory")
#define PG8_WAIT_L(n) asm volatile("s_waitcnt lgkmcnt(" #n ")" ::: "memory")
#define PG8_BAR __builtin_amdgcn_s_barrier()
#define PG8_SCHED __builtin_amdgcn_sched_barrier(0)
#define PG8_TA(u) (GATHER ? (const char*)g.A : (const char*)g.A + ((size_t)(u).pb * (size_t)g.sA + (size_t)(u).pm * BM * (size_t)g.lda) * 2)
#define PG8_STAGE_A(bufoff, gbase, h, nx) do { if constexpr (GATHER) { unsigned vo_[2] = {(nx) ? vn[h][0] : vc[h][0], (nx) ? vn[h][1] : vc[h][1]}; PG8_STAGE(bufoff, gbase, vo_); } else { PG8_STAGE(bufoff, (gbase) + (h) * hstepA, voffA); } } while (0)
#define PG8_TB(u) ((const char*)g.Bt + ((size_t)(u).pb * (size_t)g.sB + (size_t)(u).pn * BM * (size_t)g.ldb) * 2)
    Unit cur, nxt; int ui = 0;
    if (!S.next(0, cur)) return;
    f32x4 acc[2][2][4][2];
#pragma unroll
    for (int a = 0; a < 2; ++a)
#pragma unroll
        for (int b = 0; b < 2; ++b)
#pragma unroll
            for (int m = 0; m < 4; ++m)
#pragma unroll
                for (int n = 0; n < 2; ++n) acc[a][b][m][n] = (f32x4){0.f, 0.f, 0.f, 0.f};
    bf16x8 At[4][2], B0[2][2], B1[2][2];
    const char* cA = PG8_TA(cur); const char* cB = PG8_TB(cur);
    if constexpr (GATHER) { PG8_GTOK(vc, 0); PG8_GTOK(vn, 0); }
    PG8_STAGE(PG8_SB(0, 0), cB, voffB); PG8_STAGE(PG8_SB(0, 1), cB + hstepB, voffB); PG8_STAGE_A(PG8_SA(0, 0), cA, 0, false); PG8_STAGE_A(PG8_SA(0, 1), cA, 1, false);
    if (wr == 1) PG8_BAR;
    PG8_WAIT_V(2); PG8_BAR;
    PG8_STAGE(PG8_SB(1, 0), cB + kstep, voffB); PG8_STAGE_A(PG8_SA(1, 0), cA + kstep, 0, false); PG8_STAGE(PG8_SB(1, 1), cB + hstepB + kstep, voffB);
    PG8_WAIT_V(6); PG8_BAR;
    for (;;) {
        const bool has_next = S.next(ui + 1, nxt);
        const char* nA = has_next ? PG8_TA(nxt) : cA; const char* nB = has_next ? PG8_TB(nxt) : cB;
        for (int t = 0; t < nt; t += 2) {
            const bool last = (t == nt - 2);
            const char* a1 = cA + (size_t)(t + 1) * kstep;
            const char* a2 = last ? nA : cA + (size_t)(t + 2) * kstep; const char* b2 = last ? nB : cB + (size_t)(t + 2) * kstep;
            const char* a3 = a2 + kstep; const char* b3 = b2 + kstep;
            if constexpr (GATHER) { if (last && has_next) PG8_GTOK(vn, ui + 1); }
            PG8_LDB(B0, 0, 0); PG8_LDB(B1, 0, 1); PG8_SCHED; PG8_LDA(At, 0, 0); PG8_STAGE_A(PG8_SA(1, 1), a1, 1, false);
            PG8_WAIT_V(8); PG8_WAIT_L(0); PG8_BAR; PG8_MMA(0, 0, At, B0); PG8_MMA(0, 1, At, B1); PG8_BAR; PG8_SCHED;
            PG8_LDA(At, 0, 1); PG8_STAGE(PG8_SB(0, 0), b2, voffB); PG8_STAGE(PG8_SB(0, 1), b2 + hstepB, voffB); PG8_STAGE_A(PG8_SA(0, 0), a2, 0, last);
            PG8_WAIT_V(8); PG8_WAIT_L(0); PG8_BAR; PG8_MMA(1, 0, At, B0); PG8_MMA(1, 1, At, B1); PG8_BAR; PG8_SCHED;
            PG8_LDB(B0, 1, 0); PG8_LDB(B1, 1, 1); PG8_SCHED; PG8_LDA(At, 1, 0); PG8_STAGE_A(PG8_SA(0, 1), a2, 1, last);
            PG8_WAIT_V(8); PG8_WAIT_L(0); PG8_BAR; PG8_MMA(0, 0, At, B0); PG8_MMA(0, 1, At, B1); PG8_BAR; PG8_SCHED;
            PG8_LDA(At, 1, 1); PG8_STAGE(PG8_SB(1, 0), b3, voffB); PG8_STAGE(PG8_SB(1, 1), b3 + hstepB, voffB); PG8_STAGE_A(PG8_SA(1, 0), a3, 0, last);
            PG8_WAIT_V(8); PG8_WAIT_L(0); PG8_BAR; PG8_MMA(1, 0, At, B0); PG8_MMA(1, 1, At, B1); PG8_BAR; PG8_SCHED;
        }
        if (wr == 0) PG8_BAR;
        { int l2_; asm volatile("v_mbcnt_lo_u32_b32 %0, -1, 0\n\tv_mbcnt_hi_u32_b32 %0, -1, %0" : "=v"(l2_)); E(acc, cur, wr, wc, l2_ & 15, l2_ >> 4);
          if constexpr (Epi::SIGNAL) { PG8_WAIT_V(0); PG8_BAR;
              if (wid == 0 && l2_ == 0) { __builtin_amdgcn_fence(__ATOMIC_RELEASE, "agent"); (void)__hip_atomic_fetch_add(E.dep + 16 * cur.pm, 1u, __ATOMIC_RELAXED, __HIP_MEMORY_SCOPE_AGENT); } } }
        if (!has_next) break;
#pragma unroll
        for (int a = 0; a < 2; ++a)
#pragma unroll
            for (int b = 0; b < 2; ++b)
#pragma unroll
                for (int m = 0; m < 4; ++m)
#pragma unroll
                    for (int n = 0; n < 2; ++n) acc[a][b][m][n] = (f32x4){0.f, 0.f, 0.f, 0.f};
        cur = nxt; cA = nA; cB = nB; ++ui;
        if constexpr (GATHER) { _Pragma("unroll") for (int h_ = 0; h_ < 2; ++h_) _Pragma("unroll") for (int i_ = 0; i_ < 2; ++i_) vc[h_][i_] = vn[h_][i_]; }
        if (wr == 1) PG8_BAR;
    }
    PG8_WAIT_V(0);
    PG8_BAR;
#undef PG8_SA
#undef PG8_SB
#undef PG8_STAGE
#undef PG8_LDA
#undef PG8_LDB
#undef PG8_MMA
#undef PG8_WAIT_V
#undef PG8_WAIT_L
#undef PG8_BAR
#undef PG8_SCHED
#undef PG8_TA
#undef PG8_STAGE_A
#undef PG8_GTOK
#undef PG8_TB
}
}

#define XB_TMO      128
#define XB_XCNT(j)  (256  + 64 * (j))
#define XB_XSUB(j)  (1280 + 64 * (j))
#define XB_XGEN(j)  (2304 + 64 * (j))
#define XB_TOP      3328
#define XB_TOPGEN   3392
#define XCD_BAR_WORDS 3456
#define XB_SPIN_CAP (1u << 18)
__device__ __forceinline__ unsigned xb_ld(unsigned* p)              { return __hip_atomic_load(p, __ATOMIC_RELAXED, __HIP_MEMORY_SCOPE_AGENT); }
__device__ __forceinline__ unsigned xb_add(unsigned* p, unsigned v) { return __hip_atomic_fetch_add(p, v, __ATOMIC_RELAXED, __HIP_MEMORY_SCOPE_AGENT); }
__device__ __forceinline__ unsigned xb_xcc_id() { return (unsigned)__builtin_amdgcn_s_getreg((3 << 11) | 20) & 0xFu; }
#define XB_SPIN(cond, bar) do { unsigned _sp = 0; while (cond) { __builtin_amdgcn_s_sleep(1); \
    if ((++_sp & 255u) == 0u) { if (xb_ld(&(bar)[XB_TMO])) break; if (_sp > XB_SPIN_CAP) { atomicAdd(&(bar)[XB_TMO], 1u); break; } } } } while (0)
struct XcdBarrier { unsigned* bar; unsigned x; volatile LAS unsigned* st; };
__device__ __forceinline__ XcdBarrier xcd_barrier_post(unsigned* bar, volatile LAS unsigned* st, int tid) {
    XcdBarrier b; b.bar = bar; b.x = xb_xcc_id(); b.st = st;
    if (tid == 0) (void)xb_add(&bar[XB_XCNT(b.x)], 1u);
    return b;
}
__device__ __forceinline__ void xcd_barrier_complete(unsigned* bar, unsigned x, unsigned& nloc, unsigned& nx) {
    const unsigned G = gridDim.x * gridDim.y * gridDim.z;
    unsigned sum, cnt, mine, sp = 0u;
    for (;;) {
        sum = 0u; cnt = 0u; mine = 0u;
#pragma unroll
        for (unsigned j = 0; j < 16; ++j) { const unsigned c = xb_ld(&bar[XB_XCNT(j)]); sum += c; cnt += (c > 0u) ? 1u : 0u; mine = (j == x) ? c : mine; }
        if (sum == G) break;
        __builtin_amdgcn_s_sleep(1);
        if ((++sp & 255u) == 0u) { if (xb_ld(&bar[XB_TMO])) break; if (sp > XB_SPIN_CAP) { atomicAdd(&bar[XB_TMO], 1u); break; } }
    }
    nloc = mine > 0u ? mine : 1u; nx = cnt > 0u ? cnt : 1u;
}
__device__ __forceinline__ void xcd_barrier(const XcdBarrier& b, int tid) {
    asm volatile("s_waitcnt vmcnt(0)" ::: "memory");
    __syncthreads();
    if (tid == 0) {
        unsigned* bar; { unsigned long long bb_ = (unsigned long long)b.bar; asm volatile("" : "+s"(bb_)); bar = (unsigned*)(GAS unsigned*)bb_; }
        __builtin_amdgcn_s_waitcnt(0);
        unsigned nloc = b.st[0], nx = b.st[1];
        if (nloc == 0u) { xcd_barrier_complete(bar, b.x, nloc, nx); b.st[0] = nloc; b.st[1] = nx; }
        const unsigned old = xb_add(&bar[XB_XSUB(b.x)], 1u);
        const unsigned gen = old / nloc;
        if (old + 1u == (gen + 1u) * nloc) {
            __builtin_amdgcn_fence(__ATOMIC_RELEASE, "agent");
            asm volatile("s_waitcnt vmcnt(0)" ::: "memory");
            const unsigned og = xb_add(&bar[XB_TOP], 1u);
            const unsigned tg = og / nx;
            if (og + 1u == (tg + 1u) * nx) xb_add(&bar[XB_TOPGEN], 1u);
            else XB_SPIN(xb_ld(&bar[XB_TOPGEN]) == tg, bar);
            __builtin_amdgcn_fence(__ATOMIC_ACQUIRE, "agent");
            asm volatile("s_waitcnt vmcnt(0)" ::: "memory");
        } else {
            XB_SPIN(xb_ld(&bar[XB_TOPGEN]) == gen, bar);
            __builtin_amdgcn_fence(__ATOMIC_ACQUIRE, "agent");
            asm volatile("s_waitcnt vmcnt(0)" ::: "memory");
        }
    }
    __syncthreads();
}

struct Args { const float* in[32]; float* out; unsigned char* ws; int ph_lo, ph_hi; };
struct Frame {
    LAS unsigned char* lds;
    volatile LAS unsigned* MISC;
    gu32* ctl;
    int tid, lane, wave, G, vcu, gw, NGW;
    unsigned char* ws;
};
enum { I_X = 0, I_RELB, I_S5_WIN, I_S5_ARE, I_S5_AIM, I_S5_LOGDT, I_S5_BRE, I_S5_BIM, I_S5_CRE, I_S5_CIM, I_S5_D, I_S5_WGLU, I_S5_WOUT,
       I_D_WIN, I_D_QN, I_D_KVN, I_D_WUQ, I_D_WQIDX, I_D_WUK, I_D_WUV, I_D_WOUT,
       I_M_WG, I_M_BG, I_M_WE, I_M_BE, I_M_WGATE, I_M_WUP, I_M_WDOWN, I_LNM_G, I_LNM_B, I_LNF_G, I_LNF_B };

__device__ __forceinline__ void tr_item(const float* src, int ldS, int nvalid, bf16_t* dst, int ldD, long zoff, bool zfill, LAS float* scr, int lane) {
    const int nn = lane & 31; const bool ok = nn < nvalid;
    const float* sp = src + (size_t)(lane >> 5) * ldS + nn; const size_t st2 = (size_t)2 * ldS;
#pragma unroll
    for (int hb = 0; hb < 2; ++hb) {
        float tv[16];
#pragma unroll
        for (int i = 0; i < 16; ++i) { tv[i] = ok ? *sp : 0.f; sp += st2; }
        __builtin_amdgcn_sched_barrier(0);
#pragma unroll
        for (int i = 0; i < 16; ++i) scr[(2 * (hb * 16 + i) + (lane >> 5)) * 33 + nn] = tv[i];
        __builtin_amdgcn_sched_barrier(0);
    }
    LDS_WAIT(); asm volatile("" ::: "memory");
    const int c = lane & 7;
#pragma unroll
    for (int j = 0; j < 4; ++j) { const int n = (lane >> 3) + 8 * j; const LAS float* s = scr + (8 * c) * 33 + n;
        u32x4 o; o.x = pk2(s[0 * 33], s[1 * 33]); o.y = pk2(s[2 * 33], s[3 * 33]); o.z = pk2(s[4 * 33], s[5 * 33]); o.w = pk2(s[6 * 33], s[7 * 33]);
        *(GAS u32x4*)(dst + (size_t)n * ldD + 8 * c) = o;
        if (zfill) *(GAS u32x4*)(dst + zoff + (size_t)n * ldD + 8 * c) = (u32x4){0u, 0u, 0u, 0u}; }
    LDS_WAIT(); asm volatile("" ::: "memory");
}

__device__ __forceinline__ void s5_tables(const Frame& F, const Args& a, int j) {
    unsigned char* ws = F.ws;
    LAS f32x2* PW = (LAS f32x2*)F.lds;
    LAS f32x2* BBs = PW + 17 * 64;
    LAS f32x2* Cs = BBs + 1024;
    LAS float* Ks = (LAS float*)(Cs + 1024);
    for (int item = F.vcu; item < 2 * S5G; item += F.G) {
        const int g = item >> 1, half = item & 1;
        __syncthreads();
        const float dt = expf(a.in[I_S5_LOGDT][j * S5G + g]);
        for (int idx = F.tid; idx < 17 * 64; idx += 512) { const int k = idx >> 6, n = idx & 63;
            const float are = fminf(a.in[I_S5_ARE][((size_t)j * S5G + g) * S5N + n], -1e-4f), aim = a.in[I_S5_AIM][((size_t)j * S5G + g) * S5N + n];
            const float x = are * dt * (float)k, y = aim * dt * (float)k; float sy, cy; sincosf(y, &sy, &cy); const float ex = expf(x);
            PW[idx] = (f32x2){ex * cy, ex * sy}; }
        for (int idx = F.tid; idx < 1024; idx += 512) { const int n = idx >> 4;
            const float are = fminf(a.in[I_S5_ARE][((size_t)j * S5G + g) * S5N + n], -1e-4f), aim = a.in[I_S5_AIM][((size_t)j * S5G + g) * S5N + n];
            const float x = are * dt, y = aim * dt; float sy, cy; sincosf(y, &sy, &cy); const float ex = expf(x), sh = sinf(0.5f * y);
            const float nr = expm1f(x) * cy - 2.0f * sh * sh, ni = ex * sy, den = are * are + aim * aim;
            const float cr = (nr * are + ni * aim) / den, ci = (ni * are - nr * aim) / den;
            const float br = a.in[I_S5_BRE][(((size_t)j * S5G + g) * S5N) * S5P + idx], bi = a.in[I_S5_BIM][(((size_t)j * S5G + g) * S5N) * S5P + idx];
            BBs[idx] = (f32x2){cr * br - ci * bi, cr * bi + ci * br}; }
        for (int idx = F.tid; idx < 1024; idx += 512) Cs[idx] = (f32x2){a.in[I_S5_CRE][((size_t)j * S5G + g) * S5P * S5N + idx], a.in[I_S5_CIM][((size_t)j * S5G + g) * S5P * S5N + idx]};
        __syncthreads();
        { const int lag = F.tid >> 5, p = (F.tid >> 1) & 15, qh = F.tid & 1; float kacc[8];
#pragma unroll
          for (int q = 0; q < 8; ++q) kacc[q] = 0.f;
#pragma unroll 4
          for (int n = 0; n < S5N; ++n) { const f32x2 c = Cs[p * 64 + n], w = PW[lag * 64 + n];
              const float tr = c.x * w.x - c.y * w.y, ti = c.x * w.y + c.y * w.x;
              const LAS f32x4* bq = (const LAS f32x4*)(BBs + n * 16 + qh * 8);
#pragma unroll
              for (int q2 = 0; q2 < 4; ++q2) { const f32x4 b2 = bq[q2]; kacc[2 * q2] += tr * b2[0] - ti * b2[1]; kacc[2 * q2 + 1] += tr * b2[2] - ti * b2[3]; } }
#pragma unroll
          for (int q = 0; q < 8; ++q) { float v = kacc[q]; if (lag == 0 && p == qh * 8 + q) v += a.in[I_S5_D][((size_t)j * S5G + g) * S5P + p]; Ks[(lag * 16 + p) * 16 + qh * 8 + q] = v; } }
        __syncthreads();
        bf16_t* FD = (bf16_t*)(ws + WS_S5T + S5T_FD) + (size_t)g * 16 * 512; bf16_t* WS_ = (bf16_t*)(ws + WS_S5T + S5T_WS) + (size_t)g * 128 * 256; bf16_t* WY = (bf16_t*)(ws + WS_S5T + S5T_WY) + (size_t)g * 256 * 128;
        for (int idx = F.tid; idx < 8 * 512; idx += 512) { const int d = 8 * half + (idx >> 9), l = (idx >> 3) & 63, jj = idx & 7, p = l & 15, gq = l >> 4;
            float v = 0.f; if (gq < 2) v = Ks[(d * 16 + p) * 16 + 8 * gq + jj]; else if (d >= 1) v = Ks[((d - 1) * 16 + p) * 16 + 8 * (gq - 2) + jj];
            FD[(size_t)d * 512 + (idx & 511)] = (bf16_t)f2bf(v); }
        for (int idx = F.tid; idx < 64 * 256; idx += 512) { const int R = 64 * half + (idx >> 8), k = idx & 255, n = R >> 1, c = R & 1, s_ = k >> 4, q = k & 15;
            const f32x2 w = PW[(15 - s_) * 64 + n], bq = BBs[n * 16 + q];
            const float v = c ? (w.x * bq.y + w.y * bq.x) : (w.x * bq.x - w.y * bq.y);
            WS_[(size_t)R * 256 + k] = (bf16_t)f2bf(v); }
        for (int idx = F.tid; idx < 128 * 128; idx += 512) { const int R = 128 * half + (idx >> 7), k = idx & 127, t = R >> 4, p = R & 15, n = k >> 1, c = k & 1;
            const f32x2 cc = Cs[p * 64 + n], w = PW[(t + 1) * 64 + n];
            const float v = c ? -(cc.x * w.y + cc.y * w.x) : (cc.x * w.x - cc.y * w.y);
            WY[(size_t)R * 128 + k] = (bf16_t)f2bf(v); }
        if (half == 0 && F.tid < 64) ((f32x2*)(ws + WS_S5T + S5T_A16))[g * 64 + F.tid] = PW[16 * 64 + F.tid];
    }
    __syncthreads();
}

struct CvItem { const float* src; bf16_t* dst; int ldS, ldD, nvalid, zoff; };
__device__ __forceinline__ int conv_nmix(int li) { return (li & 1) == 0 ? 3 * 2048 : (1280 + 1024 + 512 + 512 + 2048); }
__device__ __forceinline__ CvItem conv_item(const Args& a, unsigned char* ws, int li, int r) {
    const int j = li >> 1; const bool s5 = (li & 1) == 0; const int nmix = conv_nmix(li);
    CvItem I; I.nvalid = 32; I.zoff = 0;
    if (r < nmix) {
        if (s5) { const int mat = r / 2048, item = r % 2048, kb = item / 64, nb = item % 64;
            const float* W = a.in[mat == 0 ? I_S5_WIN : (mat == 1 ? I_S5_WGLU : I_S5_WOUT)] + (size_t)j * D * D;
            I.src = W + (size_t)(kb * 64) * D + nb * 32; I.ldS = D; I.dst = (bf16_t*)(ws + WS_WMIX + (size_t)mat * 8 * MiB) + (size_t)(nb * 32) * D + kb * 64; I.ldD = D; return I; }
        if (r < 1280) { const int kb = r / 40, nb = r % 40; const float* W = a.in[I_D_WIN] + (size_t)j * D * DSA_IN;
            int nv = DSA_IN - nb * 32; nv = nv < 0 ? 0 : (nv > 32 ? 32 : nv);
            I.src = W + (size_t)(kb * 64) * DSA_IN + (nv ? nb * 32 : 0); I.ldS = DSA_IN; I.nvalid = nv;        I.dst = (bf16_t*)(ws + WS_WMIX + WM_D_IN) + (size_t)(nb * 32) * D + kb * 64; I.ldD = D; return I; }
        r -= 1280;
        if (r < 1024) { const int mat = r / 512, item = r % 512, kb = item / 64, nb = item % 64;
            const float* W = a.in[mat == 0 ? I_D_WUQ : I_D_WQIDX] + (size_t)j * QL * 2048;
            I.src = W + (size_t)(kb * 64) * 2048 + nb * 32; I.ldS = 2048; I.dst = (bf16_t*)(ws + WS_WMIX + WM_D_Q) + (size_t)(mat * 2048 + nb * 32) * QL + kb * 64; I.ldD = QL; return I; }
        r -= 1024;
        if (r < 512) { const int h = r / 32, item = r % 32, kb = item / 16, nb = item % 16;
            const float* W = a.in[I_D_WUK] + ((size_t)j * NH + h) * HD * KVL;
            I.src = W + (size_t)(kb * 64) * KVL + nb * 32; I.ldS = KVL; I.dst = (bf16_t*)(ws + WS_WMIX + WM_D_UK) + (size_t)h * 512 * 128 + (size_t)(nb * 32) * 128 + kb * 64; I.ldD = 128; return I; }
        r -= 512;
        if (r < 512) { const int h = r / 32, item = r % 32, kb = item / 4, nb = item % 4, p = h >> 1, hh = h & 1;
            const float* W = a.in[I_D_WUV] + ((size_t)j * NH + h) * KVL * HD;
            I.src = W + (size_t)(kb * 64) * HD + nb * 32; I.ldS = HD; I.dst = (bf16_t*)(ws + WS_WMIX + WM_D_UV) + (size_t)p * 256 * 1024 + (size_t)(hh * 128 + nb * 32) * 1024 + hh * 512 + kb * 64; I.ldD = 1024;
            I.zoff = hh ? -512 : 512; return I; }
        r -= 512;
        { const int kb = r / 64, nb = r % 64; const float* W = a.in[I_D_WOUT] + (size_t)j * D * D;
          I.src = W + (size_t)(kb * 64) * D + nb * 32; I.ldS = D; I.dst = (bf16_t*)(ws + WS_WMIX + WM_D_OUT) + (size_t)(nb * 32) * D + kb * 64; I.ldD = D; return I; }
    }
    r -= nmix;
    if (r < 16384) { const int job = r / 128, item = r % 128, e = job >> 2, which = (job >> 1) & 1, fg = job & 1, kb = item / 4, nb = item % 4;
        const float* W = a.in[which ? I_M_WUP : I_M_WGATE] + ((size_t)li * NE + e) * D * FF;
        I.src = W + (size_t)(kb * 64) * FF + fg * 128 + nb * 32; I.ldS = FF; I.dst = (bf16_t*)(ws + WS_WMOE + WE_GU) + (size_t)e * 512 * D + (size_t)(fg * 256 + which * 128 + nb * 32) * D + kb * 64; I.ldD = D; return I; }
    r -= 16384;
    { const int e = r / 256, item = r % 256, kb = item / 64, nb = item % 64;
      const float* W = a.in[I_M_WDOWN] + ((size_t)li * NE + e) * FF * D;
      I.src = W + (size_t)(kb * 64) * D + nb * 32; I.ldS = D; I.dst = (bf16_t*)(ws + WS_WMOE + WE_DN) + (size_t)e * D * FF + (size_t)(nb * 32) * FF + kb * 64; I.ldD = FF; return I; }
}
__device__ __forceinline__ void conv_run(const Frame& F, const Args& a, int li, int r0, int r1, int first, int stride) {
    unsigned char* ws = F.ws;
    LAS float* scr = (LAS float*)(F.lds + F.wave * 16384);
    int r = r0 + first; if (r >= r1) return;
    const int lane = F.lane, nn = lane & 31, hi = lane >> 5, c = lane & 7;
    CvItem cur = conv_item(a, ws, li, r);
    float tv[32];
#define CV_LOAD(I_) do { const unsigned vo_ = ((unsigned)hi * (unsigned)(I_).ldS + (unsigned)(nn < (I_).nvalid ? nn : 0)) * 4u; const char* sb_ = (const char*)(I_).src; const size_t st2_ = (size_t)8 * (I_).ldS; \
        _Pragma("unroll") for (int i_ = 0; i_ < 32; ++i_) { tv[i_] = *(const float*)(sb_ + vo_); sb_ += st2_; } } while (0)
    CV_LOAD(cur);
    for (;;) {
        __builtin_amdgcn_sched_barrier(0);
        const bool okc = nn < cur.nvalid;
#pragma unroll
        for (int i = 0; i < 32; ++i) scr[(2 * i + hi) * 33 + nn] = okc ? tv[i] : 0.f;
        __builtin_amdgcn_sched_barrier(0);
        r += stride; const bool more = r < r1;
        CvItem nxt = cur;
        if (more) { nxt = conv_item(a, ws, li, r); CV_LOAD(nxt); }
        __builtin_amdgcn_sched_barrier(0);
        LDS_WAIT(); asm volatile("" ::: "memory");
#pragma unroll
        for (int q = 0; q < 4; ++q) { const int n = (lane >> 3) + 8 * q; const LAS float* sl = scr + (8 * c) * 33 + n;
            u32x4 o; o.x = pk2(sl[0 * 33], sl[1 * 33]); o.y = pk2(sl[2 * 33], sl[3 * 33]); o.z = pk2(sl[4 * 33], sl[5 * 33]); o.w = pk2(sl[6 * 33], sl[7 * 33]);
            *(GAS u32x4*)(cur.dst + (size_t)n * cur.ldD + 8 * c) = o;
            if (cur.zoff) { unsigned z0 = 0u; asm volatile("" : "+v"(z0)); *(GAS u32x4*)(cur.dst + cur.zoff + (size_t)n * cur.ldD + 8 * c) = (u32x4){z0, z0, z0, z0}; } }
        LDS_WAIT(); asm volatile("" ::: "memory");
        if (!more) break;
        cur = nxt;
    }
#undef CV_LOAD
}
__device__ __forceinline__ void phase_conv(const Frame& F, const Args& a, int li) {
    unsigned char* ws = F.ws;
    const int j = li >> 1; const bool s5 = (li & 1) == 0;
    if (s5) s5_tables(F, a, j);
    conv_run(F, a, li, 0, conv_nmix(li) + 24576, F.gw, F.NGW);
    if (li == 0) {
        const float* x = a.in[I_X]; bf16_t* h16 = (bf16_t*)(ws + WS_H16);
        for (int m = F.gw; m < T; m += F.NGW) {
            const f32x4* xr = (const f32x4*)(x + (size_t)m * D) + F.lane; u32x2* br = (u32x2*)(h16 + (size_t)m * D) + F.lane;
            f32x4 xv[8];
#pragma unroll
            for (int q = 0; q < 8; ++q) xv[q] = xr[64 * q];
            __builtin_amdgcn_sched_barrier(0);
#pragma unroll
            for (int q = 0; q < 8; ++q) { const f32x4 v = xv[q]; u32x2 w; w.x = pk2(v[0], v[1]); w.y = pk2(v[2], v[3]); br[64 * q] = w; }
        }
    }
    {
        const int gt = F.vcu * 512 + F.tid;
        if (gt < 48 * D) { const int n = gt / D, k = gt % D;
            const float v = n < NG ? a.in[I_M_WG][((size_t)li * D + k) * NG + n] : (n < NG + NE ? a.in[I_M_WE][((size_t)li * D + k) * NE + (n - NG)] : 0.f);
            const unsigned hi = f2bf(v); const unsigned lo = f2bf(v - bf2f(hi));
            bf16_t* RT = (bf16_t*)(ws + WS_RT); RT[gt] = (bf16_t)hi; RT[48 * D + gt] = (bf16_t)lo; }
    }
}

__device__ __forceinline__ void phase_ssm2(const Frame& F, const Args& a) {
    unsigned char* ws = F.ws;
    const bf16_t* U = (const bf16_t*)(ws + WS_S + S_U16); bf16_t* Z = (bf16_t*)(ws + WS_S + S_Z16);
    const int lane = F.lane, w = F.wave, r16 = lane & 15, gq = lane >> 4;
    constexpr int UP = 528, HP = 272;
    LAS unsigned char* Us = F.lds;
    LAS unsigned char* Hs = F.lds + 128 * UP;
    LAS unsigned char* Fs = Hs + 128 * HP;
    u32x4 uv[8], fv[2];
#define SSM_FETCH(un_) do { const int b_ = (un_) / S5G, g_ = (un_) % S5G; \
        _Pragma("unroll") for (int it = 0; it < 8; ++it) { const int idx = it * 512 + F.tid, t = idx >> 1, hf = idx & 1; uv[it] = *(const u32x4*)(U + (size_t)(b_ * SEQ + t) * D + g_ * S5P + hf * 8); } \
        _Pragma("unroll") for (int it = 0; it < 2; ++it) { const int idx = it * 512 + F.tid; fv[it] = *((const u32x4*)(ws + WS_S5T + S5T_FD + (size_t)g_ * 16384) + idx); } } while (0)
    if (F.vcu < NB * S5G) SSM_FETCH(F.vcu);
    for (int unit = F.vcu; unit < NB * S5G; unit += F.G) {
        const int b = unit / S5G, g = unit % S5G;
        __syncthreads();
        { __builtin_amdgcn_sched_barrier(0);
#pragma unroll
          for (int it = 0; it < 8; ++it) { const int idx = it * 512 + F.tid, t = idx >> 1, hf = idx & 1; *(LAS u32x4*)(Us + (t >> 4) * UP + (t & 15) * 32 + hf * 16) = uv[it]; }
#pragma unroll
          for (int it = 0; it < 2; ++it) { const int idx = it * 512 + F.tid; *(LAS u32x4*)(Fs + idx * 16) = fv[it]; } }
        const bf16_t* WSg = (const bf16_t*)(ws + WS_S5T + S5T_WS) + (size_t)g * 128 * 256; const bf16_t* WYg = (const bf16_t*)(ws + WS_S5T + S5T_WY) + (size_t)g * 256 * 128;
        bf16x8 wa[8];
#pragma unroll
        for (int ks = 0; ks < 8; ++ks) wa[ks] = *(const bf16x8*)(WSg + (size_t)(16 * w + r16) * 256 + 32 * ks + 8 * gq);
        __syncthreads();
#pragma unroll 2
        for (int nt = 0; nt < 8; ++nt) {
            f32x4 acc = {0.f, 0.f, 0.f, 0.f}; bf16x8 ub8[8];
#pragma unroll
            for (int ks = 0; ks < 8; ++ks) ub8[ks] = *(const LAS bf16x8*)(Us + (nt * 16 + r16) * UP + (2 * ks + (gq >> 1)) * 32 + (gq & 1) * 16);
            __builtin_amdgcn_sched_barrier(0);
#pragma unroll
            for (int ks = 0; ks < 8; ++ks) acc = __builtin_amdgcn_mfma_f32_16x16x32_bf16(wa[ks], ub8[ks], acc, 0, 0, 0);
            __builtin_amdgcn_sched_barrier(0);
            u32x2 o; o.x = pk2(acc[0], acc[1]); o.y = pk2(acc[2], acc[3]);
            *(LAS u32x2*)(Hs + (nt * 16 + r16) * HP + (16 * w + 4 * gq) * 2) = o;
        }
        __syncthreads();
        const int t0 = w, t1 = 15 - w;
        bf16x8 wy0[4], wy1[4];
#pragma unroll
        for (int ks = 0; ks < 4; ++ks) { wy0[ks] = *(const bf16x8*)(WYg + (size_t)(t0 * 16 + r16) * 128 + 32 * ks + 8 * gq); wy1[ks] = *(const bf16x8*)(WYg + (size_t)(t1 * 16 + r16) * 128 + 32 * ks + 8 * gq); }
        __builtin_amdgcn_sched_barrier(0);
        if (w == 0) {
            const f32x2 a16 = ((const f32x2*)(ws + WS_S5T + S5T_A16))[g * 64 + lane];
            float hr = 0.f, hi = 0.f;
#pragma unroll 1
            for (int c0 = 0; c0 < 128; c0 += 32) {
                unsigned sv[32];
#pragma unroll
                for (int c = 0; c < 32; ++c) sv[c] = *(const LAS unsigned*)(Hs + (c0 + c) * HP + lane * 4);
#pragma unroll
                for (int c = 0; c < 32; ++c) { const unsigned hp = pk2(hr, hi); const float sr = bflo(sv[c]), si = bfhi(sv[c]);
                    const float nr = a16.x * hr - a16.y * hi + sr, ni = a16.x * hi + a16.y * hr + si; hr = nr; hi = ni; sv[c] = hp; }
#pragma unroll
                for (int c = 0; c < 32; ++c) *(LAS unsigned*)(Hs + (c0 + c) * HP + lane * 4) = sv[c];
            }
        }
        __builtin_amdgcn_s_waitcnt(0x0F70);
        __builtin_amdgcn_sched_barrier(0);
        { const int un = unit + F.G < NB * S5G ? unit + F.G : unit; SSM_FETCH(un); }
        __builtin_amdgcn_sched_barrier(0);
        asm volatile("s_waitcnt lgkmcnt(0)" ::: "memory"); __builtin_amdgcn_s_barrier(); asm volatile("" ::: "memory");
        bf16x8 fa[4], fb[8];
#pragma unroll
        for (int sp = 0; sp < 4; ++sp) { const int da = t0 - 2 * sp; fa[sp] = *(const LAS bf16x8*)(Fs + (da > 0 ? da : 0) * 1024 + lane * 16); }
#pragma unroll
        for (int sp = 0; sp < 8; ++sp) { const int db = t1 - 2 * sp; fb[sp] = *(const LAS bf16x8*)(Fs + (db > 0 ? db : 0) * 1024 + lane * 16); }
#pragma unroll 1
        for (int nt = 0; nt < 8; ++nt) {
            f32x4 acc0 = {0.f, 0.f, 0.f, 0.f}, acc1 = {0.f, 0.f, 0.f, 0.f};
            bf16x8 ub8[8], hb4[4];
#pragma unroll
            for (int sp = 0; sp < 8; ++sp) ub8[sp] = *(const LAS bf16x8*)(Us + (nt * 16 + r16) * UP + (2 * sp + (gq >> 1)) * 32 + (gq & 1) * 16);
#pragma unroll
            for (int ks = 0; ks < 4; ++ks) hb4[ks] = *(const LAS bf16x8*)(Hs + (nt * 16 + r16) * HP + (32 * ks + 8 * gq) * 2);
            __builtin_amdgcn_sched_barrier(0);
#pragma unroll
            for (int ks = 0; ks < 4; ++ks) { acc0 = __builtin_amdgcn_mfma_f32_16x16x32_bf16(wy0[ks], hb4[ks], acc0, 0, 0, 0); acc1 = __builtin_amdgcn_mfma_f32_16x16x32_bf16(wy1[ks], hb4[ks], acc1, 0, 0, 0); }
#pragma unroll
            for (int sp = 0; sp < 4; ++sp) { if (2 * sp <= t0) acc0 = __builtin_amdgcn_mfma_f32_16x16x32_bf16(fa[sp], ub8[sp], acc0, 0, 0, 0); }
#pragma unroll
            for (int sp = 0; sp < 8; ++sp) { if (2 * sp <= t1) acc1 = __builtin_amdgcn_mfma_f32_16x16x32_bf16(fb[sp], ub8[sp], acc1, 0, 0, 0); }
            __builtin_amdgcn_sched_barrier(0);
            float z0[4], z1[4];
#pragma unroll
            for (int jj = 0; jj < 4; ++jj) { const float y0 = acc0[jj], y1 = acc1[jj];
                z0[jj] = y0 / (1.0f + __expf(-1.5957691216057308f * (y0 + 0.044715f * y0 * y0 * y0)));
                z1[jj] = y1 / (1.0f + __expf(-1.5957691216057308f * (y1 + 0.044715f * y1 * y1 * y1))); }
            const size_t rowb = (size_t)b * SEQ + 16 * (nt * 16 + r16);
            u32x2 o0, o1; o0.x = pk2(z0[0], z0[1]); o0.y = pk2(z0[2], z0[3]); o1.x = pk2(z1[0], z1[1]); o1.y = pk2(z1[2], z1[3]);
            *(u32x2*)(Z + (rowb + t0) * D + g * S5P + 4 * gq) = o0; *(u32x2*)(Z + (rowb + t1) * D + g * S5P + 4 * gq) = o1;
        }
    }
}

#undef SSM_FETCH
template <int MODE>
__device__ __forceinline__ void phase_ln(const Frame& F, const Args& a, int li, int m0, int mstep, int mend) {
    unsigned char* ws = F.ws;
    bf16_t* H16 = (bf16_t*)(ws + WS_H16);
    const float* gam = a.in[MODE == 0 ? I_LNM_G : I_LNF_G] + (size_t)li * D; const float* bet = a.in[MODE == 0 ? I_LNM_B : I_LNF_B] + (size_t)li * D;
    const bf16_t* Y0 = (const bf16_t*)(ws + WS_S + S_Y0); const bf16_t* Y1 = (const bf16_t*)(ws + WS_S + S_Y1);
    const int lane = F.lane;
    const bool last = (MODE == 1) && (li == DEPTH - 1);
    for (int m = m0; m < mend; m += mstep) {
        float v[4][8];
        const u32x4* xr = (const u32x4*)(H16 + (size_t)m * D) + lane;
#pragma unroll
        for (int q = 0; q < 4; ++q) { const u32x4 p = xr[64 * q]; v[q][0] = bflo(p.x); v[q][1] = bfhi(p.x); v[q][2] = bflo(p.y); v[q][3] = bfhi(p.y); v[q][4] = bflo(p.z); v[q][5] = bfhi(p.z); v[q][6] = bflo(p.w); v[q][7] = bfhi(p.w); }
        if (MODE == 1) {
            const u32x2* y0 = (const u32x2*)((const unsigned char*)Y0 + (size_t)m * D) + lane; const u32x2* y1 = (const u32x2*)((const unsigned char*)Y1 + (size_t)m * D) + lane;
            u32x2 pa[4], pb[4];
#pragma unroll
            for (int q = 0; q < 4; ++q) { pa[q] = y0[64 * q]; pb[q] = y1[64 * q]; }
            __builtin_amdgcn_sched_barrier(0);
#pragma unroll
            for (int q = 0; q < 4; ++q) {
                const f32x2 a0 = __builtin_amdgcn_cvt_pk_f32_fp8((int)pa[q].x, false), a1 = __builtin_amdgcn_cvt_pk_f32_fp8((int)pa[q].x, true), a2 = __builtin_amdgcn_cvt_pk_f32_fp8((int)pa[q].y, false), a3 = __builtin_amdgcn_cvt_pk_f32_fp8((int)pa[q].y, true);
                const f32x2 b0 = __builtin_amdgcn_cvt_pk_f32_fp8((int)pb[q].x, false), b1 = __builtin_amdgcn_cvt_pk_f32_fp8((int)pb[q].x, true), b2 = __builtin_amdgcn_cvt_pk_f32_fp8((int)pb[q].y, false), b3 = __builtin_amdgcn_cvt_pk_f32_fp8((int)pb[q].y, true);
                v[q][0] = v[q][0] * DN_ALPHA + (a0[0] + b0[0]) * 0.0625f; v[q][1] = v[q][1] * DN_ALPHA + (a0[1] + b0[1]) * 0.0625f;
                v[q][2] = v[q][2] * DN_ALPHA + (a1[0] + b1[0]) * 0.0625f; v[q][3] = v[q][3] * DN_ALPHA + (a1[1] + b1[1]) * 0.0625f;
                v[q][4] = v[q][4] * DN_ALPHA + (a2[0] + b2[0]) * 0.0625f; v[q][5] = v[q][5] * DN_ALPHA + (a2[1] + b2[1]) * 0.0625f;
                v[q][6] = v[q][6] * DN_ALPHA + (a3[0] + b3[0]) * 0.0625f; v[q][7] = v[q][7] * DN_ALPHA + (a3[1] + b3[1]) * 0.0625f; }
        }
        float s = 0.f;
#pragma unroll
        for (int q = 0; q < 4; ++q)
#pragma unroll
            for (int e = 0; e < 8; ++e) s += v[q][e];
        const float mean = wave_sum(s, lane) * (1.0f / D); float s2 = 0.f;
#pragma unroll
        for (int q = 0; q < 4; ++q)
#pragma unroll
            for (int e = 0; e < 8; ++e) { v[q][e] -= mean; s2 += v[q][e] * v[q][e]; }
        const float rstd = 1.0f / sqrtf(wave_sum(s2, lane) * (1.0f / D) + LN_EPS);
#pragma unroll
        for (int q = 0; q < 4; ++q) { const f32x4 g0 = *((const f32x4*)gam + 2 * (lane + 64 * q)), g1 = *((const f32x4*)gam + 2 * (lane + 64 * q) + 1), b0 = *((const f32x4*)bet + 2 * (lane + 64 * q)), b1 = *((const f32x4*)bet + 2 * (lane + 64 * q) + 1);
#pragma unroll
            for (int e = 0; e < 4; ++e) { v[q][e] = v[q][e] * rstd * g0[e] + b0[e]; v[q][4 + e] = v[q][4 + e] * rstd * g1[e] + b1[e]; } }
        if (last) {
            f32x4* o = (f32x4*)(a.out + (size_t)m * D) + 2 * lane;
#pragma unroll
            for (int q = 0; q < 4; ++q) { o[128 * q] = (f32x4){v[q][0], v[q][1], v[q][2], v[q][3]}; o[128 * q + 1] = (f32x4){v[q][4], v[q][5], v[q][6], v[q][7]}; }
        } else {
            u32x4* ob = (u32x4*)(H16 + (size_t)m * D) + lane;
#pragma unroll
            for (int q = 0; q < 4; ++q) { u32x4 w; w.x = pk2(v[q][0], v[q][1]); w.y = pk2(v[q][2], v[q][3]); w.z = pk2(v[q][4], v[q][5]); w.w = pk2(v[q][6], v[q][7]); ob[64 * q] = w;
 }
        }
    }
}

__device__ __forceinline__ void phase_router(const Frame& F, const Args& a, int li) {
    unsigned char* ws = F.ws;
    const bf16_t* XH = (const bf16_t*)(ws + WS_H16);
    const bf16_t* WH = (const bf16_t*)(ws + WS_RT);
    const int lane = F.lane, r16 = lane & 15, g = lane >> 4, wq = F.wave & 3, kh = F.wave >> 2;
    LAS float* lb = (LAS float*)(F.lds + F.wave * 4096);
    const LAS float* lbp = (const LAS float*)(F.lds + (F.wave ^ 4) * 4096);
    for (int t0 = 0; t0 < T / 16; t0 += F.G * 4) {
        { const int rb = (t0 + F.vcu * 4) * 16 + F.wave * 8; const int re = rb + 8 < T ? rb + 8 : T; phase_ln<0>(F, a, li, rb, 1, re); }
        asm volatile("s_waitcnt vmcnt(0)" ::: "memory"); __syncthreads();
        const int tile = t0 + F.vcu * 4 + wq; const bool act = tile < T / 16;
        f32x4 acc[3];
#pragma unroll
        for (int n = 0; n < 3; ++n) acc[n] = (f32x4){0.f, 0.f, 0.f, 0.f};
        if (act) {
            const bf16_t* xh = XH + ((size_t)tile * 16 + r16) * D + 8 * g + kh * (D / 2);
            const bf16_t* wh = WH + (size_t)r16 * D + 8 * g + kh * (D / 2);
            bf16x8 ah[2][4], bh[2][4][3];
#define RT_LOAD(buf, s0) do { _Pragma("unroll") for (int u_ = 0; u_ < 4; ++u_) { ah[buf][u_] = *(const bf16x8*)(xh + 32 * ((s0) + u_)); \
                _Pragma("unroll") for (int n_ = 0; n_ < 3; ++n_) bh[buf][u_][n_] = *(const bf16x8*)(wh + (size_t)(n_ * 16) * D + 32 * ((s0) + u_)); } } while (0)
#define RT_MMA(buf) do { _Pragma("unroll") for (int u_ = 0; u_ < 4; ++u_) _Pragma("unroll") for (int n_ = 0; n_ < 3; ++n_) acc[n_] = __builtin_amdgcn_mfma_f32_16x16x32_bf16(ah[buf][u_], bh[buf][u_][n_], acc[n_], 0, 0, 0); } while (0)
            RT_LOAD(0, 0);
#pragma unroll 1
            for (int s0 = 0; s0 < D / 64; s0 += 8) {
                __builtin_amdgcn_sched_barrier(0);
                RT_LOAD(1, s0 + 4);
                __builtin_amdgcn_sched_barrier(0);
                RT_MMA(0);
                __builtin_amdgcn_sched_barrier(0);
                if (s0 + 8 < D / 64) RT_LOAD(0, s0 + 8);
                __builtin_amdgcn_sched_barrier(0);
                RT_MMA(1);
            }
#undef RT_LOAD
#undef RT_MMA
        }
#pragma unroll
        for (int n = 0; n < 3; ++n)
#pragma unroll
            for (int j = 0; j < 4; ++j) lb[(4 * g + j) * 52 + n * 16 + r16] = acc[n][j];
        __syncthreads();
        LAS unsigned* bc = (LAS unsigned*)(F.lds + 8 * 4096);
        if (F.tid < 64) bc[F.tid] = 0u;
        __syncthreads();
        int e1 = 0, e2 = 0; float w1 = 0.f, w2 = 0.f; unsigned l1 = 0u, l2 = 0u; const bool dec = act && kh == 0 && lane < 16;
        if (dec) {
            const LAS float* L = lb + lane * 52; const LAS float* L2 = lbp + lane * 52;
            float lg[NG];
#pragma unroll
            for (int q = 0; q < NG; ++q) lg[q] = L[q] + L2[q] + a.in[I_M_BG][li * NG + q];
            int gi = 0; float gm = lg[0];
#pragma unroll
            for (int q = 1; q < NG; ++q) if (lg[q] > gm) { gm = lg[q]; gi = q; }
            float gs = 0.f;
#pragma unroll
            for (int q = 0; q < NG; ++q) gs += __expf(lg[q] - gm);
            const float gp = 1.0f / gs;
            float el[EPG];
#pragma unroll
            for (int i = 0; i < EPG; ++i) el[i] = L[NG + gi * EPG + i] + L2[NG + gi * EPG + i] + a.in[I_M_BE][li * NE + gi * EPG + i];
            int i1 = 0; float m1 = el[0];
#pragma unroll
            for (int i = 1; i < EPG; ++i) if (el[i] > m1) { m1 = el[i]; i1 = i; }
            int i2 = -1; float m2 = -3.0e38f; asm volatile("" : "+v"(m2));
#pragma unroll
            for (int i = 0; i < EPG; ++i) if (i != i1 && el[i] > m2) { m2 = el[i]; i2 = i; }
            w1 = gp / (1.0f + __expf(m2 - m1)); w2 = gp / (1.0f + __expf(m1 - m2));
            e1 = gi * EPG + i1; e2 = gi * EPG + i2;
            l1 = __hip_atomic_fetch_add(bc + e1, 1u, __ATOMIC_RELAXED, __HIP_MEMORY_SCOPE_WORKGROUP);
            l2 = __hip_atomic_fetch_add(bc + e2, 1u, __ATOMIC_RELAXED, __HIP_MEMORY_SCOPE_WORKGROUP);
        }
        __syncthreads();
        if (F.tid < NE) { const unsigned n = bc[F.tid]; bc[32 + F.tid] = n ? __hip_atomic_fetch_add(F.ctl + CW_CNT + (li * NE + F.tid) * 64, n, RLX_AGENT) : 0u; }
        __syncthreads();
        if (dec) {
            const int m = tile * 16 + lane;
            unsigned* LIST = (unsigned*)(ws + WS_LIST); float* GWL = (float*)(ws + WS_GWL);
            const unsigned s1 = bc[32 + e1] + l1, s2_ = bc[32 + e2] + l2;
            LIST[(size_t)e1 * T + s1] = (unsigned)m; GWL[(size_t)e1 * T + s1] = w1;
            LIST[(size_t)e2 * T + s2_] = (unsigned)m | 0x80000000u; GWL[(size_t)e2 * T + s2_] = w2;
        }
        __syncthreads();
    }
}

__device__ __forceinline__ void moe_table(const Frame& F, int li) {
    LAS int* tab = (LAS int*)(F.lds + MOETAB_OFF);
    __syncthreads();
    if (F.tid < 64) {
        const int e = F.lane; const int c = (e < NE) ? (int)__hip_atomic_load(F.ctl + CW_CNT + (li * NE + e) * 64, RLX_AGENT) : 0; const int nt = (c + 255) >> 8;
        int incl = nt;
#pragma unroll
        for (int o = 1; o < 32; o <<= 1) { const int v = __builtin_amdgcn_ds_bpermute(((e - o) & 63) << 2, incl); if (e >= o) incl += v; }
        const int excl = incl - nt;
        if (e < NE) { tab[1 + e] = excl * 256; tab[34 + e] = c;
#pragma nounroll
            for (int k = 0; k < nt; ++k) ((LAS unsigned char*)(tab + 66))[excl + k] = (unsigned char)e; }
        if (e == NE - 1) { tab[33] = incl * 256; tab[0] = incl; }
    }
    __syncthreads();
}
__device__ __forceinline__ void phase_rms(const Frame& F, const Args& a, int j) {
    unsigned char* ws = F.ws;
    const int lane = F.lane;
    for (int it0 = F.gw * 4; it0 < 2 * T; it0 += F.NGW * 4) {
        u32x4 w[4]; bf16_t* X[4]; const float* gn[4];
#pragma unroll
        for (int r = 0; r < 4; ++r) { const int it = it0 + r; const int which = it >= T, m = it - which * T;
            X[r] = (bf16_t*)(ws + (which ? WS_CKV : WS_CQ)) + (size_t)m * 512; gn[r] = a.in[which ? I_D_KVN : I_D_QN] + (size_t)j * 512;
            w[r] = *((const u32x4*)X[r] + lane); }
#pragma unroll
        for (int r = 0; r < 4; ++r) {
            float x[8] = {bflo(w[r].x), bfhi(w[r].x), bflo(w[r].y), bfhi(w[r].y), bflo(w[r].z), bfhi(w[r].z), bflo(w[r].w), bfhi(w[r].w)};
            float s = 0.f;
#pragma unroll
            for (int q = 0; q < 8; ++q) s += x[q] * x[q];
            const float rs = 1.0f / sqrtf(wave_sum(s, lane) * (1.0f / 512.0f) + RMS_EPS);
            const f32x4 g0 = *((const f32x4*)gn[r] + 2 * lane), g1 = *((const f32x4*)gn[r] + 2 * lane + 1);
            u32x4 o; o.x = pk2(x[0] * rs * g0[0], x[1] * rs * g0[1]); o.y = pk2(x[2] * rs * g0[2], x[3] * rs * g0[3]);
            o.z = pk2(x[4] * rs * g1[0], x[5] * rs * g1[1]); o.w = pk2(x[6] * rs * g1[2], x[7] * rs * g1[3]);
            *((u32x4*)X[r] + lane) = o;
        }
    }
}

__device__ __forceinline__ void phase_topk(const Frame& F, const Args& a) {
    unsigned char* ws = F.ws;
    const float* IDX = (const float*)(ws + WS_S + S_INDEX); unsigned short* SEL = (unsigned short*)(ws + WS_SEL);
    const int lane = F.lane;
    LAS unsigned* hist = (LAS unsigned*)(F.lds + F.wave * 2048);
    LAS unsigned short* sl = (LAS unsigned short*)(F.lds + F.wave * 2048 + 1024);
    for (int i0 = 0; i0 * F.NGW < T; ++i0) {
        const int m = i0 * F.NGW + (F.gw + i0 * 257) % F.NGW; if (m >= T) continue;
        const int t = m % SEQ; unsigned short* sel = SEL + (size_t)m * TOPK;
        if (t < TOPK) { for (int k = lane; k <= t; k += 64) sel[k] = (unsigned short)k; continue; }
        unsigned key[32];
        const float* row = IDX + (size_t)m * SEQ;
        const int nreg = t >> 6;
#pragma unroll
        for (int i = 0; i < 32; ++i) { const int s = i * 64 + lane; key[i] = (s <= t) ? __builtin_bit_cast(unsigned, row[s]) : 0x7fffffffu; }
        __builtin_amdgcn_sched_barrier(0);
#pragma unroll
        for (int i = 0; i < 32; ++i) { const unsigned u = key[i]; key[i] = (u == 0x7fffffffu) ? 0u : ((u & 0x80000000u) ? ~u : (u | 0x80000000u)); }
        unsigned prefix = 0u; int need = TOPK;
#pragma unroll 1
        for (int shift = 24; shift >= 0; shift -= 8) {
            { unsigned z_ = 0u; asm volatile("" : "+v"(z_)); *(LAS u32x4*)(hist + 4 * lane) = (u32x4){z_, z_, z_, z_}; }
            const unsigned himask = shift == 24 ? 0u : (0xffffffffu << (shift + 8));
#pragma unroll
            for (int q8 = 0; q8 < 4; ++q8) if (q8 * 8 <= nreg) {
#pragma unroll
              for (int i8 = 0; i8 < 8; ++i8) { const unsigned k_ = key[q8 * 8 + i8]; const bool c_ = ((k_ & himask) == prefix) && (k_ != 0u);
                __hip_atomic_fetch_add(hist + (c_ ? ((k_ >> shift) & 255u) : 384u + (unsigned)lane), 1u, __ATOMIC_RELAXED, __HIP_MEMORY_SCOPE_WORKGROUP); } }
            LDS_WAIT(); asm volatile("" ::: "memory");
            const u32x4 h4 = *(const LAS u32x4*)(hist + 4 * lane);
            const int sl = (int)(h4.x + h4.y + h4.z + h4.w);
            int S = sl;
            S += __builtin_amdgcn_update_dpp(0, S, 0x101, 0xf, 0xf, true);
            S += __builtin_amdgcn_update_dpp(0, S, 0x102, 0xf, 0xf, true);
            S += __builtin_amdgcn_update_dpp(0, S, 0x104, 0xf, 0xf, true);
            S += __builtin_amdgcn_update_dpp(0, S, 0x108, 0xf, 0xf, true);
            { const int r1 = __builtin_amdgcn_readlane(S, 16), r2 = __builtin_amdgcn_readlane(S, 32), r3 = __builtin_amdgcn_readlane(S, 48);
              S += (lane < 16 ? r1 : 0) + (lane < 32 ? r2 : 0) + (lane < 48 ? r3 : 0); }
            const unsigned long long mk = __ballot(S >= need);
            const int Ls = 63 - __builtin_clzll(mk);
            const int above = S - sl;
            int bsel = 0, cab = above;
            { const int c3 = above + (int)h4.w, c2 = c3 + (int)h4.z, c1 = c2 + (int)h4.y;
              if (c3 >= need) { bsel = 3; cab = above; } else if (c2 >= need) { bsel = 2; cab = c3; } else if (c1 >= need) { bsel = 1; cab = c2; } else { bsel = 0; cab = c1; } }
            const int Bs = __builtin_amdgcn_readlane(bsel, Ls), Ca = __builtin_amdgcn_readlane(cab, Ls);
            const int hsel = bsel == 3 ? (int)h4.w : (bsel == 2 ? (int)h4.z : (bsel == 1 ? (int)h4.y : (int)h4.x));
            const int Hb = __builtin_amdgcn_readlane(hsel, Ls);
            prefix |= (unsigned)(4 * Ls + Bs) << shift; need -= Ca;
            LDS_WAIT(); asm volatile("" ::: "memory");
            if (shift > 0 && Hb == need && prefix != 0u) { prefix -= 1u; need = 0; break; }
        }
        const unsigned thr = prefix;
        int base = 0;
        const unsigned long long lt = (1ull << lane) - 1ull;
#pragma unroll
        for (int i = 0; i < 32; ++i) if (i <= nreg) { const bool p = key[i] > thr; const unsigned long long mk = __ballot(p);
            if (p) sl[base + __popcll(mk & lt)] = (unsigned short)(i * 64 + lane);
            base += __popcll(mk); }
        int taken = 0;
        if (need > 0) {
#pragma unroll
        for (int i = 0; i < 32; ++i) if (i <= nreg) { const bool p = key[i] == thr; const unsigned long long mk = __ballot(p);
            const int pos = taken + __popcll(mk & lt);
            if (p && pos < need) sl[base + pos] = (unsigned short)(i * 64 + lane);
            taken += __popcll(mk); }
        }
        LDS_WAIT(); asm volatile("" ::: "memory");
        if (lane < 32) *((u32x4*)sel + lane) = *((const LAS u32x4*)sl + lane);
        LDS_WAIT(); asm volatile("" ::: "memory");
    }
}

__device__ __forceinline__ int rel_bucket(int n) {
    if (n < 16) return n;
    int b = 16;
    b += (n >= 19); b += (n >= 21); b += (n >= 24); b += (n >= 27); b += (n >= 31); b += (n >= 35); b += (n >= 40); b += (n >= 46);
    b += (n >= 52); b += (n >= 59); b += (n >= 67); b += (n >= 77); b += (n >= 87); b += (n >= 99); b += (n >= 113);
    return b;
}

typedef short s16x4 __attribute__((ext_vector_type(4)));
typedef unsigned short u16x4 __attribute__((ext_vector_type(4)));

__device__ __forceinline__ void phase_indexer2(const Frame& F, const Args& a) {
    unsigned char* ws = F.ws;
    const bf16_t* QI = (const bf16_t*)(ws + WS_S + S_QIDX); const bf16_t* KI = (const bf16_t*)(ws + WS_KIDX); const float* WI = (const float*)(ws + WS_WIDX);
    float* IDX = (float*)(ws + WS_S + S_INDEX);
    const int lane = F.lane, w = F.wave, r16 = lane & 15, g = lane >> 4;
    const float idx_scale = 0.08838834764831845f;
    const int nunits = NB * (SEQ / 16);
    for (int i = 0; i * F.G + F.vcu < nunits; ++i) {
        const int u = i * F.G + F.vcu; const int b = u / (SEQ / 16); int tq = u % (SEQ / 16); if (i & 1) tq = (SEQ / 16 - 1) - tq;
        const size_t row0 = (size_t)b * SEQ + tq * 16;
        __syncthreads();
        { bf16x8 qv[8];
#pragma unroll
          for (int k = 0; k < 8; ++k) { const int f = w * 8 + k, h = f >> 2, ks = f & 3; qv[k] = *(const bf16x8*)(QI + (row0 + r16) * 2048 + h * 128 + 32 * ks + 8 * g); }
          __builtin_amdgcn_sched_barrier(0);
#pragma unroll
          for (int k = 0; k < 8; ++k) *(LAS bf16x8*)(F.lds + (w * 8 + k) * 1024 + lane * 16) = qv[k]; }
        float wq[16];
#pragma unroll
        for (int h4 = 0; h4 < 4; ++h4) { const f32x4 t4 = *(const f32x4*)(WI + (row0 + r16) * 16 + h4 * 4); wq[h4 * 4] = t4[0]; wq[h4 * 4 + 1] = t4[1]; wq[h4 * 4 + 2] = t4[2]; wq[h4 * 4 + 3] = t4[3]; }
        __syncthreads();
        const int npair = (tq >> 1) + 1;
        for (int kp = w; kp < npair; kp += 8) {
            bf16x8 ka[2][4];
#pragma unroll
            for (int t2 = 0; t2 < 2; ++t2)
#pragma unroll
                for (int ks = 0; ks < 4; ++ks) ka[t2][ks] = *(const bf16x8*)(KI + ((size_t)b * SEQ + kp * 32 + t2 * 16 + r16) * 128 + 32 * ks + 8 * g);
            f32x4 acc0 = {0.f, 0.f, 0.f, 0.f}, acc1 = {0.f, 0.f, 0.f, 0.f};
            bf16x8 qb[2][4];
#pragma unroll
            for (int ks = 0; ks < 4; ++ks) qb[0][ks] = *(const LAS bf16x8*)(F.lds + ks * 1024 + lane * 16);
#pragma unroll
            for (int h = 0; h < 16; ++h) {
                __builtin_amdgcn_sched_barrier(0);
                if (h + 1 < 16) {
#pragma unroll
                    for (int ks = 0; ks < 4; ++ks) qb[(h + 1) & 1][ks] = *(const LAS bf16x8*)(F.lds + ((h + 1) * 4 + ks) * 1024 + lane * 16); }
                __builtin_amdgcn_sched_barrier(0);
                f32x4 c0 = {0.f, 0.f, 0.f, 0.f}, c1 = {0.f, 0.f, 0.f, 0.f};
#pragma unroll
                for (int ks = 0; ks < 4; ++ks) { c0 = __builtin_amdgcn_mfma_f32_16x16x32_bf16(ka[0][ks], qb[h & 1][ks], c0, 0, 0, 0); c1 = __builtin_amdgcn_mfma_f32_16x16x32_bf16(ka[1][ks], qb[h & 1][ks], c1, 0, 0, 0); }
                const float wh = wq[h];
#pragma unroll
                for (int j = 0; j < 4; ++j) { acc0[j] += wh * fmaxf(c0[j], 0.f); acc1[j] += wh * fmaxf(c1[j], 0.f); }
            }
            float* op = IDX + (row0 + r16) * SEQ + kp * 32 + 4 * g;
            *(f32x4*)op = acc0 * idx_scale; *(f32x4*)(op + 16) = acc1 * idx_scale;
        }
    }
}


typedef short bf16x4 __attribute__((ext_vector_type(4)));
__device__ __forceinline__ void phase_attn5(const Frame& F, const Args& a, int j) {
    unsigned char* ws = F.ws;
    const bf16_t* QLT = (const bf16_t*)(ws + WS_S + S_QLAT); const bf16_t* KV = (const bf16_t*)(ws + WS_CKV);
    const unsigned short* SEL = (const unsigned short*)(ws + WS_SEL); bf16_t* OL = (bf16_t*)(ws + WS_S + S_OLAT);
    const float* RB = a.in[I_RELB];
    const int lane = F.lane, w = F.wave;
    constexpr int KROW = 1056, WBUF = 16 * KROW;
    LAS unsigned char* const L0 = F.lds;
    LAS unsigned char* const kvs = L0 + w * WBUF;
    LAS float* const rbs = (LAS float*)(L0 + 8 * WBUF);
    LAS unsigned char* const btab = (LAS unsigned char*)(rbs + 512);
    LAS float* const bmax = (LAS float*)(btab + 2048);
    LAS float* const gmx = bmax + 16;
    const float att_scale = 0.08838834764831845f;
    __syncthreads();
    rbs[F.tid] = RB[F.tid];
#pragma unroll
    for (int q = 0; q < 4; ++q) btab[F.tid * 4 + q] = (unsigned char)rel_bucket(F.tid * 4 + q);
    { const float gv = wave_max(fabsf(a.in[I_D_KVN][(size_t)j * KVL + F.tid]), lane); if (lane == 0) gmx[w] = gv; }
    __syncthreads();
    if (F.tid < 16) { float mx = rbs[F.tid];
#pragma unroll
        for (int bk = 1; bk < 32; ++bk) mx = fmaxf(mx, rbs[bk * 16 + F.tid]);
        bmax[F.tid] = mx; }
    __syncthreads();
    const bool affine = (F.G % 8 == 0) && (SEQ % (F.G / 8) == 0);
    const int per = affine ? F.G / 8 : 1;
    const int nit = affine ? SEQ / per : (T - F.vcu + F.G - 1) / F.G;
#pragma unroll 1
    for (int it = w; it < nit; it += 8) {
        int ln_ = lane; asm volatile("" : "+v"(ln_));
        const int r16 = ln_ & 15, gq = ln_ >> 4;
        const unsigned alo = (unsigned)(size_t)(kvs + (4 * gq + (r16 >> 2)) * KROW + (4 * (ln_ & 3)) * 2);
        const int m = affine ? (F.vcu / per) * SEQ + (F.vcu % per) + per * it : F.vcu + it * F.G;
        const int t = m & (SEQ - 1), nk = t + 1 < TOPK ? t + 1 : TOPK, nch = (nk + 15) >> 4;
        const char* kvb = (const char*)KV + (size_t)(m / SEQ) * SEQ * (KVL * 2);
        const unsigned short* sel = SEL + (size_t)m * TOPK;
        bf16x8 qf[16]; float ss = 0.f;
#pragma unroll
        for (int hq = 0; hq < 2; ++hq) { u32x2 q8[8];
#pragma unroll
          for (int s = 0; s < 8; ++s) q8[s] = *(const u32x2*)((const unsigned char*)QLT + ((size_t)m * NH + r16) * KVL + 32 * (8 * hq + s) + 8 * gq);
          __builtin_amdgcn_sched_barrier(0);
#pragma unroll
          for (int s = 0; s < 8; ++s) { const f32x2 a0 = __builtin_amdgcn_cvt_pk_f32_fp8((int)q8[s].x, false), a1 = __builtin_amdgcn_cvt_pk_f32_fp8((int)q8[s].x, true), a2 = __builtin_amdgcn_cvt_pk_f32_fp8((int)q8[s].y, false), a3 = __builtin_amdgcn_cvt_pk_f32_fp8((int)q8[s].y, true);
              ss += (a0[0] * a0[0] + a0[1] * a0[1]) + (a1[0] * a1[0] + a1[1] * a1[1]) + (a2[0] * a2[0] + a2[1] * a2[1]) + (a3[0] * a3[0] + a3[1] * a3[1]);
              u32x4 pk; pk.x = pk2(a0[0], a0[1]); pk.y = pk2(a1[0], a1[1]); pk.z = pk2(a2[0], a2[1]); pk.w = pk2(a3[0], a3[1]); qf[8 * hq + s] = __builtin_bit_cast(bf16x8, pk); }
          __builtin_amdgcn_sched_barrier(0); }
        ss *= (1.0f / 256.0f);
        ss += shx(ss, 16, lane); ss += shx(ss, 32, lane);
        float kvn = gmx[0];
#pragma unroll
        for (int q = 1; q < 8; ++q) kvn = fmaxf(kvn, gmx[q]);
        kvn *= 22.62741699796952f * 1.01f;
        const float Mref = fminf(sqrtf(ss) * kvn * att_scale, 60.0f) + bmax[r16];
        f32x4 oacc[32];
#pragma unroll
        for (int dt = 0; dt < 32; ++dt) oacc[dt] = (f32x4){0.f, 0.f, 0.f, 0.f};
        float Lw = 0.f;
        int selv = (r16 < nk) ? (int)sel[r16] : 0;
        u16x4 s4 = *(const u16x4*)(sel + 4 * gq);
#pragma unroll 1
        for (int c = 0; c < nch; ++c) {
            const int kn = (c + 1) * 16 + r16; int selvn = 0; u16x4 s4n = s4;
            if (c + 1 < nch) { selvn = (kn < nk) ? (int)sel[kn] : 0; s4n = *(const u16x4*)(sel + (c + 1) * 16 + 4 * gq); }
#pragma unroll
            for (int i = 0; i < 16; ++i) { const unsigned off = ((unsigned)__builtin_amdgcn_readlane(selv, i) << 10) + (unsigned)lane * 16u;
                __builtin_amdgcn_global_load_lds((const unsigned*)(kvb + off), (LAS unsigned*)(kvs + i * KROW), 16, 0, 0); }
            asm volatile("s_waitcnt vmcnt(0)" ::: "memory");
            f32x4 st0 = {0.f, 0.f, 0.f, 0.f}, st1 = {0.f, 0.f, 0.f, 0.f};
#pragma unroll
            for (int sg = 0; sg < 4; ++sg) { bf16x8 a4[4];
#pragma unroll
                for (int u = 0; u < 4; ++u) a4[u] = *(const LAS bf16x8*)(kvs + r16 * KROW + 64 * (4 * sg + u) + 16 * gq);
                __builtin_amdgcn_sched_barrier(0);
                st0 = __builtin_amdgcn_mfma_f32_16x16x32_bf16(a4[0], qf[4 * sg], st0, 0, 0, 0); st1 = __builtin_amdgcn_mfma_f32_16x16x32_bf16(a4[1], qf[4 * sg + 1], st1, 0, 0, 0);
                st0 = __builtin_amdgcn_mfma_f32_16x16x32_bf16(a4[2], qf[4 * sg + 2], st0, 0, 0, 0); st1 = __builtin_amdgcn_mfma_f32_16x16x32_bf16(a4[3], qf[4 * sg + 3], st1, 0, 0, 0);
                __builtin_amdgcn_sched_barrier(0); }
            const f32x4 st = st0 + st1;
            float p[4]; bool vv[4]; int bk[4]; float bb[4];
#pragma unroll
            for (int e = 0; e < 4; ++e) { vv[e] = (c * 16 + 4 * gq + e) < nk; const int d = vv[e] ? t - (int)s4[e] : 0; bk[e] = (int)btab[d]; }
            __builtin_amdgcn_sched_barrier(0);
#pragma unroll
            for (int e = 0; e < 4; ++e) bb[e] = rbs[bk[e] * NH + r16];
            __builtin_amdgcn_sched_barrier(0);
#pragma unroll
            for (int e = 0; e < 4; ++e) { const float pe = __expf(st[e] * (att_scale * 0.0625f) + bb[e] - Mref); p[e] = vv[e] ? pe : 0.f; }
            Lw += (p[0] + p[1]) + (p[2] + p[3]);
            u32x2 pw; pw.x = pk2(p[0], p[1]); pw.y = pk2(p[2], p[3]);
            const bf16x4 pf = __builtin_bit_cast(bf16x4, pw);
#pragma unroll
            for (int q8 = 0; q8 < 4; ++q8) {
                bf16x4 ka[8];
                if (q8 == 0) asm volatile("ds_read_b64_tr_b16 %0, %8\n\tds_read_b64_tr_b16 %1, %8 offset:32\n\tds_read_b64_tr_b16 %2, %8 offset:64\n\tds_read_b64_tr_b16 %3, %8 offset:96\n\tds_read_b64_tr_b16 %4, %8 offset:128\n\tds_read_b64_tr_b16 %5, %8 offset:160\n\tds_read_b64_tr_b16 %6, %8 offset:192\n\tds_read_b64_tr_b16 %7, %8 offset:224\n\ts_waitcnt lgkmcnt(0)"
                    : "=&v"(ka[0]), "=&v"(ka[1]), "=&v"(ka[2]), "=&v"(ka[3]), "=&v"(ka[4]), "=&v"(ka[5]), "=&v"(ka[6]), "=&v"(ka[7]) : "v"(alo) : "memory");
                if (q8 == 1) asm volatile("ds_read_b64_tr_b16 %0, %8 offset:256\n\tds_read_b64_tr_b16 %1, %8 offset:288\n\tds_read_b64_tr_b16 %2, %8 offset:320\n\tds_read_b64_tr_b16 %3, %8 offset:352\n\tds_read_b64_tr_b16 %4, %8 offset:384\n\tds_read_b64_tr_b16 %5, %8 offset:416\n\tds_read_b64_tr_b16 %6, %8 offset:448\n\tds_read_b64_tr_b16 %7, %8 offset:480\n\ts_waitcnt lgkmcnt(0)"
                    : "=&v"(ka[0]), "=&v"(ka[1]), "=&v"(ka[2]), "=&v"(ka[3]), "=&v"(ka[4]), "=&v"(ka[5]), "=&v"(ka[6]), "=&v"(ka[7]) : "v"(alo) : "memory");
                if (q8 == 2) asm volatile("ds_read_b64_tr_b16 %0, %8 offset:512\n\tds_read_b64_tr_b16 %1, %8 offset:544\n\tds_read_b64_tr_b16 %2, %8 offset:576\n\tds_read_b64_tr_b16 %3, %8 offset:608\n\tds_read_b64_tr_b16 %4, %8 offset:640\n\tds_read_b64_tr_b16 %5, %8 offset:672\n\tds_read_b64_tr_b16 %6, %8 offset:704\n\tds_read_b64_tr_b16 %7, %8 offset:736\n\ts_waitcnt lgkmcnt(0)"
                    : "=&v"(ka[0]), "=&v"(ka[1]), "=&v"(ka[2]), "=&v"(ka[3]), "=&v"(ka[4]), "=&v"(ka[5]), "=&v"(ka[6]), "=&v"(ka[7]) : "v"(alo) : "memory");
                if (q8 == 3) asm volatile("ds_read_b64_tr_b16 %0, %8 offset:768\n\tds_read_b64_tr_b16 %1, %8 offset:800\n\tds_read_b64_tr_b16 %2, %8 offset:832\n\tds_read_b64_tr_b16 %3, %8 offset:864\n\tds_read_b64_tr_b16 %4, %8 offset:896\n\tds_read_b64_tr_b16 %5, %8 offset:928\n\tds_read_b64_tr_b16 %6, %8 offset:960\n\tds_read_b64_tr_b16 %7, %8 offset:992\n\ts_waitcnt lgkmcnt(0)"
                    : "=&v"(ka[0]), "=&v"(ka[1]), "=&v"(ka[2]), "=&v"(ka[3]), "=&v"(ka[4]), "=&v"(ka[5]), "=&v"(ka[6]), "=&v"(ka[7]) : "v"(alo) : "memory");
#pragma unroll
                for (int e = 0; e < 8; ++e) oacc[q8 * 8 + e] = __builtin_amdgcn_mfma_f32_16x16x16bf16_1k(ka[e], pf, oacc[q8 * 8 + e], 0, 0, 0);
            }
            selv = selvn; s4 = s4n;
        }
        Lw += shx(Lw, 16, lane); Lw += shx(Lw, 32, lane);
        const float inv = 1.0f / Lw;
        int m2_ = m; asm volatile("" : "+s"(m2_));
        bf16_t* op = OL + (size_t)m2_ * (NH * KVL) + r16 * KVL + 4 * gq;
#pragma unroll
        for (int dt = 0; dt < 32; ++dt) { u32x2 o; o.x = pk2(oacc[dt][0] * inv, oacc[dt][1] * inv); o.y = pk2(oacc[dt][2] * inv, oacc[dt][3] * inv); *(u32x2*)(op + 16 * dt) = o; }
    }
    __syncthreads();
}

constexpr int NWAVES = 8;
constexpr int PH_PER_LAYER = 16, N_PHASES = DEPTH * PH_PER_LAYER;
__global__ void __launch_bounds__(NWAVES * 64, 2) fwd(Args args) {
    extern __shared__ __attribute__((aligned(16))) unsigned char lds[];
    Frame F;
    F.lds = (LAS unsigned char*)lds;
    F.MISC = (volatile LAS unsigned*)(F.lds + MISC_OFF);
    F.tid = threadIdx.x; F.lane = F.tid & 63; F.wave = __builtin_amdgcn_readfirstlane(F.tid >> 6);
    F.G = gridDim.x; { const int bx = blockIdx.x; F.vcu = (F.G % 8 == 0) ? (bx % 8) * (F.G / 8) + bx / 8 : bx; }
    F.gw = F.vcu * NWAVES + F.wave; F.NGW = F.G * NWAVES;
    F.ctl = (gu32*)(args.ws + WS_CTL); F.ws = args.ws;
    for (int u = F.tid; u < (LDS_BYTES - LDSCTL_OFF) / 4; u += NWAVES * 64) ((LAS unsigned*)(F.lds + LDSCTL_OFF))[u] = 0u;
    __syncthreads();
    const int lo = args.ph_lo, hi = args.ph_hi;
    const bool single = (hi - lo) > 1;
    XcdBarrier bar; bar.bar = (unsigned*)(F.ctl + CW_BAR); bar.x = 0; bar.st = nullptr;
    if (single) bar = xcd_barrier_post((unsigned*)(F.ctl + CW_BAR), F.MISC + 8, F.tid);
#define IN(k) (lo <= (k) && (k) < hi)
#define SEAM() do { if (single) { int l2_; asm volatile("v_mbcnt_lo_u32_b32 %0, -1, 0\n\tv_mbcnt_hi_u32_b32 %0, -1, %0" : "=v"(l2_)); xcd_barrier(bar, (F.wave == 0 && l2_ == 0) ? 0 : 1); } } while (0)
    const int c = (int)blockIdx.x;
    const auto kargs = __builtin_amdgcn_kernarg_segment_ptr();
    const int wave0 = __builtin_amdgcn_readfirstlane((int)(threadIdx.x >> 6));
    static_assert(offsetof(Args, ws) == 0x108, "PHB reloads ws from kernarg offset 0x108");
#define PHB() unsigned char* ws; { unsigned long long w_; asm volatile("s_load_dwordx2 %0, %1, 0x108\n\ts_waitcnt lgkmcnt(0)" : "=s"(w_) : "s"(kargs) : "memory"); ws = (unsigned char*)(GAS unsigned char*)w_;     \
        int ln_; asm volatile("v_mbcnt_lo_u32_b32 %0, -1, 0\n\tv_mbcnt_hi_u32_b32 %0, -1, %0" : "=v"(ln_)); \
        int wv_ = __builtin_amdgcn_readfirstlane(wave0); asm volatile("" : "+s"(wv_)); \
        F.tid = wv_ * 64 + ln_; F.lane = ln_; F.wave = wv_; F.gw = F.vcu * NWAVES + wv_; F.ws = ws; F.ctl = (gu32*)ws; }
#define TP_BEG(id) do { } while (0)
#define TP_END() do { } while (0)
    for (int li = -1; li < DEPTH; ++li) {
        const int pb = li * PH_PER_LAYER, j = li >> 1;
        if (li >= 0) {
        if ((li & 1) == 0) {
            if (PON(1) && IN(pb + 1)) for (int rp_ = 0; rp_ < 1 + (int)PREP(1); ++rp_) { TP_BEG(1); PHB();
                pg8::Gemm g{(const bf16_t*)(ws + WS_H16), (const bf16_t*)(ws + WS_WMIX + WM_S5_IN), D, D, D, 0, 0}; pg8::SchedGrid S{T / 256, D / 256, 1, F.G, c};
                pg8::EpiStoreBf16 E{(bf16_t*)(ws + WS_S + S_U16), D, 0, 0, 0};
                pg8::gemm_phase(F.lds, g, S, E, F.wave, F.lane); SEAM(); TP_END(); }
            if (PON(2) && IN(pb + 2)) for (int rp_ = 0; rp_ < 1 + (int)PREP(2); ++rp_) { TP_BEG(2); PHB(); phase_ssm2(F, args); SEAM(); TP_END(); }
            if (PON(3) && IN(pb + 3)) for (int rp_ = 0; rp_ < 1 + (int)PREP(3); ++rp_) { TP_BEG(3); PHB();
                pg8::Gemm g{(const bf16_t*)(ws + WS_S + S_Z16), (const bf16_t*)(ws + WS_WMIX + WM_S5_GLU), D, D, D, 0, 0}; pg8::SchedGrid S{T / 256, D / 256, 1, F.G, c};
                pg8::EpiGlu E{(const bf16_t*)(ws + WS_S + S_Z16), (bf16_t*)(ws + WS_S + S_ZZ16), D};
                pg8::gemm_phase(F.lds, g, S, E, F.wave, F.lane); SEAM(); TP_END(); }
            if (PON(4) && IN(pb + 4)) for (int rp_ = 0; rp_ < 1 + (int)PREP(4); ++rp_) { TP_BEG(4); PHB();
                pg8::Gemm g{(const bf16_t*)(ws + WS_S + S_ZZ16), (const bf16_t*)(ws + WS_WMIX + WM_S5_OUT), D, D, D, 0, 0}; pg8::SchedGrid S{T / 256, D / 256, 1, F.G, c};
                pg8::EpiResid E{(bf16_t*)(ws + WS_H16), D, DN_ALPHA};
                pg8::gemm_phase(F.lds, g, S, E, F.wave, F.lane); SEAM(); TP_END(); }
        } else {
            if (PON(17) && IN(pb + 1)) for (int rp_ = 0; rp_ < 1 + (int)PREP(17); ++rp_) { TP_BEG(17); PHB();
                pg8::Gemm g{(const bf16_t*)(ws + WS_H16), (const bf16_t*)(ws + WS_WMIX + WM_D_IN), D, D, D, 0, 0}; pg8::SchedGrid S{T / 256, 4, 1, F.G, c};
                pg8::EpiDsaIn E{(bf16_t*)(ws + WS_CQ), (bf16_t*)(ws + WS_CKV), (bf16_t*)(ws + WS_KIDX), (float*)(ws + WS_WIDX), 0};
                pg8::gemm_phase(F.lds, g, S, E, F.wave, F.lane);
                SEAM(); TP_END(); }
            if (PON(18) && IN(pb + 2)) for (int rp_ = 0; rp_ < 1 + (int)PREP(18); ++rp_) { TP_BEG(18); PHB(); phase_rms(F, args, j); SEAM(); TP_END(); }
            if (PON(19) && IN(pb + 3)) for (int rp_ = 0; rp_ < 1 + (int)PREP(19); ++rp_) { TP_BEG(19); PHB();
                { const int ntail = T / 256;
                  pg8::Gemm g{(const bf16_t*)(ws + WS_H16), (const bf16_t*)(ws + WS_WMIX + WM_D_IN) + (size_t)4 * 256 * D, D, D, D, 0, 0}; pg8::SchedGrid S{ntail, 1, 1, F.G, c};
                  pg8::EpiDsaIn E{(bf16_t*)(ws + WS_CQ), (bf16_t*)(ws + WS_CKV), (bf16_t*)(ws + WS_KIDX), (float*)(ws + WS_WIDX), 4};
                  pg8::gemm_phase(F.lds, g, S, E, F.wave, F.lane); }
                pg8::Gemm g{(const bf16_t*)(ws + WS_CQ), (const bf16_t*)(ws + WS_WMIX + WM_D_Q), QL, QL, QL, 0, 0};
                pg8::SchedGridSplit S{pg8::SchedGrid{T / 256, 4096 / 256, 1, F.G, c}, (T / 256 < F.G) ? T / 256 : 0, 4};
                pg8::EpiStoreBf16 E{(bf16_t*)(ws + WS_S + S_Q16), 2048, 0, 2048, (size_t)(S_QIDX - S_Q16) / 2};
                pg8::gemm_phase(F.lds, g, S, E, F.wave, F.lane); SEAM(); TP_END(); }
            if (PON(20) && IN(pb + 4)) for (int rp_ = 0; rp_ < 1 + (int)PREP(20); ++rp_) { TP_BEG(20); PHB();
                pg8::Gemm g{(const bf16_t*)(ws + WS_S + S_Q16), (const bf16_t*)(ws + WS_WMIX + WM_D_UK), 2048, 128, 128, 128, 512 * 128}; pg8::SchedGrid S{T / 256, 512 / 256, 16, F.G, c};
                pg8::EpiStoreFp8 E{(unsigned char*)(ws + WS_S + S_QLAT), NH * KVL, 512};
                pg8::gemm_phase(F.lds, g, S, E, F.wave, F.lane); TP_END(); }
            if (PON(21) && IN(pb + 5)) for (int rp_ = 0; rp_ < 1 + (int)PREP(21); ++rp_) { TP_BEG(21); PHB(); phase_indexer2(F, args); SEAM(); TP_END(); }
            if (PON(22) && IN(pb + 6)) for (int rp_ = 0; rp_ < 1 + (int)PREP(22); ++rp_) { TP_BEG(22); PHB(); phase_topk(F, args); SEAM(); TP_END(); }
            if (PON(23) && IN(pb + 7)) for (int rp_ = 0; rp_ < 1 + (int)PREP(23); ++rp_) { TP_BEG(23); PHB(); phase_attn5(F, args, j); SEAM(); TP_END(); }
            if (PON(24) && IN(pb + 8)) for (int rp_ = 0; rp_ < 1 + (int)PREP(24); ++rp_) { TP_BEG(24); PHB();
                pg8::Gemm g{(const bf16_t*)(ws + WS_S + S_OLAT), (const bf16_t*)(ws + WS_WMIX + WM_D_UV), NH * KVL, 1024, 1024, 1024, 256 * 1024}; pg8::SchedGrid S{T / 256, 1, 8, F.G, c};
                pg8::EpiStoreBf16 E{(bf16_t*)(ws + WS_S + S_O16), D, 256, 0, 0};
                pg8::gemm_phase(F.lds, g, S, E, F.wave, F.lane); SEAM(); TP_END(); }
            if (PON(25) && IN(pb + 9)) for (int rp_ = 0; rp_ < 1 + (int)PREP(25); ++rp_) { TP_BEG(25); PHB();
                pg8::Gemm g{(const bf16_t*)(ws + WS_S + S_O16), (const bf16_t*)(ws + WS_WMIX + WM_D_OUT), D, D, D, 0, 0}; pg8::SchedGrid S{T / 256, D / 256, 1, F.G, c};
                pg8::EpiResid E{(bf16_t*)(ws + WS_H16), D, DN_ALPHA};
                pg8::gemm_phase(F.lds, g, S, E, F.wave, F.lane); SEAM(); TP_END(); }
        }
        if (PON(15) && IN(pb + 15)) for (int rp_ = 0; rp_ < 1 + (int)PREP(15); ++rp_) { TP_BEG(15); PHB(); phase_router(F, args, li); SEAM(); TP_END(); }
        if (PON(12) && IN(pb + 12)) for (int rp_ = 0; rp_ < 1 + (int)PREP(12); ++rp_) { TP_BEG(12); PHB();
            moe_table(F, li);
            const LAS int* tab = (const LAS int*)(F.lds + MOETAB_OFF);
            unsigned* dep = (unsigned*)(F.ctl + CW_DEP + li * 192 * 16);
            { pg8::SchedMoe S{tab, 1, F.G, F.vcu};
              LAS int* gtok = (LAS int*)(F.lds + RING_BYTES);
              { const unsigned* LIST = (const unsigned*)(ws + WS_LIST);
#pragma unroll
                for (int ui = 0; ui < 3; ++ui) { pg8::Unit u; if (S.next(ui, u) && F.tid < 256) { const int slot = u.pm * 256 + F.tid - tab[1 + u.pb];
                      gtok[ui * 256 + F.tid] = slot < tab[34 + u.pb] ? (int)(LIST[(size_t)u.pb * T + slot] & 0x7fffffffu) : 0; } } }
              __syncthreads();
              pg8::Gemm g{(const bf16_t*)(ws + WS_H16), (const bf16_t*)(ws + WS_WMOE + WE_GU), D, D, D, 0, 512 * D};
              pg8::EpiMoe1 E{(bf16_t*)(ws + WS_S + S_HMID), (const float*)(ws + WS_GWL), tab, dep};
              pg8::gemm_phase<pg8::EpiMoe1, pg8::SchedMoe, true>(F.lds, g, S, E, F.wave, F.lane, gtok); }
            { pg8::Gemm g{(const bf16_t*)(ws + WS_S + S_HMID), (const bf16_t*)(ws + WS_WMOE + WE_DN), FF, FF, FF, 0, D * FF}; pg8::SchedMoe2 S{tab, dep, F.G, F.vcu};
              pg8::EpiMoe2 E{(unsigned char*)(ws + WS_S + S_Y0), (unsigned char*)(ws + WS_S + S_Y1), (const unsigned*)(ws + WS_LIST), tab};
              pg8::gemm_phase(F.lds, g, S, E, F.wave, F.lane); }
            SEAM(); TP_END(); }
        }
        if (PON(14)) for (int rp_ = 0; rp_ < 1 + (int)PREP(14); ++rp_) { TP_BEG(14); PHB(); if (li >= 0) phase_ln<1>(F, args, li, F.gw, F.NGW, T);
            if (li + 1 < DEPTH) phase_conv(F, args, li + 1);
            SEAM(); TP_END(); }
    }
#undef IN
#undef SEAM
#undef PHB
}

extern "C" void kernel_launch(void* const* d_in, const int* in_sizes, int n_in, void* d_out, int out_size, void* d_ws, size_t ws_size, hipStream_t stream) {
    static int grid = 0;
    if (grid == 0) {
        if (n_in != 32 || out_size != T * D || ws_size < WS_END) { fprintf(stderr, "kernel_launch: unexpected problem (n_in %d, out %d, ws %zu)\n", n_in, out_size, ws_size); grid = -1; return; }
        int dev = 0, cus = 0, per_cu = 0;
        if (hipGetDevice(&dev) != hipSuccess || hipDeviceGetAttribute(&cus, hipDeviceAttributeMultiprocessorCount, dev) != hipSuccess) { grid = -1; return; }
        if (hipFuncSetAttribute((const void*)fwd, hipFuncAttributeMaxDynamicSharedMemorySize, LDS_BYTES) != hipSuccess) { fprintf(stderr, "kernel_launch: hipFuncSetAttribute failed\n"); grid = -1; return; }
        if (hipOccupancyMaxActiveBlocksPerMultiprocessor(&per_cu, (const void*)fwd, NWAVES * 64, LDS_BYTES) != hipSuccess || per_cu < 1) fprintf(stderr, "kernel_launch: occupancy query reports %d\n", per_cu);
        (void)hipGetLastError();
        grid = cus;
    }
    if (grid < 0) return;
    (void)hipMemsetAsync((char*)d_ws + WS_CTL, 0, CTL_ZERO_BYTES, stream);
    Args a{};
    for (int i = 0; i < 32; ++i) a.in[i] = (const float*)d_in[i];
    a.out = (float*)d_out; a.ws = (unsigned char*)d_ws;
    a.ph_lo = 0; a.ph_hi = N_PHASES;
    hipLaunchKernelGGL(fwd, dim3(grid), dim3(NWAVES * 64), LDS_BYTES, stream, a);
}
```

```cpp
#include <hip/hip_runtime.h>
#include <cstdio>
#include <cstdint>
#include <cstddef>


#ifndef MK_PHMASK
#define MK_PHMASK 0xffffffffu
#endif
#define PON(k) (((MK_PHMASK) >> (k)) & 1u)
#ifndef MK_REPEAT
#define MK_REPEAT 0u
#endif
#define PREP(k) (((MK_REPEAT) >> (k)) & 1u)
#define LAS __attribute__((address_space(3)))
#define GAS __attribute__((address_space(1)))
typedef unsigned short bf16_t;
typedef short bf16x8 __attribute__((ext_vector_type(8)));
typedef float f32x4 __attribute__((ext_vector_type(4)));
typedef float f32x2 __attribute__((ext_vector_type(2)));
typedef unsigned u32x4 __attribute__((ext_vector_type(4)));
typedef unsigned u32x2 __attribute__((ext_vector_type(2)));
typedef GAS unsigned gu32;

constexpr int NB = 8, SEQ = 2048, T = NB * SEQ, D = 2048, DEPTH = 4;
constexpr int S5G = 128, S5P = 16, S5N = 64;
constexpr int NH = 16, HD = 128, QL = 512, KVL = 512, IDXD = 128, TOPK = 256;
constexpr int DSA_IN = QL + KVL + IDXD + NH;
constexpr int DSA_IN_PAD = 1280;
constexpr int NE = 32, EPG = 8, NG = 4, FF = 256;
constexpr float LN_EPS = 1e-5f, RMS_EPS = 1e-6f;
constexpr float DN_ALPHA = 1.6817928305074290f;
constexpr int MAXPOS = 40960;

constexpr size_t MiB = 1u << 20;
constexpr size_t WS_CTL = 0, CTL_ZERO_BYTES = 1 * MiB;
constexpr size_t WS_RT = 1 * MiB;
constexpr size_t WS_S5C = 2 * MiB;
constexpr size_t WS_LIST = 4 * MiB;
constexpr size_t WS_GWL = 6 * MiB;
constexpr size_t WS_TPOS = 8 * MiB;
constexpr size_t WS_GPOS = 9 * MiB;
constexpr size_t WS_WIDX = 10 * MiB;
constexpr size_t WS_KIDX = 12 * MiB;
constexpr size_t WS_SEL = 16 * MiB;
constexpr size_t WS_CQ = 24 * MiB;
constexpr size_t WS_CKV = 40 * MiB;
constexpr size_t WS_WMIX = 56 * MiB;
constexpr size_t WS_WMOE = 88 * MiB;
constexpr size_t WS_H32 = 184 * MiB;
constexpr size_t WS_H16 = 312 * MiB;
constexpr size_t WS_S = 376 * MiB;
constexpr size_t WS_S5T = 888 * MiB;
constexpr size_t S5T_FD = 0, S5T_WS = 2 * MiB, S5T_WY = 10 * MiB, S5T_A16 = 18 * MiB;
constexpr size_t WS_END = 908 * MiB;
constexpr size_t WM_S5_IN = 0, WM_S5_GLU = 8 * MiB, WM_S5_OUT = 16 * MiB;
constexpr size_t WM_D_IN = 0  , WM_D_Q = 6 * MiB  , WM_D_UK = 10 * MiB  , WM_D_UV = 14 * MiB  , WM_D_OUT = 18 * MiB  ;
constexpr size_t WE_GU = 0, WE_DN = 64 * MiB;
constexpr size_t S_U16 = 0, S_Z16 = 64 * MiB, S_ZZ16 = 128 * MiB;
constexpr size_t S_QLAT = 0, S_O16 = 0, S_Q16 = 256 * MiB, S_QIDX = 320 * MiB, S_INDEX = 384 * MiB, S_OLAT = 256 * MiB;
constexpr size_t S_XS = 0, S_HMID = 160 * MiB, S_Y0 = 192 * MiB, S_Y1 = 256 * MiB, S_H16LO = 320 * MiB;
constexpr int CW_TMO = 0, CW_CODE = 1, CW_BAR = 4096, CW_CNT = 16384, CW_DEP = 65536;

constexpr int RING_BYTES = 131072;
constexpr int LDSCTL_OFF = 159744, MISC_OFF = LDSCTL_OFF + 320;
constexpr int MOETAB_OFF = LDSCTL_OFF + 1024;
constexpr int LDS_BYTES = 163840;

#define RLX_AGENT __ATOMIC_RELAXED, __HIP_MEMORY_SCOPE_AGENT
#define LDS_WAIT() asm volatile("s_waitcnt lgkmcnt(0)" ::: "memory")
#define VM_WAIT() asm volatile("s_waitcnt vmcnt(0)" ::: "memory")

__device__ __forceinline__ unsigned f2bf(float f) { unsigned u = __builtin_bit_cast(unsigned, f); return (u + 0x7fffu + ((u >> 16) & 1u)) >> 16; }
__device__ __forceinline__ unsigned pk2(float lo, float hi) { return f2bf(lo) | (f2bf(hi) << 16); }
__device__ __forceinline__ float bf2f(unsigned b) { return __builtin_bit_cast(float, b << 16); }
__device__ __forceinline__ float bflo(unsigned w) { return __builtin_bit_cast(float, w << 16); }
__device__ __forceinline__ float bfhi(unsigned w) { return __builtin_bit_cast(float, w & 0xffff0000u); }
__device__ __forceinline__ int shx_i(int v, int o, int lane) { return __builtin_amdgcn_ds_bpermute((lane ^ o) << 2, v); }
__device__ __forceinline__ float shx(float v, int o, int lane) { return __builtin_bit_cast(float, __builtin_amdgcn_ds_bpermute((lane ^ o) << 2, __builtin_bit_cast(int, v))); }
#define DPP_F(x, ctrl) __builtin_bit_cast(float, __builtin_amdgcn_update_dpp(0, __builtin_bit_cast(int, (x)), (ctrl), 0xf, 0xf, false))
__device__ __forceinline__ float wave_sum(float v, int lane) {
    (void)lane;
    float t = v;
    t += DPP_F(t, 0xB1);
    t += DPP_F(t, 0x4E);
    t += DPP_F(t, 0x141);
    t += DPP_F(t, 0x140);
    const float s0 = __builtin_bit_cast(float, __builtin_amdgcn_readlane(__builtin_bit_cast(int, t), 0)), s1 = __builtin_bit_cast(float, __builtin_amdgcn_readlane(__builtin_bit_cast(int, t), 16));
    const float s2 = __builtin_bit_cast(float, __builtin_amdgcn_readlane(__builtin_bit_cast(int, t), 32)), s3 = __builtin_bit_cast(float, __builtin_amdgcn_readlane(__builtin_bit_cast(int, t), 48));
    return (s0 + s1) + (s2 + s3);
}
__device__ __forceinline__ float wave_max(float v, int lane) {
#pragma unroll
    for (int o = 1; o < 64; o <<= 1) v = fmaxf(v, shx(v, o, lane));
    return v;
}

namespace pg8 {
constexpr int BM = 256, BK = 64, HALF = 128, HTB = HALF * BK * 2, STAGE_BYTES = 8 * HTB, NXCD = 8, WGM = 8;
__host__ __device__ __forceinline__ int lds_byte(int r, int c) { const int st = (r >> 4) * 2 + (c >> 5), rr = r & 15, cc = c & 31, ob = rr * 64 + cc * 2; return st * 1024 + (ob ^ (((ob >> 9) & 1) << 5)); }
__host__ __device__ __forceinline__ void stage_rc(int b, int& R, int& C) { const int st = b / 1024, sb = b % 1024, swz = sb ^ (((sb >> 9) & 1) << 5); R = (st >> 1) * 16 + swz / 64; C = (st & 1) * 32 + (swz % 64) / 2; }
__host__ __device__ __forceinline__ int perm32(int rho) { const int n = rho >> 4, i = rho & 15; return 8 * (i >> 2) + 4 * n + (i & 3); }

struct Unit { int pm, pn, pb; };
struct Gemm { const bf16_t* A; const bf16_t* Bt; int lda, ldb, K; long long sA, sB; };

struct SchedGrid {
    int nM, nN, nB, G, c;
    __device__ __forceinline__ bool next(int i, Unit& u) const { return unit((long)i * G + c, u); }
    __device__ __forceinline__ bool unit(long L, Unit& u) const {
        const int per = nM * nN, nwg = per * nB; if (L >= nwg) return false;
        int wgid = (int)L; { const int q = nwg / NXCD, r = nwg % NXCD, xcd = wgid % NXCD, off = wgid / NXCD; wgid = (xcd < r ? xcd * (q + 1) : r * (q + 1) + (xcd - r) * q) + off; }
        u.pb = wgid / per; const int w = wgid % per;
        const int nig = WGM * nN, gid = w / nig, fm = gid * WGM, gsz = (nM - fm) < WGM ? (nM - fm) : WGM;
        u.pm = fm + ((w % nig) % gsz); u.pn = (w % nig) / gsz; return true;
    }
};
struct SchedGridSplit {
    SchedGrid base; int thr, KA;
    __device__ __forceinline__ bool next(int i, Unit& u) const {
        const int G = base.G, c = base.c, U2 = base.nM * base.nN * base.nB, nl = G - thr;
        const int NA = (KA * nl < U2) ? KA * nl : U2;
        long L;
        if (c >= thr) { const int q = c - thr; const int ra = q < NA ? (NA - q + nl - 1) / nl : 0;
            L = i < ra ? (long)q + (long)i * nl : (long)NA + c + (long)(i - ra) * G; }
        else L = (long)NA + c + (long)i * G;
        return base.unit(L, u);
    }
};
struct SchedMoe {
    const LAS int* tab; int sh  , G, c;
    __device__ __forceinline__ bool next(int i, Unit& u) const {
        const int nmt = __builtin_amdgcn_readfirstlane(tab[0]); const long L = (long)i * G + c; if (L >= ((long)nmt << sh)) return false;
        const int mt = (int)(L >> sh); u.pm = mt; u.pn = (int)(L & ((1 << sh) - 1)); u.pb = __builtin_amdgcn_readfirstlane((int)((const LAS unsigned char*)(tab + 66))[mt]); return true;
    }
};

struct SchedMoe2 {
    const LAS int* tab; unsigned* dep; int G, c;
    static constexpr int KA = 4;
    __device__ __forceinline__ bool next(int i, Unit& u) const {
        const int nmt = __builtin_amdgcn_readfirstlane(tab[0]); const int U1 = nmt << 1, U2 = nmt << 3;
        const int maxu = (U1 + G - 1) / G, thr = U1 - G * (maxu - 1), nl = G - thr;
        const int NA = (KA * nl < U2) ? KA * nl : U2;
        long L;
        if (c >= thr) { const int q = c - thr; const int ra = q < NA ? (NA - q + nl - 1) / nl : 0;
            L = i < ra ? (long)q + (long)i * nl : (long)NA + c + (long)(i - ra) * G; }
        else L = (long)NA + c + (long)i * G;
        if (L >= U2) return false;
        const int mt = (int)(L >> 3); u.pm = mt; u.pn = (int)(L & 7); u.pb = __builtin_amdgcn_readfirstlane((int)((const LAS unsigned char*)(tab + 66))[mt]);
        unsigned sp = 0u;
        while (__hip_atomic_load(dep + 16 * mt, __ATOMIC_RELAXED, __HIP_MEMORY_SCOPE_AGENT) < 2u) { __builtin_amdgcn_s_sleep(2); if (++sp > (1u << 20)) break; }
        asm volatile("" ::: "memory");
        return true;
    }
};

__device__ __forceinline__ unsigned cvt_pk_bf16(float lo, float hi) { unsigned r; asm volatile("v_cvt_pk_bf16_f32 %0, %1, %2" : "=v"(r) : "v"(lo), "v"(hi)); return r; }

struct EpiStoreBf16 {
    static constexpr bool PERM = true; static constexpr bool SIGNAL = false;
    bf16_t* O; int ldc; int bcol; int split_cols; size_t split_stride;
    __device__ __forceinline__ void operator()(const f32x4 (&acc)[2][2][4][2], const Unit& u, int wr, int wc, int fr, int fq) const {
        const int row0 = u.pm * BM + wr * 64 + fr; int colt = u.pn * BM; bf16_t* base = O + (size_t)u.pb * bcol;
        if (split_cols) { const int t = colt / split_cols; base += (size_t)t * split_stride; colt -= t * split_cols; }
        const int col0 = colt + wc * 32 + 8 * fq;
#pragma unroll
        for (int ai = 0; ai < 2; ++ai)
#pragma unroll
            for (int m = 0; m < 4; ++m) { bf16_t* rowp = base + (size_t)(row0 + ai * HALF + m * 16) * ldc + col0;
#pragma unroll
                for (int bj = 0; bj < 2; ++bj) { const f32x4 v0 = acc[ai][bj][m][0], v1 = acc[ai][bj][m][1];
                    u32x4 w; w.x = cvt_pk_bf16(v0[0], v0[1]); w.y = cvt_pk_bf16(v0[2], v0[3]); w.z = cvt_pk_bf16(v1[0], v1[1]); w.w = cvt_pk_bf16(v1[2], v1[3]);
                    *(u32x4*)(rowp + bj * HALF) = w; } }
    }
};
struct EpiStoreFp8 {
    static constexpr bool PERM = true; static constexpr bool SIGNAL = false;
    unsigned char* O; int ldc; int bcol;
    __device__ __forceinline__ void operator()(const f32x4 (&acc)[2][2][4][2], const Unit& u, int wr, int wc, int fr, int fq) const {
        const int row0 = u.pm * BM + wr * 64 + fr; unsigned char* base = O + (size_t)u.pb * bcol;
        const int col0 = u.pn * BM + wc * 32 + 8 * fq;
#pragma unroll
        for (int ai = 0; ai < 2; ++ai)
#pragma unroll
            for (int m = 0; m < 4; ++m) { unsigned char* rowp = base + (size_t)(row0 + ai * HALF + m * 16) * ldc + col0;
#pragma unroll
                for (int bj = 0; bj < 2; ++bj) { const f32x4 v0 = acc[ai][bj][m][0] * 16.0f, v1 = acc[ai][bj][m][1] * 16.0f;
                    int p0 = __builtin_amdgcn_cvt_pk_fp8_f32(v0[0], v0[1], 0, false); p0 = __builtin_amdgcn_cvt_pk_fp8_f32(v0[2], v0[3], p0, true);
                    int p1 = __builtin_amdgcn_cvt_pk_fp8_f32(v1[0], v1[1], 0, false); p1 = __builtin_amdgcn_cvt_pk_fp8_f32(v1[2], v1[3], p1, true);
                    u32x2 w; w.x = (unsigned)p0; w.y = (unsigned)p1; *(u32x2*)(rowp + bj * HALF) = w; } }
    }
};
struct EpiGlu {
    static constexpr bool PERM = true; static constexpr bool SIGNAL = false;
    const bf16_t* Z; bf16_t* O; int ldc;
    __device__ __forceinline__ void operator()(const f32x4 (&acc)[2][2][4][2], const Unit& u, int wr, int wc, int fr, int fq) const {
        const int row0 = u.pm * BM + wr * 64 + fr, col0 = u.pn * BM + wc * 32 + 8 * fq;
        u32x4 zv[2][4][2];
#pragma unroll
        for (int ai = 0; ai < 2; ++ai)
#pragma unroll
            for (int m = 0; m < 4; ++m)
#pragma unroll
                for (int bj = 0; bj < 2; ++bj) zv[ai][m][bj] = *(const u32x4*)(Z + (size_t)(row0 + ai * HALF + m * 16) * ldc + col0 + bj * HALF);
        __builtin_amdgcn_sched_barrier(0);
#pragma unroll
        for (int ai = 0; ai < 2; ++ai) {
#pragma unroll
            for (int m = 0; m < 4; ++m) { const size_t ro = (size_t)(row0 + ai * HALF + m * 16) * ldc + col0;
#pragma unroll
                for (int bj = 0; bj < 2; ++bj) { const f32x4 v0 = acc[ai][bj][m][0], v1 = acc[ai][bj][m][1];
                    const u32x4 z = zv[ai][m][bj];
                    float r[8]; const float a[8] = {v0[0], v0[1], v0[2], v0[3], v1[0], v1[1], v1[2], v1[3]};
                    const float zz[8] = {bflo(z.x), bfhi(z.x), bflo(z.y), bfhi(z.y), bflo(z.z), bfhi(z.z), bflo(z.w), bfhi(z.w)};
#pragma unroll
                    for (int j = 0; j < 8; ++j) r[j] = zz[j] / (1.0f + __expf(-a[j]));
                    u32x4 w; w.x = cvt_pk_bf16(r[0], r[1]); w.y = cvt_pk_bf16(r[2], r[3]); w.z = cvt_pk_bf16(r[4], r[5]); w.w = cvt_pk_bf16(r[6], r[7]);
                    *(u32x4*)(O + ro + bj * HALF) = w; } }
            __builtin_amdgcn_sched_barrier(0);
        }
    }
};
struct EpiResid {
    static constexpr bool PERM = true; static constexpr bool SIGNAL = false;
    bf16_t* H; int ldc; float alpha;
    __device__ __forceinline__ void operator()(const f32x4 (&acc)[2][2][4][2], const Unit& u, int wr, int wc, int fr, int fq) const {
        const int row0 = u.pm * BM + wr * 64 + fr, col0 = u.pn * BM + wc * 32 + 8 * fq;
        u32x4 hv[2][4][2];
#pragma unroll
        for (int ai = 0; ai < 2; ++ai)
#pragma unroll
            for (int m = 0; m < 4; ++m)
#pragma unroll
                for (int bj = 0; bj < 2; ++bj) hv[ai][m][bj] = *(const u32x4*)(H + (size_t)(row0 + ai * HALF + m * 16) * ldc + col0 + bj * HALF);
        __builtin_amdgcn_sched_barrier(0);
#pragma unroll
        for (int ai = 0; ai < 2; ++ai) {
#pragma unroll
            for (int m = 0; m < 4; ++m) { bf16_t* rowp = H + (size_t)(row0 + ai * HALF + m * 16) * ldc + col0;
#pragma unroll
                for (int bj = 0; bj < 2; ++bj) { const f32x4 v0 = acc[ai][bj][m][0], v1 = acc[ai][bj][m][1]; const u32x4 h = hv[ai][m][bj];
                    u32x4 w; w.x = cvt_pk_bf16(bflo(h.x) * alpha + v0[0], bfhi(h.x) * alpha + v0[1]); w.y = cvt_pk_bf16(bflo(h.y) * alpha + v0[2], bfhi(h.y) * alpha + v0[3]);
                    w.z = cvt_pk_bf16(bflo(h.z) * alpha + v1[0], bfhi(h.z) * alpha + v1[1]); w.w = cvt_pk_bf16(bflo(h.w) * alpha + v1[2], bfhi(h.w) * alpha + v1[3]);
                    *(u32x4*)(rowp + bj * HALF) = w; } }
            __builtin_amdgcn_sched_barrier(0);
        }
    }
};
struct EpiDsaIn {
    static constexpr bool PERM = true; static constexpr bool SIGNAL = false;
    bf16_t* CQ; bf16_t* CKV; bf16_t* KIDX; float* WIDX; int pn0;
    __device__ __forceinline__ void operator()(const f32x4 (&acc)[2][2][4][2], const Unit& u0, int wr, int wc, int fr, int fq) const {
        Unit u = u0; u.pn += pn0;
        const int row0 = u.pm * BM + wr * 64 + fr, cb = wc * 32 + 8 * fq;
#pragma unroll
        for (int ai = 0; ai < 2; ++ai)
#pragma unroll
            for (int m = 0; m < 4; ++m) { const size_t row = (size_t)(row0 + ai * HALF + m * 16);
#pragma unroll
                for (int bj = 0; bj < 2; ++bj) { const f32x4 v0 = acc[ai][bj][m][0], v1 = acc[ai][bj][m][1];
                    u32x4 w; w.x = cvt_pk_bf16(v0[0], v0[1]); w.y = cvt_pk_bf16(v0[2], v0[3]); w.z = cvt_pk_bf16(v1[0], v1[1]); w.w = cvt_pk_bf16(v1[2], v1[3]);
                    if (u.pn < 2) *(u32x4*)(CQ + row * 512 + u.pn * 256 + bj * HALF + cb) = w;
                    else if (u.pn < 4) *(u32x4*)(CKV + row * 512 + (u.pn - 2) * 256 + bj * HALF + cb) = w;
                    else if (bj == 0) *(u32x4*)(KIDX + row * 128 + cb) = w;
                    else if (cb < 16) { *(f32x4*)(WIDX + row * 16 + cb) = v0 * 0.25f; *(f32x4*)(WIDX + row * 16 + cb + 4) = v1 * 0.25f; } } }
    }
};
struct EpiMoe1 {
    static constexpr bool PERM = true; static constexpr bool SIGNAL = true;
    bf16_t* HM; const float* GWL; const LAS int* tab; unsigned* dep;
    __device__ __forceinline__ void operator()(const f32x4 (&acc)[2][2][4][2], const Unit& u, int wr, int wc, int fr, int fq) const {
        const int row0 = u.pm * BM + wr * 64 + fr, cb = u.pn * 128 + wc * 32 + 8 * fq;
        const int poff = tab[1 + u.pb], cnt = tab[34 + u.pb];
        float gwv[2][4];
#pragma unroll
        for (int ai = 0; ai < 2; ++ai)
#pragma unroll
            for (int m = 0; m < 4; ++m) { const int slot = row0 + ai * HALF + m * 16 - poff; gwv[ai][m] = slot < cnt ? GWL[(size_t)u.pb * T + slot] : 0.f; }
        __builtin_amdgcn_sched_barrier(0);
#pragma unroll
        for (int ai = 0; ai < 2; ++ai)
#pragma unroll
            for (int m = 0; m < 4; ++m) { const int pos = row0 + ai * HALF + m * 16; const float gw = gwv[ai][m];
                const f32x4 g0 = acc[ai][0][m][0], g1 = acc[ai][0][m][1], u0 = acc[ai][1][m][0], u1 = acc[ai][1][m][1];
                const float g[8] = {g0[0], g0[1], g0[2], g0[3], g1[0], g1[1], g1[2], g1[3]}, uu[8] = {u0[0], u0[1], u0[2], u0[3], u1[0], u1[1], u1[2], u1[3]}; float r[8];
#pragma unroll
                for (int j = 0; j < 8; ++j) r[j] = g[j] / (1.0f + __expf(-g[j])) * uu[j] * gw;
                u32x4 w; w.x = cvt_pk_bf16(r[0], r[1]); w.y = cvt_pk_bf16(r[2], r[3]); w.z = cvt_pk_bf16(r[4], r[5]); w.w = cvt_pk_bf16(r[6], r[7]);
                *(u32x4*)(HM + (size_t)pos * 256 + cb) = w; }
    }
};
struct EpiMoe2 {
    static constexpr bool PERM = true; static constexpr bool SIGNAL = false;
    unsigned char* Y0; unsigned char* Y1; const unsigned* LIST; const LAS int* tab;
    __device__ __forceinline__ void operator()(const f32x4 (&acc)[2][2][4][2], const Unit& u, int wr, int wc, int fr, int fq) const {
        const int row0 = u.pm * BM + wr * 64 + fr, col0 = u.pn * BM + wc * 32 + 8 * fq;
        const int poff = tab[1 + u.pb], cnt = tab[34 + u.pb];
        unsigned tkv2[2][4];
#pragma unroll
        for (int ai = 0; ai < 2; ++ai)
#pragma unroll
          for (int m = 0; m < 4; ++m) { const int slot = row0 + ai * HALF + m * 16 - poff; tkv2[ai][m] = slot < cnt ? LIST[(size_t)u.pb * T + slot] : 0xffffffffu; }
        __builtin_amdgcn_sched_barrier(0);
#pragma unroll
        for (int ai = 0; ai < 2; ++ai) {
#pragma unroll
            for (int m = 0; m < 4; ++m) { const unsigned tk = tkv2[ai][m];
                if (tk != 0xffffffffu) { unsigned char* rowp = ((tk >> 31) ? Y1 : Y0) + (size_t)(tk & 0x7fffffffu) * D + col0;
#pragma unroll
                    for (int bj = 0; bj < 2; ++bj) { const f32x4 v0 = acc[ai][bj][m][0] * 16.0f, v1 = acc[ai][bj][m][1] * 16.0f;
                        int p0 = __builtin_amdgcn_cvt_pk_fp8_f32(v0[0], v0[1], 0, false); p0 = __builtin_amdgcn_cvt_pk_fp8_f32(v0[2], v0[3], p0, true);
                        int p1 = __builtin_amdgcn_cvt_pk_fp8_f32(v1[0], v1[1], 0, false); p1 = __builtin_amdgcn_cvt_pk_fp8_f32(v1[2], v1[3], p1, true);
                        u32x2 w; w.x = (unsigned)p0; w.y = (unsigned)p1; *(u32x2*)(rowp + bj * HALF) = w; } } }
        }
    }
};

template <class Epi, class Sched, bool GATHER = false>
__device__ __forceinline__ void gemm_phase(LAS unsigned char* lds, const Gemm g, const Sched& S, const Epi& E, int wid, int lane, const LAS int* gtok = nullptr) {
    const int tid = wid * 64 + lane, wr = wid >> 2, wc = wid & 3, fr = lane & 15, fq = lane >> 4;
    const int K = g.K, nt = K / BK;
    unsigned voffA[2], voffB[2];
#pragma unroll
    for (int i = 0; i < 2; ++i) { int R, C; stage_rc(tid * 16 + i * 8192, R, C); const int Rb = Epi::PERM ? ((R & ~31) + perm32(R & 31)) : R;
        voffA[i] = GATHER ? (unsigned)(R * 65536 + C * 2) : (unsigned)(R * g.lda + C) * 2u; voffB[i] = (unsigned)(Rb * g.ldb + C) * 2u; }
    const size_t kstep = (size_t)(BK * 2);
    const size_t hstepA = GATHER ? 0 : (size_t)HALF * g.lda * 2, hstepB = (size_t)HALF * g.ldb * 2;
    unsigned vc[2][2], vn[2][2];
#define PG8_GTOK(dst, ui_) do { _Pragma("unroll") for (int h_ = 0; h_ < 2; ++h_) _Pragma("unroll") for (int i_ = 0; i_ < 2; ++i_) \
        dst[h_][i_] = (unsigned)gtok[(ui_) * 256 + h_ * HALF + (int)(voffA[i_] >> 16)] * (unsigned)(g.lda * 2) + (voffA[i_] & 0xffffu); } while (0)
    const unsigned ldsw = (unsigned)wid * 1024u;
    const int aoff = lds_byte(wr * 64 + fr, fq * 8), boff = lds_byte(wc * 32 + fr, fq * 8);
#define PG8_SA(b, h) (((b) * 2 + (h)) * HTB)
#define PG8_SB(b, h) ((4 + (b) * 2 + (h)) * HTB)
#define PG8_STAGE(bufoff, gbase, voff) do { _Pragma("unroll") for (int _i = 0; _i < 2; ++_i) \
        __builtin_amdgcn_global_load_lds((const unsigned*)((const char*)(gbase) + (voff)[_i]), (LAS unsigned*)(lds + (bufoff) + ldsw + _i * 8192), 16, 0, 0); } while (0)
#define PG8_LDA(dst, b, h) do { _Pragma("unroll") for (int m = 0; m < 4; ++m) _Pragma("unroll") for (int k = 0; k < 2; ++k) dst[m][k] = *(const LAS bf16x8*)(lds + PG8_SA(b, h) + aoff + m * 2048 + k * 1024); } while (0)
#define PG8_LDB(dst, b, h) do { _Pragma("unroll") for (int n = 0; n < 2; ++n) _Pragma("unroll") for (int k = 0; k < 2; ++k) dst[n][k] = *(const LAS bf16x8*)(lds + PG8_SB(b, h) + boff + n * 2048 + k * 1024); } while (0)
#define PG8_MMA(ai, bj, At, Bt) do { __builtin_amdgcn_s_setprio(1); _Pragma("unroll") for (int m = 0; m < 4; ++m) _Pragma("unroll") for (int n = 0; n < 2; ++n) _Pragma("unroll") for (int k = 0; k < 2; ++k) \
        acc[ai][bj][m][n] = __builtin_amdgcn_mfma_f32_16x16x32_bf16(Bt[n][k], At[m][k], acc[ai][bj][m][n], 0, 0, 0); __builtin_amdgcn_s_setprio(0); } while (0)
#define PG8_WAIT_V(n) asm volatile("s_waitcnt vmcnt(" #n ")" ::: "memory")
#define PG8_WAIT_L(n) asm volatile("s_waitcnt lgkmcnt(" #n ")" ::: "memory")
#define PG8_BAR __builtin_amdgcn_s_barrier()
#define PG8_SCHED __builtin_amdgcn_sched_barrier(0)
#define PG8_TA(u) (GATHER ? (const char*)g.A : (const char*)g.A + ((size_t)(u).pb * (size_t)g.sA + (size_t)(u).pm * BM * (size_t)g.lda) * 2)
#define PG8_STAGE_A(bufoff, gbase, h, nx) do { if constexpr (GATHER) { unsigned vo_[2] = {(nx) ? vn[h][0] : vc[h][0], (nx) ? vn[h][1] : vc[h][1]}; PG8_STAGE(bufoff, gbase, vo_); } else { PG8_STAGE(bufoff, (gbase) + (h) * hstepA, voffA); } } while (0)
#define PG8_TB(u) ((const char*)g.Bt + ((size_t)(u).pb * (size_t)g.sB + (size_t)(u).pn * BM * (size_t)g.ldb) * 2)
    Unit cur, nxt; int ui = 0;
    if (!S.next(0, cur)) return;
    f32x4 acc[2][2][4][2];
#pragma unroll
    for (int a = 0; a < 2; ++a)
#pragma unroll
        for (int b = 0; b < 2; ++b)
#pragma unroll
            for (int m = 0; m < 4; ++m)
#pragma unroll
                for (int n = 0; n < 2; ++n) acc[a][b][m][n] = (f32x4){0.f, 0.f, 0.f, 0.f};
    bf16x8 At[4][2], B0[2][2], B1[2][2];
    const char* cA = PG8_TA(cur); const char* cB = PG8_TB(cur);
    if constexpr (GATHER) { PG8_GTOK(vc, 0); PG8_GTOK(vn, 0); }
    PG8_STAGE(PG8_SB(0, 0), cB, voffB); PG8_STAGE(PG8_SB(0, 1), cB + hstepB, voffB); PG8_STAGE_A(PG8_SA(0, 0), cA, 0, false); PG8_STAGE_A(PG8_SA(0, 1), cA, 1, false);
    if (wr == 1) PG8_BAR;
    PG8_WAIT_V(2); PG8_BAR;
    PG8_STAGE(PG8_SB(1, 0), cB + kstep, voffB); PG8_STAGE_A(PG8_SA(1, 0), cA + kstep, 0, false); PG8_STAGE(PG8_SB(1, 1), cB + hstepB + kstep, voffB);
    PG8_WAIT_V(6); PG8_BAR;
    for (;;) {
        const bool has_next = S.next(ui + 1, nxt);
        const char* nA = has_next ? PG8_TA(nxt) : cA; const char* nB = has_next ? PG8_TB(nxt) : cB;
        for (int t = 0; t < nt; t += 2) {
            const bool last = (t == nt - 2);
            const char* a1 = cA + (size_t)(t + 1) * kstep;
            const char* a2 = last ? nA : cA + (size_t)(t + 2) * kstep; const char* b2 = last ? nB : cB + (size_t)(t + 2) * kstep;
            const char* a3 = a2 + kstep; const char* b3 = b2 + kstep;
            if constexpr (GATHER) { if (last && has_next) PG8_GTOK(vn, ui + 1); }
            PG8_LDB(B0, 0, 0); PG8_LDB(B1, 0, 1); PG8_SCHED; PG8_LDA(At, 0, 0); PG8_STAGE_A(PG8_SA(1, 1), a1, 1, false);
            PG8_WAIT_V(8); PG8_WAIT_L(0); PG8_BAR; PG8_MMA(0, 0, At, B0); PG8_MMA(0, 1, At, B1); PG8_BAR; PG8_SCHED;
            PG8_LDA(At, 0, 1); PG8_STAGE(PG8_SB(0, 0), b2, voffB); PG8_STAGE(PG8_SB(0, 1), b2 + hstepB, voffB); PG8_STAGE_A(PG8_SA(0, 0), a2, 0, last);
            PG8_WAIT_V(8); PG8_WAIT_L(0); PG8_BAR; PG8_MMA(1, 0, At, B0); PG8_MMA(1, 1, At, B1); PG8_BAR; PG8_SCHED;
            PG8_LDB(B0, 1, 0); PG8_LDB(B1, 1, 1); PG8_SCHED; PG8_LDA(At, 1, 0); PG8_STAGE_A(PG8_SA(0, 1), a2, 1, last);
            PG8_WAIT_V(8); PG8_WAIT_L(0); PG8_BAR; PG8_MMA(0, 0, At, B0); PG8_MMA(0, 1, At, B1); PG8_BAR; PG8_SCHED;
            PG8_LDA(At, 1, 1); PG8_STAGE(PG8_SB(1, 0), b3, voffB); PG8_STAGE(PG8_SB(1, 1), b3 + hstepB, voffB); PG8_STAGE_A(PG8_SA(1, 0), a3, 0, last);
            PG8_WAIT_V(8); PG8_WAIT_L(0); PG8_BAR; PG8_MMA(1, 0, At, B0); PG8_MMA(1, 1, At, B1); PG8_BAR; PG8_SCHED;
        }
        if (wr == 0) PG8_BAR;
        { int l2_; asm volatile("v_mbcnt_lo_u32_b32 %0, -1, 0\n\tv_mbcnt_hi_u32_b32 %0, -1, %0" : "=v"(l2_)); E(acc, cur, wr, wc, l2_ & 15, l2_ >> 4);
          if constexpr (Epi::SIGNAL) { PG8_WAIT_V(0); PG8_BAR;
              if (wid == 0 && l2_ == 0) { __builtin_amdgcn_fence(__ATOMIC_RELEASE, "agent"); (void)__hip_atomic_fetch_add(E.dep + 16 * cur.pm, 1u, __ATOMIC_RELAXED, __HIP_MEMORY_SCOPE_AGENT); } } }
        if (!has_next) break;
#pragma unroll
        for (int a = 0; a < 2; ++a)
#pragma unroll
            for (int b = 0; b < 2; ++b)
#pragma unroll
                for (int m = 0; m < 4; ++m)
#pragma unroll
                    for (int n = 0; n < 2; ++n) acc[a][b][m][n] = (f32x4){0.f, 0.f, 0.f, 0.f};
        cur = nxt; cA = nA; cB = nB; ++ui;
        if constexpr (GATHER) { _Pragma("unroll") for (int h_ = 0; h_ < 2; ++h_) _Pragma("unroll") for (int i_ = 0; i_ < 2; ++i_) vc[h_][i_] = vn[h_][i_]; }
        if (wr == 1) PG8_BAR;
    }
    PG8_WAIT_V(0);
    PG8_BAR;
#undef PG8_SA
#undef PG8_SB
#undef PG8_STAGE
#undef PG8_LDA
#undef PG8_LDB
#undef PG8_MMA
#undef PG8_WAIT_V
#undef PG8_WAIT_L
#undef PG8_BAR
#undef PG8_SCHED
#undef PG8_TA
#undef PG8_STAGE_A
#undef PG8_GTOK
#undef PG8_TB
}
}

#define XB_TMO      128
#define XB_XCNT(j)  (256  + 64 * (j))
#define XB_XSUB(j)  (1280 + 64 * (j))
#define XB_XGEN(j)  (2304 + 64 * (j))
#define XB_TOP      3328
#define XB_TOPGEN   3392
#define XCD_BAR_WORDS 3456
#define XB_SPIN_CAP (1u << 18)
__device__ __forceinline__ unsigned xb_ld(unsigned* p)              { return __hip_atomic_load(p, __ATOMIC_RELAXED, __HIP_MEMORY_SCOPE_AGENT); }
__device__ __forceinline__ unsigned xb_add(unsigned* p, unsigned v) { return __hip_atomic_fetch_add(p, v, __ATOMIC_RELAXED, __HIP_MEMORY_SCOPE_AGENT); }
__device__ __forceinline__ unsigned xb_xcc_id() { return (unsigned)__builtin_amdgcn_s_getreg((3 << 11) | 20) & 0xFu; }
#define XB_SPIN(cond, bar) do { unsigned _sp = 0; while (cond) { __builtin_amdgcn_s_sleep(1); \
    if ((++_sp & 255u) == 0u) { if (xb_ld(&(bar)[XB_TMO])) break; if (_sp > XB_SPIN_CAP) { atomicAdd(&(bar)[XB_TMO], 1u); break; } } } } while (0)
struct XcdBarrier { unsigned* bar; unsigned x; volatile LAS unsigned* st; };
__device__ __forceinline__ XcdBarrier xcd_barrier_post(unsigned* bar, volatile LAS unsigned* st, int tid) {
    XcdBarrier b; b.bar = bar; b.x = xb_xcc_id(); b.st = st;
    if (tid == 0) (void)xb_add(&bar[XB_XCNT(b.x)], 1u);
    return b;
}
__device__ __forceinline__ void xcd_barrier_complete(unsigned* bar, unsigned x, unsigned& nloc, unsigned& nx) {
    const unsigned G = gridDim.x * gridDim.y * gridDim.z;
    unsigned sum, cnt, mine, sp = 0u;
    for (;;) {
        sum = 0u; cnt = 0u; mine = 0u;
#pragma unroll
        for (unsigned j = 0; j < 16; ++j) { const unsigned c = xb_ld(&bar[XB_XCNT(j)]); sum += c; cnt += (c > 0u) ? 1u : 0u; mine = (j == x) ? c : mine; }
        if (sum == G) break;
        __builtin_amdgcn_s_sleep(1);
        if ((++sp & 255u) == 0u) { if (xb_ld(&bar[XB_TMO])) break; if (sp > XB_SPIN_CAP) { atomicAdd(&bar[XB_TMO], 1u); break; } }
    }
    nloc = mine > 0u ? mine : 1u; nx = cnt > 0u ? cnt : 1u;
}
__device__ __forceinline__ void xcd_barrier(const XcdBarrier& b, int tid) {
    asm volatile("s_waitcnt vmcnt(0)" ::: "memory");
    __syncthreads();
    if (tid == 0) {
        unsigned* bar; { unsigned long long bb_ = (unsigned long long)b.bar; asm volatile("" : "+s"(bb_)); bar = (unsigned*)(GAS unsigned*)bb_; }
        __builtin_amdgcn_s_waitcnt(0);
        unsigned nloc = b.st[0], nx = b.st[1];
        if (nloc == 0u) { xcd_barrier_complete(bar, b.x, nloc, nx); b.st[0] = nloc; b.st[1] = nx; }
        const unsigned old = xb_add(&bar[XB_XSUB(b.x)], 1u);
        const unsigned gen = old / nloc;
        if (old + 1u == (gen + 1u) * nloc) {
            __builtin_amdgcn_fence(__ATOMIC_RELEASE, "agent");
            asm volatile("s_waitcnt vmcnt(0)" ::: "memory");
            const unsigned og = xb_add(&bar[XB_TOP], 1u);
            const unsigned tg = og / nx;
            if (og + 1u != (tg + 1u) * nx) XB_SPIN(xb_ld(&bar[XB_TOP]) < (tg + 1u) * nx, bar);
            __builtin_amdgcn_fence(__ATOMIC_ACQUIRE, "agent");
            asm volatile("s_waitcnt vmcnt(0)" ::: "memory");
        } else {
            XB_SPIN(xb_ld(&bar[XB_TOP]) < (gen + 1u) * nx, bar);
            __builtin_amdgcn_fence(__ATOMIC_ACQUIRE, "agent");
            asm volatile("s_waitcnt vmcnt(0)" ::: "memory");
        }
    }
    __syncthreads();
}

struct Args { const float* in[32]; float* out; unsigned char* ws; int ph_lo, ph_hi; };
struct Frame {
    LAS unsigned char* lds;
    volatile LAS unsigned* MISC;
    gu32* ctl;
    int tid, lane, wave, G, vcu, gw, NGW;
    unsigned char* ws;
};
enum { I_X = 0, I_RELB, I_S5_WIN, I_S5_ARE, I_S5_AIM, I_S5_LOGDT, I_S5_BRE, I_S5_BIM, I_S5_CRE, I_S5_CIM, I_S5_D, I_S5_WGLU, I_S5_WOUT,
       I_D_WIN, I_D_QN, I_D_KVN, I_D_WUQ, I_D_WQIDX, I_D_WUK, I_D_WUV, I_D_WOUT,
       I_M_WG, I_M_BG, I_M_WE, I_M_BE, I_M_WGATE, I_M_WUP, I_M_WDOWN, I_LNM_G, I_LNM_B, I_LNF_G, I_LNF_B };

__device__ __forceinline__ void tr_item(const float* src, int ldS, int nvalid, bf16_t* dst, int ldD, long zoff, bool zfill, LAS float* scr, int lane) {
    const int nn = lane & 31; const bool ok = nn < nvalid;
    const float* sp = src + (size_t)(lane >> 5) * ldS + nn; const size_t st2 = (size_t)2 * ldS;
#pragma unroll
    for (int hb = 0; hb < 2; ++hb) {
        float tv[16];
#pragma unroll
        for (int i = 0; i < 16; ++i) { tv[i] = ok ? *sp : 0.f; sp += st2; }
        __builtin_amdgcn_sched_barrier(0);
#pragma unroll
        for (int i = 0; i < 16; ++i) scr[(2 * (hb * 16 + i) + (lane >> 5)) * 33 + nn] = tv[i];
        __builtin_amdgcn_sched_barrier(0);
    }
    LDS_WAIT(); asm volatile("" ::: "memory");
    const int c = lane & 7;
#pragma unroll
    for (int j = 0; j < 4; ++j) { const int n = (lane >> 3) + 8 * j; const LAS float* s = scr + (8 * c) * 33 + n;
        u32x4 o; o.x = pk2(s[0 * 33], s[1 * 33]); o.y = pk2(s[2 * 33], s[3 * 33]); o.z = pk2(s[4 * 33], s[5 * 33]); o.w = pk2(s[6 * 33], s[7 * 33]);
        *(GAS u32x4*)(dst + (size_t)n * ldD + 8 * c) = o;
        if (zfill) *(GAS u32x4*)(dst + zoff + (size_t)n * ldD + 8 * c) = (u32x4){0u, 0u, 0u, 0u}; }
    LDS_WAIT(); asm volatile("" ::: "memory");
}

__device__ __forceinline__ void s5_tables(const Frame& F, const Args& a, int j) {
    unsigned char* ws = F.ws;
    LAS f32x2* PW = (LAS f32x2*)F.lds;
    LAS f32x2* BBs = PW + 17 * 64;
    LAS f32x2* Cs = BBs + 1024;
    LAS float* Ks = (LAS float*)(Cs + 1024);
    for (int item = F.vcu; item < 2 * S5G; item += F.G) {
        const int g = item >> 1, half = item & 1;
        __syncthreads();
        const float dt = expf(a.in[I_S5_LOGDT][j * S5G + g]);
        for (int idx = F.tid; idx < 17 * 64; idx += 512) { const int k = idx >> 6, n = idx & 63;
            const float are = fminf(a.in[I_S5_ARE][((size_t)j * S5G + g) * S5N + n], -1e-4f), aim = a.in[I_S5_AIM][((size_t)j * S5G + g) * S5N + n];
            const float x = are * dt * (float)k, y = aim * dt * (float)k; float sy, cy; sincosf(y, &sy, &cy); const float ex = expf(x);
            PW[idx] = (f32x2){ex * cy, ex * sy}; }
        for (int idx = F.tid; idx < 1024; idx += 512) { const int n = idx >> 4;
            const float are = fminf(a.in[I_S5_ARE][((size_t)j * S5G + g) * S5N + n], -1e-4f), aim = a.in[I_S5_AIM][((size_t)j * S5G + g) * S5N + n];
            const float x = are * dt, y = aim * dt; float sy, cy; sincosf(y, &sy, &cy); const float ex = expf(x), sh = sinf(0.5f * y);
            const float nr = expm1f(x) * cy - 2.0f * sh * sh, ni = ex * sy, den = are * are + aim * aim;
            const float cr = (nr * are + ni * aim) / den, ci = (ni * are - nr * aim) / den;
            const float br = a.in[I_S5_BRE][(((size_t)j * S5G + g) * S5N) * S5P + idx], bi = a.in[I_S5_BIM][(((size_t)j * S5G + g) * S5N) * S5P + idx];
            BBs[idx] = (f32x2){cr * br - ci * bi, cr * bi + ci * br}; }
        for (int idx = F.tid; idx < 1024; idx += 512) Cs[idx] = (f32x2){a.in[I_S5_CRE][((size_t)j * S5G + g) * S5P * S5N + idx], a.in[I_S5_CIM][((size_t)j * S5G + g) * S5P * S5N + idx]};
        __syncthreads();
        { const int lag = F.tid >> 5, p = (F.tid >> 1) & 15, qh = F.tid & 1; float kacc[8];
#pragma unroll
          for (int q = 0; q < 8; ++q) kacc[q] = 0.f;
#pragma unroll 4
          for (int n = 0; n < S5N; ++n) { const f32x2 c = Cs[p * 64 + n], w = PW[lag * 64 + n];
              const float tr = c.x * w.x - c.y * w.y, ti = c.x * w.y + c.y * w.x;
              const LAS f32x4* bq = (const LAS f32x4*)(BBs + n * 16 + qh * 8);
#pragma unroll
              for (int q2 = 0; q2 < 4; ++q2) { const f32x4 b2 = bq[q2]; kacc[2 * q2] += tr * b2[0] - ti * b2[1]; kacc[2 * q2 + 1] += tr * b2[2] - ti * b2[3]; } }
#pragma unroll
          for (int q = 0; q < 8; ++q) { float v = kacc[q]; if (lag == 0 && p == qh * 8 + q) v += a.in[I_S5_D][((size_t)j * S5G + g) * S5P + p]; Ks[(lag * 16 + p) * 16 + qh * 8 + q] = v; } }
        __syncthreads();
        bf16_t* FD = (bf16_t*)(ws + WS_S5T + S5T_FD) + (size_t)g * 16 * 512; bf16_t* WS_ = (bf16_t*)(ws + WS_S5T + S5T_WS) + (size_t)g * 128 * 256; bf16_t* WY = (bf16_t*)(ws + WS_S5T + S5T_WY) + (size_t)g * 256 * 128;
        for (int idx = F.tid; idx < 8 * 512; idx += 512) { const int d = 8 * half + (idx >> 9), l = (idx >> 3) & 63, jj = idx & 7, p = l & 15, gq = l >> 4;
            float v = 0.f; if (gq < 2) v = Ks[(d * 16 + p) * 16 + 8 * gq + jj]; else if (d >= 1) v = Ks[((d - 1) * 16 + p) * 16 + 8 * (gq - 2) + jj];
            FD[(size_t)d * 512 + (idx & 511)] = (bf16_t)f2bf(v); }
        for (int idx = F.tid; idx < 64 * 256; idx += 512) { const int R = 64 * half + (idx >> 8), k = idx & 255, n = R >> 1, c = R & 1, s_ = k >> 4, q = k & 15;
            const f32x2 w = PW[(15 - s_) * 64 + n], bq = BBs[n * 16 + q];
            const float v = c ? (w.x * bq.y + w.y * bq.x) : (w.x * bq.x - w.y * bq.y);
            WS_[(size_t)R * 256 + k] = (bf16_t)f2bf(v); }
        for (int idx = F.tid; idx < 128 * 128; idx += 512) { const int R = 128 * half + (idx >> 7), k = idx & 127, t = R >> 4, p = R & 15, n = k >> 1, c = k & 1;
            const f32x2 cc = Cs[p * 64 + n], w = PW[(t + 1) * 64 + n];
            const float v = c ? -(cc.x * w.y + cc.y * w.x) : (cc.x * w.x - cc.y * w.y);
            WY[(size_t)R * 128 + k] = (bf16_t)f2bf(v); }
        if (half == 0 && F.tid < 64) ((f32x2*)(ws + WS_S5T + S5T_A16))[g * 64 + F.tid] = PW[16 * 64 + F.tid];
    }
    __syncthreads();
}

struct CvItem { const float* src; bf16_t* dst; int ldS, ldD, nvalid, zoff; };
__device__ __forceinline__ int conv_nmix(int li) { return (li & 1) == 0 ? 3 * 2048 : (1280 + 1024 + 512 + 512 + 2048); }
__device__ __forceinline__ CvItem conv_item(const Args& a, unsigned char* ws, int li, int r) {
    const int j = li >> 1; const bool s5 = (li & 1) == 0; const int nmix = conv_nmix(li);
    CvItem I; I.nvalid = 32; I.zoff = 0;
    if (r < nmix) {
        if (s5) { const int mat = r / 2048, item = r % 2048, kb = item / 64, nb = item % 64;
            const float* W = a.in[mat == 0 ? I_S5_WIN : (mat == 1 ? I_S5_WGLU : I_S5_WOUT)] + (size_t)j * D * D;
            I.src = W + (size_t)(kb * 64) * D + nb * 32; I.ldS = D; I.dst = (bf16_t*)(ws + WS_WMIX + (size_t)mat * 8 * MiB) + (size_t)(nb * 32) * D + kb * 64; I.ldD = D; return I; }
        if (r < 1280) { const int kb = r / 40, nb = r % 40; const float* W = a.in[I_D_WIN] + (size_t)j * D * DSA_IN;
            int nv = DSA_IN - nb * 32; nv = nv < 0 ? 0 : (nv > 32 ? 32 : nv);
            I.src = W + (size_t)(kb * 64) * DSA_IN + (nv ? nb * 32 : 0); I.ldS = DSA_IN; I.nvalid = nv;        I.dst = (bf16_t*)(ws + WS_WMIX + WM_D_IN) + (size_t)(nb * 32) * D + kb * 64; I.ldD = D; return I; }
        r -= 1280;
        if (r < 1024) { const int mat = r / 512, item = r % 512, kb = item / 64, nb = item % 64;
            const float* W = a.in[mat == 0 ? I_D_WUQ : I_D_WQIDX] + (size_t)j * QL * 2048;
            I.src = W + (size_t)(kb * 64) * 2048 + nb * 32; I.ldS = 2048; I.dst = (bf16_t*)(ws + WS_WMIX + WM_D_Q) + (size_t)(mat * 2048 + nb * 32) * QL + kb * 64; I.ldD = QL; return I; }
        r -= 1024;
        if (r < 512) { const int h = r / 32, item = r % 32, kb = item / 16, nb = item % 16;
            const float* W = a.in[I_D_WUK] + ((size_t)j * NH + h) * HD * KVL;
            I.src = W + (size_t)(kb * 64) * KVL + nb * 32; I.ldS = KVL; I.dst = (bf16_t*)(ws + WS_WMIX + WM_D_UK) + (size_t)h * 512 * 128 + (size_t)(nb * 32) * 128 + kb * 64; I.ldD = 128; return I; }
        r -= 512;
        if (r < 512) { const int h = r / 32, item = r % 32, kb = item / 4, nb = item % 4, p = h >> 1, hh = h & 1;
            const float* W = a.in[I_D_WUV] + ((size_t)j * NH + h) * KVL * HD;
            I.src = W + (size_t)(kb * 64) * HD + nb * 32; I.ldS = HD; I.dst = (bf16_t*)(ws + WS_WMIX + WM_D_UV) + (size_t)p * 256 * 1024 + (size_t)(hh * 128 + nb * 32) * 1024 + hh * 512 + kb * 64; I.ldD = 1024;
            I.zoff = hh ? -512 : 512; return I; }
        r -= 512;
        { const int kb = r / 64, nb = r % 64; const float* W = a.in[I_D_WOUT] + (size_t)j * D * D;
          I.src = W + (size_t)(kb * 64) * D + nb * 32; I.ldS = D; I.dst = (bf16_t*)(ws + WS_WMIX + WM_D_OUT) + (size_t)(nb * 32) * D + kb * 64; I.ldD = D; return I; }
    }
    r -= nmix;
    if (r < 16384) { const int job = r / 128, item = r % 128, e = job >> 2, which = (job >> 1) & 1, fg = job & 1, kb = item / 4, nb = item % 4;
        const float* W = a.in[which ? I_M_WUP : I_M_WGATE] + ((size_t)li * NE + e) * D * FF;
        I.src = W + (size_t)(kb * 64) * FF + fg * 128 + nb * 32; I.ldS = FF; I.dst = (bf16_t*)(ws + WS_WMOE + WE_GU) + (size_t)e * 512 * D + (size_t)(fg * 256 + which * 128 + nb * 32) * D + kb * 64; I.ldD = D; return I; }
    r -= 16384;
    { const int e = r / 256, item = r % 256, kb = item / 64, nb = item % 64;
      const float* W = a.in[I_M_WDOWN] + ((size_t)li * NE + e) * FF * D;
      I.src = W + (size_t)(kb * 64) * D + nb * 32; I.ldS = D; I.dst = (bf16_t*)(ws + WS_WMOE + WE_DN) + (size_t)e * D * FF + (size_t)(nb * 32) * FF + kb * 64; I.ldD = FF; return I; }
}
__device__ __forceinline__ void conv_run(const Frame& F, const Args& a, int li, int r0, int r1, int first, int stride) {
    unsigned char* ws = F.ws;
    LAS float* scr = (LAS float*)(F.lds + F.wave * 16384);
    int r = r0 + first; if (r >= r1) return;
    const int lane = F.lane, nn = lane & 31, hi = lane >> 5, c = lane & 7;
    CvItem cur = conv_item(a, ws, li, r);
    float tv[32];
#define CV_LOAD(I_) do { const unsigned vo_ = ((unsigned)hi * (unsigned)(I_).ldS + (unsigned)(nn < (I_).nvalid ? nn : 0)) * 4u; const char* sb_ = (const char*)(I_).src; const size_t st2_ = (size_t)8 * (I_).ldS; \
        _Pragma("unroll") for (int i_ = 0; i_ < 32; ++i_) { tv[i_] = *(const float*)(sb_ + vo_); sb_ += st2_; } } while (0)
    CV_LOAD(cur);
    for (;;) {
        __builtin_amdgcn_sched_barrier(0);
        const bool okc = nn < cur.nvalid;
#pragma unroll
        for (int i = 0; i < 32; ++i) scr[(2 * i + hi) * 33 + nn] = okc ? tv[i] : 0.f;
        __builtin_amdgcn_sched_barrier(0);
        r += stride; const bool more = r < r1;
        CvItem nxt = cur;
        if (more) { nxt = conv_item(a, ws, li, r); CV_LOAD(nxt); }
        __builtin_amdgcn_sched_barrier(0);
        LDS_WAIT(); asm volatile("" ::: "memory");
#pragma unroll
        for (int q = 0; q < 4; ++q) { const int n = (lane >> 3) + 8 * q; const LAS float* sl = scr + (8 * c) * 33 + n;
            u32x4 o; o.x = pk2(sl[0 * 33], sl[1 * 33]); o.y = pk2(sl[2 * 33], sl[3 * 33]); o.z = pk2(sl[4 * 33], sl[5 * 33]); o.w = pk2(sl[6 * 33], sl[7 * 33]);
            *(GAS u32x4*)(cur.dst + (size_t)n * cur.ldD + 8 * c) = o;
            if (cur.zoff) { unsigned z0 = 0u; asm volatile("" : "+v"(z0)); *(GAS u32x4*)(cur.dst + cur.zoff + (size_t)n * cur.ldD + 8 * c) = (u32x4){z0, z0, z0, z0}; } }
        LDS_WAIT(); asm volatile("" ::: "memory");
        if (!more) break;
        cur = nxt;
    }
#undef CV_LOAD
}
__device__ __forceinline__ void phase_conv(const Frame& F, const Args& a, int li) {
    unsigned char* ws = F.ws;
    const int j = li >> 1; const bool s5 = (li & 1) == 0;
    if (s5) s5_tables(F, a, j);
    conv_run(F, a, li, 0, conv_nmix(li) + 24576, F.gw, F.NGW);
    if (li == 0) {
        const float* x = a.in[I_X]; bf16_t* h16 = (bf16_t*)(ws + WS_H16);
        for (int m = F.gw; m < T; m += F.NGW) {
            const f32x4* xr = (const f32x4*)(x + (size_t)m * D) + F.lane; u32x2* br = (u32x2*)(h16 + (size_t)m * D) + F.lane;
            f32x4 xv[8];
#pragma unroll
            for (int q = 0; q < 8; ++q) xv[q] = xr[64 * q];
            __builtin_amdgcn_sched_barrier(0);
#pragma unroll
            for (int q = 0; q < 8; ++q) { const f32x4 v = xv[q]; u32x2 w; w.x = pk2(v[0], v[1]); w.y = pk2(v[2], v[3]); br[64 * q] = w; }
        }
    }
    {
        const int gt = F.vcu * 512 + F.tid;
        if (gt < 48 * D) { const int n = gt / D, k = gt % D;
            const float v = n < NG ? a.in[I_M_WG][((size_t)li * D + k) * NG + n] : (n < NG + NE ? a.in[I_M_WE][((size_t)li * D + k) * NE + (n - NG)] : 0.f);
            const unsigned hi = f2bf(v); const unsigned lo = f2bf(v - bf2f(hi));
            bf16_t* RT = (bf16_t*)(ws + WS_RT); RT[gt] = (bf16_t)hi; RT[48 * D + gt] = (bf16_t)lo; }
    }
}

__device__ __forceinline__ void phase_ssm2(const Frame& F, const Args& a) {
    unsigned char* ws = F.ws;
    const bf16_t* U = (const bf16_t*)(ws + WS_S + S_U16); bf16_t* Z = (bf16_t*)(ws + WS_S + S_Z16);
    const int lane = F.lane, w = F.wave, r16 = lane & 15, gq = lane >> 4;
    constexpr int UP = 528, HP = 272;
    LAS unsigned char* Us = F.lds;
    LAS unsigned char* Hs = F.lds + 128 * UP;
    LAS unsigned char* Fs = Hs + 128 * HP;
    u32x4 uv[8], fv[2];
#define SSM_FETCH(un_) do { const int b_ = (un_) / S5G, g_ = (un_) % S5G; \
        _Pragma("unroll") for (int it = 0; it < 8; ++it) { const int idx = it * 512 + F.tid, t = idx >> 1, hf = idx & 1; uv[it] = *(const u32x4*)(U + (size_t)(b_ * SEQ + t) * D + g_ * S5P + hf * 8); } \
        _Pragma("unroll") for (int it = 0; it < 2; ++it) { const int idx = it * 512 + F.tid; fv[it] = *((const u32x4*)(ws + WS_S5T + S5T_FD + (size_t)g_ * 16384) + idx); } } while (0)
    if (F.vcu < NB * S5G) SSM_FETCH(F.vcu);
    for (int unit = F.vcu; unit < NB * S5G; unit += F.G) {
        const int b = unit / S5G, g = unit % S5G;
        __syncthreads();
        { __builtin_amdgcn_sched_barrier(0);
#pragma unroll
          for (int it = 0; it < 8; ++it) { const int idx = it * 512 + F.tid, t = idx >> 1, hf = idx & 1; *(LAS u32x4*)(Us + (t >> 4) * UP + (t & 15) * 32 + hf * 16) = uv[it]; }
#pragma unroll
          for (int it = 0; it < 2; ++it) { const int idx = it * 512 + F.tid; *(LAS u32x4*)(Fs + idx * 16) = fv[it]; } }
        const bf16_t* WSg = (const bf16_t*)(ws + WS_S5T + S5T_WS) + (size_t)g * 128 * 256; const bf16_t* WYg = (const bf16_t*)(ws + WS_S5T + S5T_WY) + (size_t)g * 256 * 128;
        bf16x8 wa[8];
#pragma unroll
        for (int ks = 0; ks < 8; ++ks) wa[ks] = *(const bf16x8*)(WSg + (size_t)(16 * w + r16) * 256 + 32 * ks + 8 * gq);
        __syncthreads();
#pragma unroll 2
        for (int nt = 0; nt < 8; ++nt) {
            f32x4 acc = {0.f, 0.f, 0.f, 0.f}; bf16x8 ub8[8];
#pragma unroll
            for (int ks = 0; ks < 8; ++ks) ub8[ks] = *(const LAS bf16x8*)(Us + (nt * 16 + r16) * UP + (2 * ks + (gq >> 1)) * 32 + (gq & 1) * 16);
            __builtin_amdgcn_sched_barrier(0);
#pragma unroll
            for (int ks = 0; ks < 8; ++ks) acc = __builtin_amdgcn_mfma_f32_16x16x32_bf16(wa[ks], ub8[ks], acc, 0, 0, 0);
            __builtin_amdgcn_sched_barrier(0);
            u32x2 o; o.x = pk2(acc[0], acc[1]); o.y = pk2(acc[2], acc[3]);
            *(LAS u32x2*)(Hs + (nt * 16 + r16) * HP + (16 * w + 4 * gq) * 2) = o;
        }
        __syncthreads();
        const int t0 = w, t1 = 15 - w;
        bf16x8 wy0[4], wy1[4];
#pragma unroll
        for (int ks = 0; ks < 4; ++ks) { wy0[ks] = *(const bf16x8*)(WYg + (size_t)(t0 * 16 + r16) * 128 + 32 * ks + 8 * gq); wy1[ks] = *(const bf16x8*)(WYg + (size_t)(t1 * 16 + r16) * 128 + 32 * ks + 8 * gq); }
        __builtin_amdgcn_sched_barrier(0);
        if (w == 0) {
            const f32x2 a16 = ((const f32x2*)(ws + WS_S5T + S5T_A16))[g * 64 + lane];
            float hr = 0.f, hi = 0.f;
#pragma unroll 1
            for (int c0 = 0; c0 < 128; c0 += 32) {
                unsigned sv[32];
#pragma unroll
                for (int c = 0; c < 32; ++c) sv[c] = *(const LAS unsigned*)(Hs + (c0 + c) * HP + lane * 4);
#pragma unroll
                for (int c = 0; c < 32; ++c) { const unsigned hp = pk2(hr, hi); const float sr = bflo(sv[c]), si = bfhi(sv[c]);
                    const float nr = a16.x * hr - a16.y * hi + sr, ni = a16.x * hi + a16.y * hr + si; hr = nr; hi = ni; sv[c] = hp; }
#pragma unroll
                for (int c = 0; c < 32; ++c) *(LAS unsigned*)(Hs + (c0 + c) * HP + lane * 4) = sv[c];
            }
        }
        __builtin_amdgcn_s_waitcnt(0x0F70);
        __builtin_amdgcn_sched_barrier(0);
        { const int un = unit + F.G < NB * S5G ? unit + F.G : unit; SSM_FETCH(un); }
        __builtin_amdgcn_sched_barrier(0);
        asm volatile("s_waitcnt lgkmcnt(0)" ::: "memory"); __builtin_amdgcn_s_barrier(); asm volatile("" ::: "memory");
        bf16x8 fa[4], fb[8];
#pragma unroll
        for (int sp = 0; sp < 4; ++sp) { const int da = t0 - 2 * sp; fa[sp] = *(const LAS bf16x8*)(Fs + (da > 0 ? da : 0) * 1024 + lane * 16); }
#pragma unroll
        for (int sp = 0; sp < 8; ++sp) { const int db = t1 - 2 * sp; fb[sp] = *(const LAS bf16x8*)(Fs + (db > 0 ? db : 0) * 1024 + lane * 16); }
#pragma unroll 1
        for (int nt = 0; nt < 8; ++nt) {
            f32x4 acc0 = {0.f, 0.f, 0.f, 0.f}, acc1 = {0.f, 0.f, 0.f, 0.f};
            bf16x8 ub8[8], hb4[4];
#pragma unroll
            for (int sp = 0; sp < 8; ++sp) ub8[sp] = *(const LAS bf16x8*)(Us + (nt * 16 + r16) * UP + (2 * sp + (gq >> 1)) * 32 + (gq & 1) * 16);
#pragma unroll
            for (int ks = 0; ks < 4; ++ks) hb4[ks] = *(const LAS bf16x8*)(Hs + (nt * 16 + r16) * HP + (32 * ks + 8 * gq) * 2);
            __builtin_amdgcn_sched_barrier(0);
#pragma unroll
            for (int ks = 0; ks < 4; ++ks) { acc0 = __builtin_amdgcn_mfma_f32_16x16x32_bf16(wy0[ks], hb4[ks], acc0, 0, 0, 0); acc1 = __builtin_amdgcn_mfma_f32_16x16x32_bf16(wy1[ks], hb4[ks], acc1, 0, 0, 0); }
#pragma unroll
            for (int sp = 0; sp < 4; ++sp) { if (2 * sp <= t0) acc0 = __builtin_amdgcn_mfma_f32_16x16x32_bf16(fa[sp], ub8[sp], acc0, 0, 0, 0); }
#pragma unroll
            for (int sp = 0; sp < 8; ++sp) { if (2 * sp <= t1) acc1 = __builtin_amdgcn_mfma_f32_16x16x32_bf16(fb[sp], ub8[sp], acc1, 0, 0, 0); }
            __builtin_amdgcn_sched_barrier(0);
            float z0[4], z1[4];
#pragma unroll
            for (int jj = 0; jj < 4; ++jj) { const float y0 = acc0[jj], y1 = acc1[jj];
                z0[jj] = y0 / (1.0f + __expf(-1.5957691216057308f * (y0 + 0.044715f * y0 * y0 * y0)));
                z1[jj] = y1 / (1.0f + __expf(-1.5957691216057308f * (y1 + 0.044715f * y1 * y1 * y1))); }
            const size_t rowb = (size_t)b * SEQ + 16 * (nt * 16 + r16);
            u32x2 o0, o1; o0.x = pk2(z0[0], z0[1]); o0.y = pk2(z0[2], z0[3]); o1.x = pk2(z1[0], z1[1]); o1.y = pk2(z1[2], z1[3]);
            *(u32x2*)(Z + (rowb + t0) * D + g * S5P + 4 * gq) = o0; *(u32x2*)(Z + (rowb + t1) * D + g * S5P + 4 * gq) = o1;
        }
    }
}

#undef SSM_FETCH
template <int MODE>
__device__ __forceinline__ void phase_ln(const Frame& F, const Args& a, int li, int m0, int mstep, int mend) {
    unsigned char* ws = F.ws;
    bf16_t* H16 = (bf16_t*)(ws + WS_H16);
    const float* gam = a.in[MODE == 0 ? I_LNM_G : I_LNF_G] + (size_t)li * D; const float* bet = a.in[MODE == 0 ? I_LNM_B : I_LNF_B] + (size_t)li * D;
    const bf16_t* Y0 = (const bf16_t*)(ws + WS_S + S_Y0); const bf16_t* Y1 = (const bf16_t*)(ws + WS_S + S_Y1);
    const int lane = F.lane;
    const bool last = (MODE == 1) && (li == DEPTH - 1);
    for (int m = m0; m < mend; m += mstep) {
        float v[4][8];
        const u32x4* xr = (const u32x4*)(H16 + (size_t)m * D) + lane;
#pragma unroll
        for (int q = 0; q < 4; ++q) { const u32x4 p = xr[64 * q]; v[q][0] = bflo(p.x); v[q][1] = bfhi(p.x); v[q][2] = bflo(p.y); v[q][3] = bfhi(p.y); v[q][4] = bflo(p.z); v[q][5] = bfhi(p.z); v[q][6] = bflo(p.w); v[q][7] = bfhi(p.w); }
        if (MODE == 1) {
            const u32x2* y0 = (const u32x2*)((const unsigned char*)Y0 + (size_t)m * D) + lane; const u32x2* y1 = (const u32x2*)((const unsigned char*)Y1 + (size_t)m * D) + lane;
            u32x2 pa[4], pb[4];
#pragma unroll
            for (int q = 0; q < 4; ++q) { pa[q] = y0[64 * q]; pb[q] = y1[64 * q]; }
            __builtin_amdgcn_sched_barrier(0);
#pragma unroll
            for (int q = 0; q < 4; ++q) {
                const f32x2 a0 = __builtin_amdgcn_cvt_pk_f32_fp8((int)pa[q].x, false), a1 = __builtin_amdgcn_cvt_pk_f32_fp8((int)pa[q].x, true), a2 = __builtin_amdgcn_cvt_pk_f32_fp8((int)pa[q].y, false), a3 = __builtin_amdgcn_cvt_pk_f32_fp8((int)pa[q].y, true);
                const f32x2 b0 = __builtin_amdgcn_cvt_pk_f32_fp8((int)pb[q].x, false), b1 = __builtin_amdgcn_cvt_pk_f32_fp8((int)pb[q].x, true), b2 = __builtin_amdgcn_cvt_pk_f32_fp8((int)pb[q].y, false), b3 = __builtin_amdgcn_cvt_pk_f32_fp8((int)pb[q].y, true);
                v[q][0] = v[q][0] * DN_ALPHA + (a0[0] + b0[0]) * 0.0625f; v[q][1] = v[q][1] * DN_ALPHA + (a0[1] + b0[1]) * 0.0625f;
                v[q][2] = v[q][2] * DN_ALPHA + (a1[0] + b1[0]) * 0.0625f; v[q][3] = v[q][3] * DN_ALPHA + (a1[1] + b1[1]) * 0.0625f;
                v[q][4] = v[q][4] * DN_ALPHA + (a2[0] + b2[0]) * 0.0625f; v[q][5] = v[q][5] * DN_ALPHA + (a2[1] + b2[1]) * 0.0625f;
                v[q][6] = v[q][6] * DN_ALPHA + (a3[0] + b3[0]) * 0.0625f; v[q][7] = v[q][7] * DN_ALPHA + (a3[1] + b3[1]) * 0.0625f; }
        }
        float s = 0.f;
#pragma unroll
        for (int q = 0; q < 4; ++q)
#pragma unroll
            for (int e = 0; e < 8; ++e) s += v[q][e];
        const float mean = wave_sum(s, lane) * (1.0f / D); float s2 = 0.f;
#pragma unroll
        for (int q = 0; q < 4; ++q)
#pragma unroll
            for (int e = 0; e < 8; ++e) { v[q][e] -= mean; s2 += v[q][e] * v[q][e]; }
        const float rstd = 1.0f / sqrtf(wave_sum(s2, lane) * (1.0f / D) + LN_EPS);
#pragma unroll
        for (int q = 0; q < 4; ++q) { const f32x4 g0 = *((const f32x4*)gam + 2 * (lane + 64 * q)), g1 = *((const f32x4*)gam + 2 * (lane + 64 * q) + 1), b0 = *((const f32x4*)bet + 2 * (lane + 64 * q)), b1 = *((const f32x4*)bet + 2 * (lane + 64 * q) + 1);
#pragma unroll
            for (int e = 0; e < 4; ++e) { v[q][e] = v[q][e] * rstd * g0[e] + b0[e]; v[q][4 + e] = v[q][4 + e] * rstd * g1[e] + b1[e]; } }
        if (last) {
            f32x4* o = (f32x4*)(a.out + (size_t)m * D) + 2 * lane;
#pragma unroll
            for (int q = 0; q < 4; ++q) { o[128 * q] = (f32x4){v[q][0], v[q][1], v[q][2], v[q][3]}; o[128 * q + 1] = (f32x4){v[q][4], v[q][5], v[q][6], v[q][7]}; }
        } else {
            u32x4* ob = (u32x4*)(H16 + (size_t)m * D) + lane;
#pragma unroll
            for (int q = 0; q < 4; ++q) { u32x4 w; w.x = pk2(v[q][0], v[q][1]); w.y = pk2(v[q][2], v[q][3]); w.z = pk2(v[q][4], v[q][5]); w.w = pk2(v[q][6], v[q][7]); ob[64 * q] = w;
 }
        }
    }
}

__device__ __forceinline__ void phase_router(const Frame& F, const Args& a, int li) {
    unsigned char* ws = F.ws;
    const bf16_t* XH = (const bf16_t*)(ws + WS_H16);
    const bf16_t* WH = (const bf16_t*)(ws + WS_RT);
    const int lane = F.lane, r16 = lane & 15, g = lane >> 4, wq = F.wave & 3, kh = F.wave >> 2;
    LAS float* lb = (LAS float*)(F.lds + F.wave * 4096);
    const LAS float* lbp = (const LAS float*)(F.lds + (F.wave ^ 4) * 4096);
    for (int t0 = 0; t0 < T / 16; t0 += F.G * 4) {
        { const int rb = (t0 + F.vcu * 4) * 16 + F.wave * 8; const int re = rb + 8 < T ? rb + 8 : T; phase_ln<0>(F, a, li, rb, 1, re); }
        asm volatile("s_waitcnt vmcnt(0)" ::: "memory"); __syncthreads();
        const int tile = t0 + F.vcu * 4 + wq; const bool act = tile < T / 16;
        f32x4 acc[3];
#pragma unroll
        for (int n = 0; n < 3; ++n) acc[n] = (f32x4){0.f, 0.f, 0.f, 0.f};
        if (act) {
            const bf16_t* xh = XH + ((size_t)tile * 16 + r16) * D + 8 * g + kh * (D / 2);
            const bf16_t* wh = WH + (size_t)r16 * D + 8 * g + kh * (D / 2);
            bf16x8 ah[2][4], bh[2][4][3];
#define RT_LOAD(buf, s0) do { _Pragma("unroll") for (int u_ = 0; u_ < 4; ++u_) { ah[buf][u_] = *(const bf16x8*)(xh + 32 * ((s0) + u_)); \
                _Pragma("unroll") for (int n_ = 0; n_ < 3; ++n_) bh[buf][u_][n_] = *(const bf16x8*)(wh + (size_t)(n_ * 16) * D + 32 * ((s0) + u_)); } } while (0)
#define RT_MMA(buf) do { _Pragma("unroll") for (int u_ = 0; u_ < 4; ++u_) _Pragma("unroll") for (int n_ = 0; n_ < 3; ++n_) acc[n_] = __builtin_amdgcn_mfma_f32_16x16x32_bf16(ah[buf][u_], bh[buf][u_][n_], acc[n_], 0, 0, 0); } while (0)
            RT_LOAD(0, 0);
#pragma unroll 1
            for (int s0 = 0; s0 < D / 64; s0 += 8) {
                __builtin_amdgcn_sched_barrier(0);
                RT_LOAD(1, s0 + 4);
                __builtin_amdgcn_sched_barrier(0);
                RT_MMA(0);
                __builtin_amdgcn_sched_barrier(0);
                if (s0 + 8 < D / 64) RT_LOAD(0, s0 + 8);
                __builtin_amdgcn_sched_barrier(0);
                RT_MMA(1);
            }
#undef RT_LOAD
#undef RT_MMA
        }
#pragma unroll
        for (int n = 0; n < 3; ++n)
#pragma unroll
            for (int j = 0; j < 4; ++j) lb[(4 * g + j) * 52 + n * 16 + r16] = acc[n][j];
        __syncthreads();
        LAS unsigned* bc = (LAS unsigned*)(F.lds + 8 * 4096);
        if (F.tid < 64) bc[F.tid] = 0u;
        __syncthreads();
        int e1 = 0, e2 = 0; float w1 = 0.f, w2 = 0.f; unsigned l1 = 0u, l2 = 0u; const bool dec = act && kh == 0 && lane < 16;
        if (dec) {
            const LAS float* L = lb + lane * 52; const LAS float* L2 = lbp + lane * 52;
            float lg[NG];
#pragma unroll
            for (int q = 0; q < NG; ++q) lg[q] = L[q] + L2[q] + a.in[I_M_BG][li * NG + q];
            int gi = 0; float gm = lg[0];
#pragma unroll
            for (int q = 1; q < NG; ++q) if (lg[q] > gm) { gm = lg[q]; gi = q; }
            float gs = 0.f;
#pragma unroll
            for (int q = 0; q < NG; ++q) gs += __expf(lg[q] - gm);
            const float gp = 1.0f / gs;
            float el[EPG];
#pragma unroll
            for (int i = 0; i < EPG; ++i) el[i] = L[NG + gi * EPG + i] + L2[NG + gi * EPG + i] + a.in[I_M_BE][li * NE + gi * EPG + i];
            int i1 = 0; float m1 = el[0];
#pragma unroll
            for (int i = 1; i < EPG; ++i) if (el[i] > m1) { m1 = el[i]; i1 = i; }
            int i2 = -1; float m2 = -3.0e38f; asm volatile("" : "+v"(m2));
#pragma unroll
            for (int i = 0; i < EPG; ++i) if (i != i1 && el[i] > m2) { m2 = el[i]; i2 = i; }
            w1 = gp / (1.0f + __expf(m2 - m1)); w2 = gp / (1.0f + __expf(m1 - m2));
            e1 = gi * EPG + i1; e2 = gi * EPG + i2;
            l1 = __hip_atomic_fetch_add(bc + e1, 1u, __ATOMIC_RELAXED, __HIP_MEMORY_SCOPE_WORKGROUP);
            l2 = __hip_atomic_fetch_add(bc + e2, 1u, __ATOMIC_RELAXED, __HIP_MEMORY_SCOPE_WORKGROUP);
        }
        __syncthreads();
        if (F.tid < NE) { const unsigned n = bc[F.tid]; bc[32 + F.tid] = n ? __hip_atomic_fetch_add(F.ctl + CW_CNT + (li * NE + F.tid) * 64, n, RLX_AGENT) : 0u; }
        __syncthreads();
        if (dec) {
            const int m = tile * 16 + lane;
            unsigned* LIST = (unsigned*)(ws + WS_LIST); float* GWL = (float*)(ws + WS_GWL);
            const unsigned s1 = bc[32 + e1] + l1, s2_ = bc[32 + e2] + l2;
            LIST[(size_t)e1 * T + s1] = (unsigned)m; GWL[(size_t)e1 * T + s1] = w1;
            LIST[(size_t)e2 * T + s2_] = (unsigned)m | 0x80000000u; GWL[(size_t)e2 * T + s2_] = w2;
        }
        __syncthreads();
    }
}

__device__ __forceinline__ void moe_table(const Frame& F, int li) {
    LAS int* tab = (LAS int*)(F.lds + MOETAB_OFF);
    __syncthreads();
    if (F.tid < 64) {
        const int e = F.lane; const int c = (e < NE) ? (int)__hip_atomic_load(F.ctl + CW_CNT + (li * NE + e) * 64, RLX_AGENT) : 0; const int nt = (c + 255) >> 8;
        int incl = nt;
#pragma unroll
        for (int o = 1; o < 32; o <<= 1) { const int v = __builtin_amdgcn_ds_bpermute(((e - o) & 63) << 2, incl); if (e >= o) incl += v; }
        const int excl = incl - nt;
        if (e < NE) { tab[1 + e] = excl * 256; tab[34 + e] = c;
#pragma nounroll
            for (int k = 0; k < nt; ++k) ((LAS unsigned char*)(tab + 66))[excl + k] = (unsigned char)e; }
        if (e == NE - 1) { tab[33] = incl * 256; tab[0] = incl; }
    }
    __syncthreads();
}
__device__ __forceinline__ void phase_rms(const Frame& F, const Args& a, int j) {
    unsigned char* ws = F.ws;
    const int lane = F.lane;
    for (int it0 = F.gw * 4; it0 < 2 * T; it0 += F.NGW * 4) {
        u32x4 w[4]; bf16_t* X[4]; const float* gn[4];
#pragma unroll
        for (int r = 0; r < 4; ++r) { const int it = it0 + r; const int which = it >= T, m = it - which * T;
            X[r] = (bf16_t*)(ws + (which ? WS_CKV : WS_CQ)) + (size_t)m * 512; gn[r] = a.in[which ? I_D_KVN : I_D_QN] + (size_t)j * 512;
            w[r] = *((const u32x4*)X[r] + lane); }
#pragma unroll
        for (int r = 0; r < 4; ++r) {
            float x[8] = {bflo(w[r].x), bfhi(w[r].x), bflo(w[r].y), bfhi(w[r].y), bflo(w[r].z), bfhi(w[r].z), bflo(w[r].w), bfhi(w[r].w)};
            float s = 0.f;
#pragma unroll
            for (int q = 0; q < 8; ++q) s += x[q] * x[q];
            const float rs = 1.0f / sqrtf(wave_sum(s, lane) * (1.0f / 512.0f) + RMS_EPS);
            const f32x4 g0 = *((const f32x4*)gn[r] + 2 * lane), g1 = *((const f32x4*)gn[r] + 2 * lane + 1);
            u32x4 o; o.x = pk2(x[0] * rs * g0[0], x[1] * rs * g0[1]); o.y = pk2(x[2] * rs * g0[2], x[3] * rs * g0[3]);
            o.z = pk2(x[4] * rs * g1[0], x[5] * rs * g1[1]); o.w = pk2(x[6] * rs * g1[2], x[7] * rs * g1[3]);
            *((u32x4*)X[r] + lane) = o;
        }
    }
}

__device__ __forceinline__ void phase_topk(const Frame& F, const Args& a) {
    unsigned char* ws = F.ws;
    const float* IDX = (const float*)(ws + WS_S + S_INDEX); unsigned short* SEL = (unsigned short*)(ws + WS_SEL);
    const int lane = F.lane;
    LAS unsigned* hist = (LAS unsigned*)(F.lds + F.wave * 2048);
    LAS unsigned short* sl = (LAS unsigned short*)(F.lds + F.wave * 2048 + 1024);
    for (int i0 = 0; i0 * F.NGW < T; ++i0) {
        const int m = i0 * F.NGW + (F.gw + i0 * 257) % F.NGW; if (m >= T) continue;
        const int t = m % SEQ; unsigned short* sel = SEL + (size_t)m * TOPK;
        if (t < TOPK) { for (int k = lane; k <= t; k += 64) sel[k] = (unsigned short)k; continue; }
        unsigned key[32];
        const float* row = IDX + (size_t)m * SEQ;
        const int nreg = t >> 6;
#pragma unroll
        for (int i = 0; i < 32; ++i) { const int s = i * 64 + lane; key[i] = (s <= t) ? __builtin_bit_cast(unsigned, row[s]) : 0x7fffffffu; }
        __builtin_amdgcn_sched_barrier(0);
#pragma unroll
        for (int i = 0; i < 32; ++i) { const unsigned u = key[i]; key[i] = (u == 0x7fffffffu) ? 0u : ((u & 0x80000000u) ? ~u : (u | 0x80000000u)); }
        unsigned prefix = 0u; int need = TOPK;
#pragma unroll 1
        for (int shift = 24; shift >= 0; shift -= 8) {
            { unsigned z_ = 0u; asm volatile("" : "+v"(z_)); *(LAS u32x4*)(hist + 4 * lane) = (u32x4){z_, z_, z_, z_}; }
            const unsigned himask = shift == 24 ? 0u : (0xffffffffu << (shift + 8));
#pragma unroll
            for (int q8 = 0; q8 < 4; ++q8) if (q8 * 8 <= nreg) {
#pragma unroll
              for (int i8 = 0; i8 < 8; ++i8) { const unsigned k_ = key[q8 * 8 + i8]; const bool c_ = ((k_ & himask) == prefix) && (k_ != 0u);
                __hip_atomic_fetch_add(hist + (c_ ? ((k_ >> shift) & 255u) : 384u + (unsigned)lane), 1u, __ATOMIC_RELAXED, __HIP_MEMORY_SCOPE_WORKGROUP); } }
            LDS_WAIT(); asm volatile("" ::: "memory");
            const u32x4 h4 = *(const LAS u32x4*)(hist + 4 * lane);
            const int sl = (int)(h4.x + h4.y + h4.z + h4.w);
            int S = sl;
            S += __builtin_amdgcn_update_dpp(0, S, 0x101, 0xf, 0xf, true);
            S += __builtin_amdgcn_update_dpp(0, S, 0x102, 0xf, 0xf, true);
            S += __builtin_amdgcn_update_dpp(0, S, 0x104, 0xf, 0xf, true);
            S += __builtin_amdgcn_update_dpp(0, S, 0x108, 0xf, 0xf, true);
            { const int r1 = __builtin_amdgcn_readlane(S, 16), r2 = __builtin_amdgcn_readlane(S, 32), r3 = __builtin_amdgcn_readlane(S, 48);
              S += (lane < 16 ? r1 : 0) + (lane < 32 ? r2 : 0) + (lane < 48 ? r3 : 0); }
            const unsigned long long mk = __ballot(S >= need);
            const int Ls = 63 - __builtin_clzll(mk);
            const int above = S - sl;
            int bsel = 0, cab = above;
            { const int c3 = above + (int)h4.w, c2 = c3 + (int)h4.z, c1 = c2 + (int)h4.y;
              if (c3 >= need) { bsel = 3; cab = above; } else if (c2 >= need) { bsel = 2; cab = c3; } else if (c1 >= need) { bsel = 1; cab = c2; } else { bsel = 0; cab = c1; } }
            const int Bs = __builtin_amdgcn_readlane(bsel, Ls), Ca = __builtin_amdgcn_readlane(cab, Ls);
            const int hsel = bsel == 3 ? (int)h4.w : (bsel == 2 ? (int)h4.z : (bsel == 1 ? (int)h4.y : (int)h4.x));
            const int Hb = __builtin_amdgcn_readlane(hsel, Ls);
            prefix |= (unsigned)(4 * Ls + Bs) << shift; need -= Ca;
            LDS_WAIT(); asm volatile("" ::: "memory");
            if (shift > 0 && Hb == need && prefix != 0u) { prefix -= 1u; need = 0; break; }
        }
        const unsigned thr = prefix;
        int base = 0;
        const unsigned long long lt = (1ull << lane) - 1ull;
#pragma unroll
        for (int i = 0; i < 32; ++i) if (i <= nreg) { const bool p = key[i] > thr; const unsigned long long mk = __ballot(p);
            if (p) sl[base + __popcll(mk & lt)] = (unsigned short)(i * 64 + lane);
            base += __popcll(mk); }
        int taken = 0;
        if (need > 0) {
#pragma unroll
        for (int i = 0; i < 32; ++i) if (i <= nreg) { const bool p = key[i] == thr; const unsigned long long mk = __ballot(p);
            const int pos = taken + __popcll(mk & lt);
            if (p && pos < need) sl[base + pos] = (unsigned short)(i * 64 + lane);
            taken += __popcll(mk); }
        }
        LDS_WAIT(); asm volatile("" ::: "memory");
        if (lane < 32) *((u32x4*)sel + lane) = *((const LAS u32x4*)sl + lane);
        LDS_WAIT(); asm volatile("" ::: "memory");
    }
}

__device__ __forceinline__ int rel_bucket(int n) {
    if (n < 16) return n;
    int b = 16;
    b += (n >= 19); b += (n >= 21); b += (n >= 24); b += (n >= 27); b += (n >= 31); b += (n >= 35); b += (n >= 40); b += (n >= 46);
    b += (n >= 52); b += (n >= 59); b += (n >= 67); b += (n >= 77); b += (n >= 87); b += (n >= 99); b += (n >= 113);
    return b;
}

typedef short s16x4 __attribute__((ext_vector_type(4)));
typedef unsigned short u16x4 __attribute__((ext_vector_type(4)));

__device__ __forceinline__ void phase_indexer2(const Frame& F, const Args& a) {
    unsigned char* ws = F.ws;
    const bf16_t* QI = (const bf16_t*)(ws + WS_S + S_QIDX); const bf16_t* KI = (const bf16_t*)(ws + WS_KIDX); const float* WI = (const float*)(ws + WS_WIDX);
    float* IDX = (float*)(ws + WS_S + S_INDEX);
    const int lane = F.lane, w = F.wave, r16 = lane & 15, g = lane >> 4;
    const float idx_scale = 0.08838834764831845f;
    const int nunits = NB * (SEQ / 16);
    for (int i = 0; i * F.G + F.vcu < nunits; ++i) {
        const int u = i * F.G + F.vcu; const int b = u / (SEQ / 16); int tq = u % (SEQ / 16); if (i & 1) tq = (SEQ / 16 - 1) - tq;
        const size_t row0 = (size_t)b * SEQ + tq * 16;
        __syncthreads();
        { bf16x8 qv[8];
#pragma unroll
          for (int k = 0; k < 8; ++k) { const int f = w * 8 + k, h = f >> 2, ks = f & 3; qv[k] = *(const bf16x8*)(QI + (row0 + r16) * 2048 + h * 128 + 32 * ks + 8 * g); }
          __builtin_amdgcn_sched_barrier(0);
#pragma unroll
          for (int k = 0; k < 8; ++k) *(LAS bf16x8*)(F.lds + (w * 8 + k) * 1024 + lane * 16) = qv[k]; }
        float wq[16];
#pragma unroll
        for (int h4 = 0; h4 < 4; ++h4) { const f32x4 t4 = *(const f32x4*)(WI + (row0 + r16) * 16 + h4 * 4); wq[h4 * 4] = t4[0]; wq[h4 * 4 + 1] = t4[1]; wq[h4 * 4 + 2] = t4[2]; wq[h4 * 4 + 3] = t4[3]; }
        __syncthreads();
        const int npair = (tq >> 1) + 1;
        for (int kp = w; kp < npair; kp += 8) {
            bf16x8 ka[2][4];
#pragma unroll
            for (int t2 = 0; t2 < 2; ++t2)
#pragma unroll
                for (int ks = 0; ks < 4; ++ks) ka[t2][ks] = *(const bf16x8*)(KI + ((size_t)b * SEQ + kp * 32 + t2 * 16 + r16) * 128 + 32 * ks + 8 * g);
            f32x4 acc0 = {0.f, 0.f, 0.f, 0.f}, acc1 = {0.f, 0.f, 0.f, 0.f};
            bf16x8 qb[2][4];
#pragma unroll
            for (int ks = 0; ks < 4; ++ks) qb[0][ks] = *(const LAS bf16x8*)(F.lds + ks * 1024 + lane * 16);
#pragma unroll
            for (int h = 0; h < 16; ++h) {
                __builtin_amdgcn_sched_barrier(0);
                if (h + 1 < 16) {
#pragma unroll
                    for (int ks = 0; ks < 4; ++ks) qb[(h + 1) & 1][ks] = *(const LAS bf16x8*)(F.lds + ((h + 1) * 4 + ks) * 1024 + lane * 16); }
                __builtin_amdgcn_sched_barrier(0);
                f32x4 c0 = {0.f, 0.f, 0.f, 0.f}, c1 = {0.f, 0.f, 0.f, 0.f};
#pragma unroll
                for (int ks = 0; ks < 4; ++ks) { c0 = __builtin_amdgcn_mfma_f32_16x16x32_bf16(ka[0][ks], qb[h & 1][ks], c0, 0, 0, 0); c1 = __builtin_amdgcn_mfma_f32_16x16x32_bf16(ka[1][ks], qb[h & 1][ks], c1, 0, 0, 0); }
                const float wh = wq[h];
#pragma unroll
                for (int j = 0; j < 4; ++j) { acc0[j] += wh * fmaxf(c0[j], 0.f); acc1[j] += wh * fmaxf(c1[j], 0.f); }
            }
            float* op = IDX + (row0 + r16) * SEQ + kp * 32 + 4 * g;
            *(f32x4*)op = acc0 * idx_scale; *(f32x4*)(op + 16) = acc1 * idx_scale;
        }
    }
}


typedef short bf16x4 __attribute__((ext_vector_type(4)));
__device__ __forceinline__ void phase_attn5(const Frame& F, const Args& a, int j) {
    unsigned char* ws = F.ws;
    const bf16_t* QLT = (const bf16_t*)(ws + WS_S + S_QLAT); const bf16_t* KV = (const bf16_t*)(ws + WS_CKV);
    const unsigned short* SEL = (const unsigned short*)(ws + WS_SEL); bf16_t* OL = (bf16_t*)(ws + WS_S + S_OLAT);
    const float* RB = a.in[I_RELB];
    const int lane = F.lane, w = F.wave;
    constexpr int KROW = 1056, WBUF = 16 * KROW;
    LAS unsigned char* const L0 = F.lds;
    LAS unsigned char* const kvs = L0 + w * WBUF;
    LAS float* const rbs = (LAS float*)(L0 + 8 * WBUF);
    LAS unsigned char* const btab = (LAS unsigned char*)(rbs + 512);
    LAS float* const bmax = (LAS float*)(btab + 2048);
    LAS float* const gmx = bmax + 16;
    const float att_scale = 0.08838834764831845f;
    __syncthreads();
    rbs[F.tid] = RB[F.tid];
#pragma unroll
    for (int q = 0; q < 4; ++q) btab[F.tid * 4 + q] = (unsigned char)rel_bucket(F.tid * 4 + q);
    { const float gv = wave_max(fabsf(a.in[I_D_KVN][(size_t)j * KVL + F.tid]), lane); if (lane == 0) gmx[w] = gv; }
    __syncthreads();
    if (F.tid < 16) { float mx = rbs[F.tid];
#pragma unroll
        for (int bk = 1; bk < 32; ++bk) mx = fmaxf(mx, rbs[bk * 16 + F.tid]);
        bmax[F.tid] = mx; }
    __syncthreads();
    const bool affine = (F.G % 8 == 0) && (SEQ % (F.G / 8) == 0);
    const int per = affine ? F.G / 8 : 1;
    const int nit = affine ? SEQ / per : (T - F.vcu + F.G - 1) / F.G;
#pragma unroll 1
    for (int it = w; it < nit; it += 8) {
        int ln_ = lane; asm volatile("" : "+v"(ln_));
        const int r16 = ln_ & 15, gq = ln_ >> 4;
        const unsigned alo = (unsigned)(size_t)(kvs + (4 * gq + (r16 >> 2)) * KROW + (4 * (ln_ & 3)) * 2);
        const int m = affine ? (F.vcu / per) * SEQ + (F.vcu % per) + per * it : F.vcu + it * F.G;
        const int t = m & (SEQ - 1), nk = t + 1 < TOPK ? t + 1 : TOPK, nch = (nk + 15) >> 4;
        const char* kvb = (const char*)KV + (size_t)(m / SEQ) * SEQ * (KVL * 2);
        const unsigned short* sel = SEL + (size_t)m * TOPK;
        bf16x8 qf[16]; float ss = 0.f;
#pragma unroll
        for (int hq = 0; hq < 2; ++hq) { u32x2 q8[8];
#pragma unroll
          for (int s = 0; s < 8; ++s) q8[s] = *(const u32x2*)((const unsigned char*)QLT + ((size_t)m * NH + r16) * KVL + 32 * (8 * hq + s) + 8 * gq);
          __builtin_amdgcn_sched_barrier(0);
#pragma unroll
          for (int s = 0; s < 8; ++s) { const f32x2 a0 = __builtin_amdgcn_cvt_pk_f32_fp8((int)q8[s].x, false), a1 = __builtin_amdgcn_cvt_pk_f32_fp8((int)q8[s].x, true), a2 = __builtin_amdgcn_cvt_pk_f32_fp8((int)q8[s].y, false), a3 = __builtin_amdgcn_cvt_pk_f32_fp8((int)q8[s].y, true);
              ss += (a0[0] * a0[0] + a0[1] * a0[1]) + (a1[0] * a1[0] + a1[1] * a1[1]) + (a2[0] * a2[0] + a2[1] * a2[1]) + (a3[0] * a3[0] + a3[1] * a3[1]);
              u32x4 pk; pk.x = pk2(a0[0], a0[1]); pk.y = pk2(a1[0], a1[1]); pk.z = pk2(a2[0], a2[1]); pk.w = pk2(a3[0], a3[1]); qf[8 * hq + s] = __builtin_bit_cast(bf16x8, pk); }
          __builtin_amdgcn_sched_barrier(0); }
        ss *= (1.0f / 256.0f);
        ss += shx(ss, 16, lane); ss += shx(ss, 32, lane);
        float kvn = gmx[0];
#pragma unroll
        for (int q = 1; q < 8; ++q) kvn = fmaxf(kvn, gmx[q]);
        kvn *= 22.62741699796952f * 1.01f;
        const float Mref = fminf(sqrtf(ss) * kvn * att_scale, 60.0f) + bmax[r16];
        f32x4 oacc[32];
#pragma unroll
        for (int dt = 0; dt < 32; ++dt) oacc[dt] = (f32x4){0.f, 0.f, 0.f, 0.f};
        float Lw = 0.f;
        int selv = (r16 < nk) ? (int)sel[r16] : 0;
        u16x4 s4 = *(const u16x4*)(sel + 4 * gq);
#pragma unroll 1
        for (int c = 0; c < nch; ++c) {
            const int kn = (c + 1) * 16 + r16; int selvn = 0; u16x4 s4n = s4;
            if (c + 1 < nch) { selvn = (kn < nk) ? (int)sel[kn] : 0; s4n = *(const u16x4*)(sel + (c + 1) * 16 + 4 * gq); }
#pragma unroll
            for (int i = 0; i < 16; ++i) { const unsigned off = ((unsigned)__builtin_amdgcn_readlane(selv, i) << 10) + (unsigned)lane * 16u;
                __builtin_amdgcn_global_load_lds((const unsigned*)(kvb + off), (LAS unsigned*)(kvs + i * KROW), 16, 0, 0); }
            asm volatile("s_waitcnt vmcnt(0)" ::: "memory");
            f32x4 st0 = {0.f, 0.f, 0.f, 0.f}, st1 = {0.f, 0.f, 0.f, 0.f};
#pragma unroll
            for (int sg = 0; sg < 4; ++sg) { bf16x8 a4[4];
#pragma unroll
                for (int u = 0; u < 4; ++u) a4[u] = *(const LAS bf16x8*)(kvs + r16 * KROW + 64 * (4 * sg + u) + 16 * gq);
                __builtin_amdgcn_sched_barrier(0);
                st0 = __builtin_amdgcn_mfma_f32_16x16x32_bf16(a4[0], qf[4 * sg], st0, 0, 0, 0); st1 = __builtin_amdgcn_mfma_f32_16x16x32_bf16(a4[1], qf[4 * sg + 1], st1, 0, 0, 0);
                st0 = __builtin_amdgcn_mfma_f32_16x16x32_bf16(a4[2], qf[4 * sg + 2], st0, 0, 0, 0); st1 = __builtin_amdgcn_mfma_f32_16x16x32_bf16(a4[3], qf[4 * sg + 3], st1, 0, 0, 0);
                __builtin_amdgcn_sched_barrier(0); }
            const f32x4 st = st0 + st1;
            float p[4]; bool vv[4]; int bk[4]; float bb[4];
#pragma unroll
            for (int e = 0; e < 4; ++e) { vv[e] = (c * 16 + 4 * gq + e) < nk; const int d = vv[e] ? t - (int)s4[e] : 0; bk[e] = (int)btab[d]; }
            __builtin_amdgcn_sched_barrier(0);
#pragma unroll
            for (int e = 0; e < 4; ++e) bb[e] = rbs[bk[e] * NH + r16];
            __builtin_amdgcn_sched_barrier(0);
#pragma unroll
            for (int e = 0; e < 4; ++e) { const float pe = __expf(st[e] * (att_scale * 0.0625f) + bb[e] - Mref); p[e] = vv[e] ? pe : 0.f; }
            Lw += (p[0] + p[1]) + (p[2] + p[3]);
            u32x2 pw; pw.x = pk2(p[0], p[1]); pw.y = pk2(p[2], p[3]);
            const bf16x4 pf = __builtin_bit_cast(bf16x4, pw);
#pragma unroll
            for (int q8 = 0; q8 < 4; ++q8) {
                bf16x4 ka[8];
                if (q8 == 0) asm volatile("ds_read_b64_tr_b16 %0, %8\n\tds_read_b64_tr_b16 %1, %8 offset:32\n\tds_read_b64_tr_b16 %2, %8 offset:64\n\tds_read_b64_tr_b16 %3, %8 offset:96\n\tds_read_b64_tr_b16 %4, %8 offset:128\n\tds_read_b64_tr_b16 %5, %8 offset:160\n\tds_read_b64_tr_b16 %6, %8 offset:192\n\tds_read_b64_tr_b16 %7, %8 offset:224\n\ts_waitcnt lgkmcnt(0)"
                    : "=&v"(ka[0]), "=&v"(ka[1]), "=&v"(ka[2]), "=&v"(ka[3]), "=&v"(ka[4]), "=&v"(ka[5]), "=&v"(ka[6]), "=&v"(ka[7]) : "v"(alo) : "memory");
                if (q8 == 1) asm volatile("ds_read_b64_tr_b16 %0, %8 offset:256\n\tds_read_b64_tr_b16 %1, %8 offset:288\n\tds_read_b64_tr_b16 %2, %8 offset:320\n\tds_read_b64_tr_b16 %3, %8 offset:352\n\tds_read_b64_tr_b16 %4, %8 offset:384\n\tds_read_b64_tr_b16 %5, %8 offset:416\n\tds_read_b64_tr_b16 %6, %8 offset:448\n\tds_read_b64_tr_b16 %7, %8 offset:480\n\ts_waitcnt lgkmcnt(0)"
                    : "=&v"(ka[0]), "=&v"(ka[1]), "=&v"(ka[2]), "=&v"(ka[3]), "=&v"(ka[4]), "=&v"(ka[5]), "=&v"(ka[6]), "=&v"(ka[7]) : "v"(alo) : "memory");
                if (q8 == 2) asm volatile("ds_read_b64_tr_b16 %0, %8 offset:512\n\tds_read_b64_tr_b16 %1, %8 offset:544\n\tds_read_b64_tr_b16 %2, %8 offset:576\n\tds_read_b64_tr_b16 %3, %8 offset:608\n\tds_read_b64_tr_b16 %4, %8 offset:640\n\tds_read_b64_tr_b16 %5, %8 offset:672\n\tds_read_b64_tr_b16 %6, %8 offset:704\n\tds_read_b64_tr_b16 %7, %8 offset:736\n\ts_waitcnt lgkmcnt(0)"
                    : "=&v"(ka[0]), "=&v"(ka[1]), "=&v"(ka[2]), "=&v"(ka[3]), "=&v"(ka[4]), "=&v"(ka[5]), "=&v"(ka[6]), "=&v"(ka[7]) : "v"(alo) : "memory");
                if (q8 == 3) asm volatile("ds_read_b64_tr_b16 %0, %8 offset:768\n\tds_read_b64_tr_b16 %1, %8 offset:800\n\tds_read_b64_tr_b16 %2, %8 offset:832\n\tds_read_b64_tr_b16 %3, %8 offset:864\n\tds_read_b64_tr_b16 %4, %8 offset:896\n\tds_read_b64_tr_b16 %5, %8 offset:928\n\tds_read_b64_tr_b16 %6, %8 offset:960\n\tds_read_b64_tr_b16 %7, %8 offset:992\n\ts_waitcnt lgkmcnt(0)"
                    : "=&v"(ka[0]), "=&v"(ka[1]), "=&v"(ka[2]), "=&v"(ka[3]), "=&v"(ka[4]), "=&v"(ka[5]), "=&v"(ka[6]), "=&v"(ka[7]) : "v"(alo) : "memory");
#pragma unroll
                for (int e = 0; e < 8; ++e) oacc[q8 * 8 + e] = __builtin_amdgcn_mfma_f32_16x16x16bf16_1k(ka[e], pf, oacc[q8 * 8 + e], 0, 0, 0);
            }
            selv = selvn; s4 = s4n;
        }
        Lw += shx(Lw, 16, lane); Lw += shx(Lw, 32, lane);
        const float inv = 1.0f / Lw;
        int m2_ = m; asm volatile("" : "+s"(m2_));
        bf16_t* op = OL + (size_t)m2_ * (NH * KVL) + r16 * KVL + 4 * gq;
#pragma unroll
        for (int dt = 0; dt < 32; ++dt) { u32x2 o; o.x = pk2(oacc[dt][0] * inv, oacc[dt][1] * inv); o.y = pk2(oacc[dt][2] * inv, oacc[dt][3] * inv); *(u32x2*)(op + 16 * dt) = o; }
    }
    __syncthreads();
}

constexpr int NWAVES = 8;
constexpr int PH_PER_LAYER = 16, N_PHASES = DEPTH * PH_PER_LAYER;
__global__ void __launch_bounds__(NWAVES * 64, 2) fwd(Args args) {
    extern __shared__ __attribute__((aligned(16))) unsigned char lds[];
    Frame F;
    F.lds = (LAS unsigned char*)lds;
    F.MISC = (volatile LAS unsigned*)(F.lds + MISC_OFF);
    F.tid = threadIdx.x; F.lane = F.tid & 63; F.wave = __builtin_amdgcn_readfirstlane(F.tid >> 6);
    F.G = gridDim.x; { const int bx = blockIdx.x; F.vcu = (F.G % 8 == 0) ? (bx % 8) * (F.G / 8) + bx / 8 : bx; }
    F.gw = F.vcu * NWAVES + F.wave; F.NGW = F.G * NWAVES;
    F.ctl = (gu32*)(args.ws + WS_CTL); F.ws = args.ws;
    for (int u = F.tid; u < (LDS_BYTES - LDSCTL_OFF) / 4; u += NWAVES * 64) ((LAS unsigned*)(F.lds + LDSCTL_OFF))[u] = 0u;
    __syncthreads();
    const int lo = args.ph_lo, hi = args.ph_hi;
    const bool single = (hi - lo) > 1;
    XcdBarrier bar; bar.bar = (unsigned*)(F.ctl + CW_BAR); bar.x = 0; bar.st = nullptr;
    if (single) bar = xcd_barrier_post((unsigned*)(F.ctl + CW_BAR), F.MISC + 8, F.tid);
#define IN(k) (lo <= (k) && (k) < hi)
#define SEAM() do { if (single) { int l2_; asm volatile("v_mbcnt_lo_u32_b32 %0, -1, 0\n\tv_mbcnt_hi_u32_b32 %0, -1, %0" : "=v"(l2_)); xcd_barrier(bar, (F.wave == 0 && l2_ == 0) ? 0 : 1); } } while (0)
    const int c = (int)blockIdx.x;
    const auto kargs = __builtin_amdgcn_kernarg_segment_ptr();
    const int wave0 = __builtin_amdgcn_readfirstlane((int)(threadIdx.x >> 6));
    static_assert(offsetof(Args, ws) == 0x108, "PHB reloads ws from kernarg offset 0x108");
#define PHB() unsigned char* ws; { unsigned long long w_; asm volatile("s_load_dwordx2 %0, %1, 0x108\n\ts_waitcnt lgkmcnt(0)" : "=s"(w_) : "s"(kargs) : "memory"); ws = (unsigned char*)(GAS unsigned char*)w_;     \
        int ln_; asm volatile("v_mbcnt_lo_u32_b32 %0, -1, 0\n\tv_mbcnt_hi_u32_b32 %0, -1, %0" : "=v"(ln_)); \
        int wv_ = __builtin_amdgcn_readfirstlane(wave0); asm volatile("" : "+s"(wv_)); \
        F.tid = wv_ * 64 + ln_; F.lane = ln_; F.wave = wv_; F.gw = F.vcu * NWAVES + wv_; F.ws = ws; F.ctl = (gu32*)ws; }
#define TP_BEG(id) do { } while (0)
#define TP_END() do { } while (0)
    for (int li = -1; li < DEPTH; ++li) {
        const int pb = li * PH_PER_LAYER, j = li >> 1;
        if (li >= 0) {
        if ((li & 1) == 0) {
            if (PON(1) && IN(pb + 1)) for (int rp_ = 0; rp_ < 1 + (int)PREP(1); ++rp_) { TP_BEG(1); PHB();
                pg8::Gemm g{(const bf16_t*)(ws + WS_H16), (const bf16_t*)(ws + WS_WMIX + WM_S5_IN), D, D, D, 0, 0}; pg8::SchedGrid S{T / 256, D / 256, 1, F.G, c};
                pg8::EpiStoreBf16 E{(bf16_t*)(ws + WS_S + S_U16), D, 0, 0, 0};
                pg8::gemm_phase(F.lds, g, S, E, F.wave, F.lane); SEAM(); TP_END(); }
            if (PON(2) && IN(pb + 2)) for (int rp_ = 0; rp_ < 1 + (int)PREP(2); ++rp_) { TP_BEG(2); PHB(); phase_ssm2(F, args); SEAM(); TP_END(); }
            if (PON(3) && IN(pb + 3)) for (int rp_ = 0; rp_ < 1 + (int)PREP(3); ++rp_) { TP_BEG(3); PHB();
                pg8::Gemm g{(const bf16_t*)(ws + WS_S + S_Z16), (const bf16_t*)(ws + WS_WMIX + WM_S5_GLU), D, D, D, 0, 0}; pg8::SchedGrid S{T / 256, D / 256, 1, F.G, c};
                pg8::EpiGlu E{(const bf16_t*)(ws + WS_S + S_Z16), (bf16_t*)(ws + WS_S + S_ZZ16), D};
                pg8::gemm_phase(F.lds, g, S, E, F.wave, F.lane); SEAM(); TP_END(); }
            if (PON(4) && IN(pb + 4)) for (int rp_ = 0; rp_ < 1 + (int)PREP(4); ++rp_) { TP_BEG(4); PHB();
                pg8::Gemm g{(const bf16_t*)(ws + WS_S + S_ZZ16), (const bf16_t*)(ws + WS_WMIX + WM_S5_OUT), D, D, D, 0, 0}; pg8::SchedGrid S{T / 256, D / 256, 1, F.G, c};
                pg8::EpiResid E{(bf16_t*)(ws + WS_H16), D, DN_ALPHA};
                pg8::gemm_phase(F.lds, g, S, E, F.wave, F.lane); SEAM(); TP_END(); }
        } else {
            if (PON(17) && IN(pb + 1)) for (int rp_ = 0; rp_ < 1 + (int)PREP(17); ++rp_) { TP_BEG(17); PHB();
                pg8::Gemm g{(const bf16_t*)(ws + WS_H16), (const bf16_t*)(ws + WS_WMIX + WM_D_IN), D, D, D, 0, 0}; pg8::SchedGrid S{T / 256, 4, 1, F.G, c};
                pg8::EpiDsaIn E{(bf16_t*)(ws + WS_CQ), (bf16_t*)(ws + WS_CKV), (bf16_t*)(ws + WS_KIDX), (float*)(ws + WS_WIDX), 0};
                pg8::gemm_phase(F.lds, g, S, E, F.wave, F.lane);
                SEAM(); TP_END(); }
            if (PON(18) && IN(pb + 2)) for (int rp_ = 0; rp_ < 1 + (int)PREP(18); ++rp_) { TP_BEG(18); PHB(); phase_rms(F, args, j); SEAM(); TP_END(); }
            if (PON(19) && IN(pb + 3)) for (int rp_ = 0; rp_ < 1 + (int)PREP(19); ++rp_) { TP_BEG(19); PHB();
                { const int ntail = T / 256;
                  pg8::Gemm g{(const bf16_t*)(ws + WS_H16), (const bf16_t*)(ws + WS_WMIX + WM_D_IN) + (size_t)4 * 256 * D, D, D, D, 0, 0}; pg8::SchedGrid S{ntail, 1, 1, F.G, c};
                  pg8::EpiDsaIn E{(bf16_t*)(ws + WS_CQ), (bf16_t*)(ws + WS_CKV), (bf16_t*)(ws + WS_KIDX), (float*)(ws + WS_WIDX), 4};
                  pg8::gemm_phase(F.lds, g, S, E, F.wave, F.lane); }
                pg8::Gemm g{(const bf16_t*)(ws + WS_CQ), (const bf16_t*)(ws + WS_WMIX + WM_D_Q), QL, QL, QL, 0, 0};
                pg8::SchedGridSplit S{pg8::SchedGrid{T / 256, 4096 / 256, 1, F.G, c}, (T / 256 < F.G) ? T / 256 : 0, 4};
                pg8::EpiStoreBf16 E{(bf16_t*)(ws + WS_S + S_Q16), 2048, 0, 2048, (size_t)(S_QIDX - S_Q16) / 2};
                pg8::gemm_phase(F.lds, g, S, E, F.wave, F.lane); SEAM(); TP_END(); }
            if (PON(20) && IN(pb + 4)) for (int rp_ = 0; rp_ < 1 + (int)PREP(20); ++rp_) { TP_BEG(20); PHB();
                pg8::Gemm g{(const bf16_t*)(ws + WS_S + S_Q16), (const bf16_t*)(ws + WS_WMIX + WM_D_UK), 2048, 128, 128, 128, 512 * 128}; pg8::SchedGrid S{T / 256, 512 / 256, 16, F.G, c};
                pg8::EpiStoreFp8 E{(unsigned char*)(ws + WS_S + S_QLAT), NH * KVL, 512};
                pg8::gemm_phase(F.lds, g, S, E, F.wave, F.lane); TP_END(); }
            if (PON(21) && IN(pb + 5)) for (int rp_ = 0; rp_ < 1 + (int)PREP(21); ++rp_) { TP_BEG(21); PHB(); phase_indexer2(F, args); SEAM(); TP_END(); }
            if (PON(22) && IN(pb + 6)) for (int rp_ = 0; rp_ < 1 + (int)PREP(22); ++rp_) { TP_BEG(22); PHB(); phase_topk(F, args); SEAM(); TP_END(); }
            if (PON(23) && IN(pb + 7)) for (int rp_ = 0; rp_ < 1 + (int)PREP(23); ++rp_) { TP_BEG(23); PHB(); phase_attn5(F, args, j); SEAM(); TP_END(); }
            if (PON(24) && IN(pb + 8)) for (int rp_ = 0; rp_ < 1 + (int)PREP(24); ++rp_) { TP_BEG(24); PHB();
                pg8::Gemm g{(const bf16_t*)(ws + WS_S + S_OLAT), (const bf16_t*)(ws + WS_WMIX + WM_D_UV), NH * KVL, 1024, 1024, 1024, 256 * 1024}; pg8::SchedGrid S{T / 256, 1, 8, F.G, c};
                pg8::EpiStoreBf16 E{(bf16_t*)(ws + WS_S + S_O16), D, 256, 0, 0};
                pg8::gemm_phase(F.lds, g, S, E, F.wave, F.lane); SEAM(); TP_END(); }
            if (PON(25) && IN(pb + 9)) for (int rp_ = 0; rp_ < 1 + (int)PREP(25); ++rp_) { TP_BEG(25); PHB();
                pg8::Gemm g{(const bf16_t*)(ws + WS_S + S_O16), (const bf16_t*)(ws + WS_WMIX + WM_D_OUT), D, D, D, 0, 0}; pg8::SchedGrid S{T / 256, D / 256, 1, F.G, c};
                pg8::EpiResid E{(bf16_t*)(ws + WS_H16), D, DN_ALPHA};
                pg8::gemm_phase(F.lds, g, S, E, F.wave, F.lane); SEAM(); TP_END(); }
        }
        if (PON(15) && IN(pb + 15)) for (int rp_ = 0; rp_ < 1 + (int)PREP(15); ++rp_) { TP_BEG(15); PHB(); phase_router(F, args, li); SEAM(); TP_END(); }
        if (PON(12) && IN(pb + 12)) for (int rp_ = 0; rp_ < 1 + (int)PREP(12); ++rp_) { TP_BEG(12); PHB();
            moe_table(F, li);
            const LAS int* tab = (const LAS int*)(F.lds + MOETAB_OFF);
            unsigned* dep = (unsigned*)(F.ctl + CW_DEP + li * 192 * 16);
            { pg8::SchedMoe S{tab, 1, F.G, F.vcu};
              LAS int* gtok = (LAS int*)(F.lds + RING_BYTES);
              { const unsigned* LIST = (const unsigned*)(ws + WS_LIST);
#pragma unroll
                for (int ui = 0; ui < 3; ++ui) { pg8::Unit u; if (S.next(ui, u) && F.tid < 256) { const int slot = u.pm * 256 + F.tid - tab[1 + u.pb];
                      gtok[ui * 256 + F.tid] = slot < tab[34 + u.pb] ? (int)(LIST[(size_t)u.pb * T + slot] & 0x7fffffffu) : 0; } } }
              __syncthreads();
              pg8::Gemm g{(const bf16_t*)(ws + WS_H16), (const bf16_t*)(ws + WS_WMOE + WE_GU), D, D, D, 0, 512 * D};
              pg8::EpiMoe1 E{(bf16_t*)(ws + WS_S + S_HMID), (const float*)(ws + WS_GWL), tab, dep};
              pg8::gemm_phase<pg8::EpiMoe1, pg8::SchedMoe, true>(F.lds, g, S, E, F.wave, F.lane, gtok); }
            { pg8::Gemm g{(const bf16_t*)(ws + WS_S + S_HMID), (const bf16_t*)(ws + WS_WMOE + WE_DN), FF, FF, FF, 0, D * FF}; pg8::SchedMoe2 S{tab, dep, F.G, F.vcu};
              pg8::EpiMoe2 E{(unsigned char*)(ws + WS_S + S_Y0), (unsigned char*)(ws + WS_S + S_Y1), (const unsigned*)(ws + WS_LIST), tab};
              pg8::gemm_phase(F.lds, g, S, E, F.wave, F.lane); }
            SEAM(); TP_END(); }
        }
        if (PON(14)) for (int rp_ = 0; rp_ < 1 + (int)PREP(14); ++rp_) { TP_BEG(14); PHB(); if (li >= 0) phase_ln<1>(F, args, li, F.gw, F.NGW, T);
            if (li + 1 < DEPTH) phase_conv(F, args, li + 1);
            SEAM(); TP_END(); }
    }
#undef IN
#undef SEAM
#undef PHB
}

extern "C" void kernel_launch(void* const* d_in, const int* in_sizes, int n_in, void* d_out, int out_size, void* d_ws, size_t ws_size, hipStream_t stream) {
    static int grid = 0;
    if (grid == 0) {
        if (n_in != 32 || out_size != T * D || ws_size < WS_END) { fprintf(stderr, "kernel_launch: unexpected problem (n_in %d, out %d, ws %zu)\n", n_in, out_size, ws_size); grid = -1; return; }
        int dev = 0, cus = 0, per_cu = 0;
        if (hipGetDevice(&dev) != hipSuccess || hipDeviceGetAttribute(&cus, hipDeviceAttributeMultiprocessorCount, dev) != hipSuccess) { grid = -1; return; }
        if (hipFuncSetAttribute((const void*)fwd, hipFuncAttributeMaxDynamicSharedMemorySize, LDS_BYTES) != hipSuccess) { fprintf(stderr, "kernel_launch: hipFuncSetAttribute failed\n"); grid = -1; return; }
        if (hipOccupancyMaxActiveBlocksPerMultiprocessor(&per_cu, (const void*)fwd, NWAVES * 64, LDS_BYTES) != hipSuccess || per_cu < 1) fprintf(stderr, "kernel_launch: occupancy query reports %d\n", per_cu);
        (void)hipGetLastError();
        grid = cus;
    }
    if (grid < 0) return;
    (void)hipMemsetAsync((char*)d_ws + WS_CTL, 0, CTL_ZERO_BYTES, stream);
    Args a{};
    for (int i = 0; i < 32; ++i) a.in[i] = (const float*)d_in[i];
    a.out = (float*)d_out; a.ws = (unsigned char*)d_ws;
    a.ph_lo = 0; a.ph_hi = N_PHASES;
    hipLaunchKernelGGL(fwd, dim3(grid), dim3(NWAVES * 64), LDS_BYTES, stream, a);
}
```
